# Optimizing an MI355X kernel written in HIP

```python
import math
import jax, jax.numpy as jnp
from jax import lax
import numpy as np

D_MODEL = 4096
BATCH = 2
SEQ = 4096
DEPTH = 2

HD = 128
GRID_W = 64
Q_BLOCK = 128
A_HEADS = 8
NA_ROWS = 8
NA_COLS = 16
B_Q_HEADS = 8
B_KV_HEADS = 2
ROPE_THETA = 10000.0
C_HEADS = 4
D_PATTERNS = ((128, 1), (512, 4), (2048, 16))
D_GROUPS = 3
D_HEADS_PER_GROUP = 4
N_BRANCHES = 4
RMS_EPS = 1e-6
NEG_INF = -1e30

A_W = A_HEADS * HD
B_QW = B_Q_HEADS * HD
B_KVW = B_KV_HEADS * HD
C_QKW = C_HEADS * 2 * HD
C_VW = C_HEADS * 2 * HD
D_QKVW = D_GROUPS * D_HEADS_PER_GROUP * HD
D_OW = D_HEADS_PER_GROUP * HD
SPLIT_WIDTHS = (A_W, A_W, A_W, A_W,
                B_QW, B_KVW, B_KVW, B_QW,
                C_QKW, C_QKW, C_VW, C_VW,
                D_QKVW, D_QKVW, D_QKVW, D_OW) + (D_MODEL,) * N_BRANCHES
N_IN = sum(SPLIT_WIDTHS)

kernel_name = "hybrid_parallel_gated_encoder"


def rms_norm(x, g):
    xf = x.astype(jnp.float32)
    y = xf * lax.rsqrt(jnp.mean(xf * xf, axis=-1, keepdims=True) + RMS_EPS)
    return (y * g.astype(jnp.float32)).astype(x.dtype)


def alibi_slopes(n):
    return jnp.asarray(2.0 ** (-8.0 * np.arange(1, n + 1) / n), dtype=jnp.float32)


def axial_rope(S):
    t = jnp.arange(S)
    row = (t // GRID_W).astype(jnp.float32)
    col = (t % GRID_W).astype(jnp.float32)
    n_pairs = HD // 4
    inv_freq = ROPE_THETA ** (-jnp.arange(n_pairs, dtype=jnp.float32) / n_pairs)
    ang = jnp.concatenate([row[:, None] * inv_freq, col[:, None] * inv_freq], axis=-1)
    return jnp.cos(ang), jnp.sin(ang)


def apply_rope(x, cos, sin):
    xf = x.astype(jnp.float32)
    x1, x2 = xf[..., 0::2], xf[..., 1::2]
    c, s = cos[None, :, None, :], sin[None, :, None, :]
    out = jnp.stack([x1 * c - x2 * s, x1 * s + x2 * c], axis=-1)
    return out.reshape(x.shape).astype(x.dtype)


def neighbourhood_attention(q, k, v, rel_bias, rows):
    B, S, H, _ = q.shape
    win_r = min(NA_ROWS, rows)
    qg = q.reshape(B, rows, GRID_W, H, HD)
    kg = k.reshape(B, rows, GRID_W, H, HD)
    vg = v.reshape(B, rows, GRID_W, H, HD)
    cols = jnp.arange(GRID_W)
    c0 = jnp.clip(cols - NA_COLS // 2, 0, GRID_W - NA_COLS)
    col_idx = c0[:, None] + jnp.arange(NA_COLS)[None, :]
    col_off = col_idx - cols[:, None] + (NA_COLS - 1)

    def row_block(r):
        r0 = jnp.clip(r - NA_ROWS // 2, 0, rows - win_r)
        q_r = lax.dynamic_index_in_dim(qg, r, axis=1, keepdims=False)
        k_r = lax.dynamic_slice_in_dim(kg, r0, win_r, axis=1)
        v_r = lax.dynamic_slice_in_dim(vg, r0, win_r, axis=1)
        k_nb = k_r[:, :, col_idx]
        v_nb = v_r[:, :, col_idx]
        s = jnp.einsum('bchd,bicjhd->bhcij', q_r, k_nb, preferred_element_type=jnp.float32)
        row_off = r0 + jnp.arange(win_r) - r + (NA_ROWS - 1)
        bias = rel_bias.astype(jnp.float32)[:, row_off][:, :, col_off]
        s = s + bias.transpose(0, 2, 1, 3)[None]
        p = jax.nn.softmax(s.reshape(B, H, GRID_W, win_r * NA_COLS), axis=-1)
        p = p.reshape(B, H, GRID_W, win_r, NA_COLS).astype(v.dtype)
        return jnp.einsum('bhcij,bicjhd->bchd', p, v_nb)

    o = lax.map(row_block, jnp.arange(rows))
    return o.transpose(1, 0, 2, 3, 4).reshape(B, S, H * HD)


def gqa_block_attention(q, k, v):
    B, S, Hq, _ = q.shape
    Hkv = k.shape[2]
    G = Hq // Hkv
    nblk = S // Q_BLOCK
    qb = q.reshape(B, nblk, Q_BLOCK, Hkv, G, HD).swapaxes(0, 1)

    def block(qi):
        s = jnp.einsum('bqhgd,bkhd->bhgqk', qi, k, preferred_element_type=jnp.float32)
        p = jax.nn.softmax(s, axis=-1).astype(v.dtype)
        return jnp.einsum('bhgqk,bkhd->bqhgd', p, v)

    o = lax.map(block, qb)
    return o.swapaxes(0, 1).reshape(B, S, Hq * HD)


def diff_block_attention(q, k, v, lam, slopes):
    B, S, H = q.shape[:3]
    nblk = S // Q_BLOCK
    kpos = jnp.arange(S, dtype=jnp.float32)
    qb = q.reshape(B, nblk, Q_BLOCK, H, 2, HD).swapaxes(0, 1)

    def block(args):
        qi, i = args
        qpos = (i * Q_BLOCK + jnp.arange(Q_BLOCK)).astype(jnp.float32)
        dist = jnp.abs(qpos[:, None] - kpos[None, :])
        s = jnp.einsum('bqhmd,bkhmd->bhmqk', qi, k, preferred_element_type=jnp.float32)
        s = s - slopes[None, :, None, None, None] * dist
        p = jax.nn.softmax(s, axis=-1)
        a = (p[:, :, 0] - lam * p[:, :, 1]).astype(v.dtype)
        return jnp.einsum('bhqk,bkhe->bqhe', a, v)

    o = lax.map(block, (qb, jnp.arange(nblk)))
    return o.swapaxes(0, 1).reshape(B, S, H, 2 * HD)


def dilated_attention(q, k, v, slopes):
    B, S = q.shape[:2]
    nblk = S // Q_BLOCK
    outs, lses = [], []
    for g, (window, dilation) in enumerate(D_PATTERNS):
        n_side = window // (2 * dilation)
        offs = dilation * jnp.arange(-n_side, n_side + 1)
        penalty = slopes[g][:, None, None] * jnp.abs(offs).astype(jnp.float32)
        kg, vg = k[:, :, g], v[:, :, g]
        qb = q[:, :, g].reshape(B, nblk, Q_BLOCK, D_HEADS_PER_GROUP, HD).swapaxes(0, 1)

        def block(args, kg=kg, vg=vg, offs=offs, penalty=penalty):
            qi, i = args
            t = i * Q_BLOCK + jnp.arange(Q_BLOCK)
            idx = t[:, None] + offs[None, :]
            valid = (idx >= 0) & (idx < S)
            idx = jnp.clip(idx, 0, S - 1)
            kn, vn = kg[:, idx], vg[:, idx]
            s = jnp.einsum('bqhd,bqkhd->bhqk', qi, kn, preferred_element_type=jnp.float32) - penalty[None]
            s = jnp.where(valid[None, None], s, NEG_INF)
            lse = jax.nn.logsumexp(s, axis=-1)
            p = jnp.exp(s - lse[..., None]).astype(vn.dtype)
            return jnp.einsum('bhqk,bqkhd->bqhd', p, vn), lse

        o, lse = lax.map(block, (qb, jnp.arange(nblk)))
        outs.append(o.swapaxes(0, 1).reshape(B, S, D_HEADS_PER_GROUP, HD))
        lses.append(lse.transpose(1, 0, 3, 2).reshape(B, S, D_HEADS_PER_GROUP))
    o = jnp.stack(outs, axis=0).astype(jnp.float32)
    w = jax.nn.softmax(jnp.stack(lses, axis=0), axis=0)
    out = jnp.sum(w[..., None] * o, axis=0)
    return out.astype(q.dtype).reshape(B, S, D_OW)


def hybrid_layer(x, layer_idx, norm_g, w_in, qk_gain, na_rel_bias, diff_lambda, diff_subln_g,
                 w_branch_a, w_branch_b, w_branch_c, w_branch_d, w_out):
    B, S, _ = x.shape
    rows = S // GRID_W
    scale = HD ** -0.5
    xn = rms_norm(x, norm_g)
    proj = jnp.einsum('bsd,de->bse', xn, w_in)
    split_points = [int(p) for p in np.cumsum(SPLIT_WIDTHS)[:-1]]
    (a_q, a_k, a_v, a_z, b_q, b_k, b_v, b_z, c_q, c_k, c_v, c_z,
     d_q, d_k, d_v, d_z, g_a, g_b, g_c, g_d) = jnp.split(proj, split_points, axis=-1)

    qa = rms_norm(a_q.reshape(B, S, A_HEADS, HD), qk_gain[0, 0]) * scale
    ka = rms_norm(a_k.reshape(B, S, A_HEADS, HD), qk_gain[0, 1])
    va = a_v.reshape(B, S, A_HEADS, HD)
    y_a = neighbourhood_attention(qa, ka, va, na_rel_bias, rows) * jax.nn.silu(a_z)

    cos, sin = axial_rope(S)
    qb = apply_rope(rms_norm(b_q.reshape(B, S, B_Q_HEADS, HD), qk_gain[1, 0]), cos, sin) * scale
    kb = apply_rope(rms_norm(b_k.reshape(B, S, B_KV_HEADS, HD), qk_gain[1, 1]), cos, sin)
    vb = b_v.reshape(B, S, B_KV_HEADS, HD)
    y_b = gqa_block_attention(qb, kb, vb) * jax.nn.silu(b_z)

    lam_init = 0.8 - 0.6 * math.exp(-0.3 * layer_idx)
    lam_p = diff_lambda.astype(jnp.float32)
    lam = jnp.exp(jnp.sum(lam_p[0] * lam_p[1])) - jnp.exp(jnp.sum(lam_p[2] * lam_p[3])) + lam_init
    qc = rms_norm(c_q.reshape(B, S, C_HEADS, 2, HD), qk_gain[2, 0]) * scale
    kc = rms_norm(c_k.reshape(B, S, C_HEADS, 2, HD), qk_gain[2, 1])
    vc = c_v.reshape(B, S, C_HEADS, 2 * HD)
    oc = diff_block_attention(qc, kc, vc, lam, alibi_slopes(C_HEADS))
    oc = rms_norm(oc, diff_subln_g) * (1.0 - lam_init)
    y_c = oc.reshape(B, S, C_VW) * jax.nn.silu(c_z)

    d_slopes = alibi_slopes(D_GROUPS * D_HEADS_PER_GROUP).reshape(D_GROUPS, D_HEADS_PER_GROUP)
    qd = rms_norm(d_q.reshape(B, S, D_GROUPS, D_HEADS_PER_GROUP, HD), qk_gain[3, 0]) * scale
    kd = rms_norm(d_k.reshape(B, S, D_GROUPS, D_HEADS_PER_GROUP, HD), qk_gain[3, 1])
    vd = d_v.reshape(B, S, D_GROUPS, D_HEADS_PER_GROUP, HD)
    y_d = dilated_attention(qd, kd, vd, d_slopes) * jax.nn.silu(d_z)

    merged = (jax.nn.sigmoid(g_a) * jnp.einsum('bse,ed->bsd', y_a, w_branch_a)
              + jax.nn.sigmoid(g_b) * jnp.einsum('bse,ed->bsd', y_b, w_branch_b)
              + jax.nn.sigmoid(g_c) * jnp.einsum('bse,ed->bsd', y_c, w_branch_c)
              + jax.nn.sigmoid(g_d) * jnp.einsum('bse,ed->bsd', y_d, w_branch_d))
    return x + jnp.einsum('bsd,de->bse', merged, w_out)


def setup_inputs(seed: int = 0) -> dict:
    key = jax.random.key(seed)
    ks = jax.random.split(key, 12)
    f32 = jnp.float32
    nrm = jax.random.normal
    return {
        'x': nrm(ks[0], (BATCH, SEQ, D_MODEL), f32),
        'norm_g': 1.0 + 0.01 * nrm(ks[1], (DEPTH, D_MODEL), f32),
        'w_in': nrm(ks[2], (DEPTH, D_MODEL, N_IN), f32) * D_MODEL ** -0.5,
        'qk_gain': 1.0 + 0.01 * nrm(ks[3], (DEPTH, N_BRANCHES, 2, HD), f32),
        'na_rel_bias': 0.1 * nrm(ks[4], (DEPTH, A_HEADS, 2 * NA_ROWS - 1, 2 * NA_COLS - 1), f32),
        'diff_lambda': 0.1 * nrm(ks[5], (DEPTH, 4, HD), f32),
        'diff_subln_g': 1.0 + 0.01 * nrm(ks[6], (DEPTH, 2 * HD), f32),
        'w_branch_a': nrm(ks[7], (DEPTH, A_W, D_MODEL), f32) * A_W ** -0.5,
        'w_branch_b': nrm(ks[8], (DEPTH, B_QW, D_MODEL), f32) * B_QW ** -0.5,
        'w_branch_c': nrm(ks[9], (DEPTH, C_VW, D_MODEL), f32) * C_VW ** -0.5,
        'w_branch_d': nrm(ks[10], (DEPTH, D_OW, D_MODEL), f32) * D_OW ** -0.5,
        'w_out': nrm(ks[11], (DEPTH, D_MODEL, D_MODEL), f32) * D_MODEL ** -0.5,
    }


def reference(x, norm_g, w_in, qk_gain, na_rel_bias, diff_lambda, diff_subln_g,
              w_branch_a, w_branch_b, w_branch_c, w_branch_d, w_out):
    for l in range(DEPTH):
        x = hybrid_layer(x, l, norm_g[l], w_in[l], qk_gain[l], na_rel_bias[l], diff_lambda[l],
                         diff_subln_g[l], w_branch_a[l], w_branch_b[l], w_branch_c[l],
                         w_branch_d[l], w_out[l])
    return x
```

```cpp
#include <hip/hip_runtime.h>
#include <cstdio>
#include <cstdint>
__device__ __forceinline__ int fresh_tid(int wave) { unsigned m = ~0u; asm volatile("" : "+s"(m)); return wave * 64 + (int)__builtin_amdgcn_mbcnt_hi(m, __builtin_amdgcn_mbcnt_lo(m, 0u)); }
namespace pg8 {
#define PG8_LAS __attribute__((address_space(3)))
typedef unsigned short bf16_t;
typedef short bf16x8 __attribute__((ext_vector_type(8)));
typedef float f32x4 __attribute__((ext_vector_type(4)));
typedef unsigned u32x4 __attribute__((ext_vector_type(4)));
constexpr int BM = 256, BK = 64, HALF = 128, HTB = HALF * BK * 2  , STAGE_BYTES = 8 * HTB, NXCD = 8, WGM = 8;

__host__ __device__ __forceinline__ int lds_byte(int r, int c) { const int st = (r >> 4) * 2 + (c >> 5), rr = r & 15, cc = c & 31, ob = rr * 64 + cc * 2; return st * 1024 + (ob ^ (((ob >> 9) & 1) << 5)); }
__host__ __device__ __forceinline__ void stage_rc(int b, int& R, int& C) { const int st = b / 1024, sb = b % 1024, swz = sb ^ (((sb >> 9) & 1) << 5); R = (st >> 1) * 16 + swz / 64; C = (st & 1) * 32 + (swz % 64) / 2; }
__host__ __device__ __forceinline__ int perm32(int rho) { const int n = rho >> 4, i = rho & 15; return 8 * (i >> 2) + 4 * n + (i & 3); }

struct Unit { int pm, pn, seg; };
struct Gemm { const bf16_t* A; const bf16_t* Bt; int M, N, K, P;
    __device__ __forceinline__ int pitch() const { return P; }
    __device__ __forceinline__ int ntiles(const Unit&) const { return K / BK; }
    __device__ __forceinline__ const char* a_base(const Unit& u, size_t tstep) const { return (const char*)A + (size_t)u.pm * tstep; }
    __device__ __forceinline__ const char* b_base(const Unit& u, size_t tstep) const { return (const char*)Bt + (size_t)u.pn * tstep; }
};
__host__ __device__ __forceinline__ int map16(int j) { return j + 26; }
__host__ __device__ __forceinline__ int map8(int j) { return j < 26 ? j : j + 16; }
constexpr int NT16 = 16, NT8 = 110;
struct GemmMap16 { const bf16_t* A; const bf16_t* Bt; int K, P;
    __device__ __forceinline__ int pitch() const { return P; }
    __device__ __forceinline__ int ntiles(const Unit&) const { return K / BK; }
    __device__ __forceinline__ const char* a_base(const Unit& u, size_t tstep) const { return (const char*)A + (size_t)u.pm * tstep; }
    __device__ __forceinline__ const char* b_base(const Unit& u, size_t tstep) const { return (const char*)Bt + (size_t)map16(u.pn) * tstep; }
};
struct ChainGemm { const bf16_t* A0; const bf16_t* B0; size_t a_stride, b_stride; int P, K, rot;
    __device__ __forceinline__ int branch(const Unit& u) const { return (u.seg + 3 * rot) & 3; }
    __device__ __forceinline__ int pitch() const { return P; }
    __device__ __forceinline__ int ntiles(const Unit& u) const { return (branch(u) == 3) ? (K / BK) / 2 : K / BK; }
    __device__ __forceinline__ const char* a_base(const Unit& u, size_t tstep) const { return (const char*)(A0 + (size_t)branch(u) * a_stride) + (size_t)u.pm * tstep; }
    __device__ __forceinline__ const char* b_base(const Unit& u, size_t tstep) const { return (const char*)(B0 + (size_t)branch(u) * b_stride) + (size_t)u.pn * tstep; }
};

struct StaticOrder {
    int nM, nN, nwg, G, c;
    __host__ __device__ void init(int M, int N, int G_, int c_) { nM = M / BM; nN = N / BM; nwg = nM * nN; G = G_; c = c_; }
    __host__ __device__ bool next(int i, Unit& u) const {
        const long L = (long)i * G + c; if (L >= nwg) return false;
        int wgid = (int)L; { const int q = nwg / NXCD, r = nwg % NXCD, xcd = wgid % NXCD, off = wgid / NXCD; wgid = (xcd < r ? xcd * (q + 1) : r * (q + 1) + (xcd - r) * q) + off; }
        const int nig = WGM * nN, gid = wgid / nig, fm = gid * WGM, gsz = (nM - fm) < WGM ? (nM - fm) : WGM;
        u.pm = fm + ((wgid % nig) % gsz); u.pn = (wgid % nig) / gsz; u.seg = 0; return true;
    }
    __device__ __forceinline__ void a_ready(const Unit&) const {}
    __device__ __forceinline__ void done(const Unit&) const {}
};
struct ChainOrder { StaticOrder T;
    __device__ __forceinline__ bool next(int i, Unit& u) const { if (!T.next(i >> 2, u)) return false; u.seg = i & 3; return true; }
    __device__ __forceinline__ void a_ready(const Unit&) const {}
    __device__ __forceinline__ void done(const Unit&) const {}
};

__device__ __forceinline__ unsigned cvt_pk_bf16(float lo, float hi) { unsigned r; asm volatile("v_cvt_pk_bf16_f32 %0, %1, %2" : "=v"(r) : "v"(lo), "v"(hi)); return r; }
typedef float f32x2 __attribute__((ext_vector_type(2)));
typedef int i32x4 __attribute__((ext_vector_type(4)));
template <bool I8> struct AccT { typedef f32x4 type; };
template <> struct AccT<true> { typedef i32x4 type; };
template <bool I8> __device__ __forceinline__ typename AccT<I8>::type mma1(bf16x8 b, bf16x8 a, typename AccT<I8>::type c) {
    if constexpr (I8) return __builtin_amdgcn_mfma_i32_16x16x64_i8(__builtin_bit_cast(i32x4, b), __builtin_bit_cast(i32x4, a), c, 0, 0, 0);
    else return __builtin_amdgcn_mfma_f32_16x16x32_bf16(b, a, c, 0, 0, 0);
}
__device__ __forceinline__ float sigmoid_fast(float v) { return __builtin_amdgcn_rcpf(1.0f + __builtin_amdgcn_exp2f(-1.4426950408889634f * v)); }
__device__ __forceinline__ float bf_lo(unsigned w) { return __builtin_bit_cast(float, w << 16); }
__device__ __forceinline__ float bf_hi(unsigned w) { return __builtin_bit_cast(float, w & 0xffff0000u); }
template <bool I8> struct EpiProjT {
    static constexpr bool PERM = true, AFTER_DRAIN = false;
    bf16_t* O; int ldc; const float* qk_gain  ; PG8_LAS float* xtab  ; float qscale; const float* sa; const float* sb;
    __device__ __forceinline__ bool resets(const Unit&) const { return true; }
    __device__ __forceinline__ void operator()(const typename AccT<I8>::type (&acc)[2][2][4][2], const Unit& u, int wr, int wc, int fr, int fq) const {
        const int pn = I8 ? map8(u.pn) : map16(u.pn);
        int kind, br = 0, isk = 0;
        if (pn >= 62) kind = 2;
        else if ((pn >= 12 && pn < 16) || (pn >= 22 && pn < 26) || (pn >= 38 && pn < 42) || pn >= 60) kind = 1;
        else if (pn < 8) { kind = 3; br = 0; isk = pn >= 4; }
        else if (pn >= 16 && pn < 21) { kind = 3; br = 1; isk = pn >= 20; }
        else if (pn >= 26 && pn < 34) { kind = 3; br = 2; isk = pn >= 30; }
        else if (pn >= 42 && pn < 54) { kind = 3; br = 3; isk = pn >= 48; }
        else kind = 0;
        const int row0 = u.pm * BM + wr * 64 + fr, cc0 = wc * 32 + 8 * fq, col0 = pn * BM + cc0;
        f32x4 sbv[2][2];
        if (I8) {
#pragma unroll
            for (int bj = 0; bj < 2; ++bj)
#pragma unroll
                for (int n = 0; n < 2; ++n) sbv[bj][n] = *(const f32x4*)(sb + u.pn * BM + cc0 + bj * HALF + 4 * n);
        }
        float sarr[2][4];
#pragma unroll
        for (int ai = 0; ai < 2; ++ai)
#pragma unroll
            for (int m = 0; m < 4; ++m) sarr[ai][m] = I8 ? sa[row0 + ai * HALF + m * 16] : 1.0f;
        if (I8) asm volatile("" ::: "memory");
#define EPV(ai, bj, m, n, sar) (I8 ? (f32x4){(float)acc[ai][bj][m][n][0], (float)acc[ai][bj][m][n][1], (float)acc[ai][bj][m][n][2], (float)acc[ai][bj][m][n][3]} * (sar) * sbv[bj][n] \
                                   : (f32x4){(float)acc[ai][bj][m][n][0], (float)acc[ai][bj][m][n][1], (float)acc[ai][bj][m][n][2], (float)acc[ai][bj][m][n][3]})
        if (kind != 3) {
#pragma unroll
            for (int ai = 0; ai < 2; ++ai)
#pragma unroll
                for (int m = 0; m < 4; ++m) { const int row = row0 + ai * HALF + m * 16; bf16_t* rowp = O + (size_t)row * ldc + col0; const float sar = sarr[ai][m];
#pragma unroll
                    for (int bj = 0; bj < 2; ++bj) { f32x4 v0 = EPV(ai, bj, m, 0, sar), v1 = EPV(ai, bj, m, 1, sar);
                        if (kind == 1) {
#pragma unroll
                            for (int e = 0; e < 4; ++e) { v0[e] *= sigmoid_fast(v0[e]); v1[e] *= sigmoid_fast(v1[e]); }
                        } else if (kind == 2) {
#pragma unroll
                            for (int e = 0; e < 4; ++e) { v0[e] = fminf(__builtin_amdgcn_exp2f(-1.4426950408889634f * v0[e]), 1e18f); v1[e] = fminf(__builtin_amdgcn_exp2f(-1.4426950408889634f * v1[e]), 1e18f); }
                        }
                        u32x4 w; w.x = cvt_pk_bf16(v0[0], v0[1]); w.y = cvt_pk_bf16(v0[2], v0[3]); w.z = cvt_pk_bf16(v1[0], v1[1]); w.w = cvt_pk_bf16(v1[2], v1[3]);
                        *(u32x4*)(rowp + bj * HALF) = w; } }
            return;
        }
#pragma unroll
        for (int ai = 0; ai < 2; ++ai)
#pragma unroll
            for (int m = 0; m < 4; ++m) { const float sar = sarr[ai][m];
#pragma unroll
                for (int bj = 0; bj < 2; ++bj) { const f32x4 a = EPV(ai, bj, m, 0, sar), b = EPV(ai, bj, m, 1, sar);
                    float s = (a[0] * a[0] + a[1] * a[1]) + (a[2] * a[2] + a[3] * a[3]) + (b[0] * b[0] + b[1] * b[1]) + (b[2] * b[2] + b[3] * b[3]);
                    s += __builtin_bit_cast(float, __builtin_amdgcn_ds_bpermute(((fq * 16 + fr) ^ 16) << 2, __builtin_bit_cast(int, s)));
                    s += __builtin_bit_cast(float, __builtin_amdgcn_ds_bpermute(((fq * 16 + fr) ^ 32) << 2, __builtin_bit_cast(int, s)));
                    if (fq == 0) xtab[((ai * HALF + wr * 64 + m * 16 + fr) * 2 + bj) * 4 + wc] = s; } }
        asm volatile("s_waitcnt lgkmcnt(0)" ::: "memory"); __builtin_amdgcn_s_barrier(); asm volatile("" ::: "memory");
        const float* gp = qk_gain + (br * 2 + isk) * 128 + cc0;
        const f32x4 ga = *(const f32x4*)gp, gb = *(const f32x4*)(gp + 4);
        const float sc = isk ? 1.0f : qscale;
        float invf[4];
#pragma unroll
        for (int i = 0; i < 4; ++i) invf[i] = __builtin_amdgcn_exp2f(-(float)(((cc0 >> 1) + i) & 31) * (13.287712379549449f / 32.f));
#pragma unroll
        for (int ai = 0; ai < 2; ++ai)
#pragma unroll
            for (int m = 0; m < 4; ++m) { const int rl = ai * HALF + wr * 64 + m * 16 + fr; const int row = u.pm * BM + rl;
                bf16_t* rowp = O + (size_t)row * ldc + col0; const float sar = sarr[ai][m];
                const int spos = row & 4095; const float fpos = (wc < 2) ? (float)(spos >> 6) : (float)(spos & 63);
#pragma unroll
                for (int bj = 0; bj < 2; ++bj) { const f32x4 t = *(const PG8_LAS f32x4*)(xtab + (rl * 2 + bj) * 4);
                    const float rstd = sc / sqrtf(((t[0] + t[1]) + (t[2] + t[3])) * (1.0f / 128.0f) + 1e-6f);
                    f32x4 v0 = EPV(ai, bj, m, 0, sar) * rstd * ga, v1 = EPV(ai, bj, m, 1, sar) * rstd * gb;
                    if (br == 1) {
                        float x[8] = {v0[0], v0[1], v0[2], v0[3], v1[0], v1[1], v1[2], v1[3]};
#pragma unroll
                        for (int i = 0; i < 4; ++i) { const float rev = __builtin_amdgcn_fractf(fpos * invf[i] * 0.15915494309189535f);
                            const float sn = __builtin_amdgcn_sinf(rev), cs = __builtin_amdgcn_cosf(rev);
                            const float x1 = x[2 * i], x2 = x[2 * i + 1]; x[2 * i] = x1 * cs - x2 * sn; x[2 * i + 1] = x1 * sn + x2 * cs; }
                        v0 = (f32x4){x[0], x[1], x[2], x[3]}; v1 = (f32x4){x[4], x[5], x[6], x[7]};
                    }
                    u32x4 w; w.x = cvt_pk_bf16(v0[0], v0[1]); w.y = cvt_pk_bf16(v0[2], v0[3]); w.z = cvt_pk_bf16(v1[0], v1[1]); w.w = cvt_pk_bf16(v1[2], v1[3]);
                    *(u32x4*)(rowp + bj * HALF) = w; } }
#undef EPV
    }
};
struct EpiChain {
    static constexpr bool PERM = true, AFTER_DRAIN = false;
    const bf16_t* G; int ldg; bf16_t* Mg; int ldm; int rot;
    __device__ __forceinline__ bool resets(const Unit& u) const { return u.seg == 3; }
    __device__ __forceinline__ void operator()(f32x4 (&acc)[2][2][4][2], const Unit& u, int wr, int wc, int fr, int fq) const {
        const int row0 = u.pm * BM + wr * 64 + fr, col0 = u.pn * BM + wc * 32 + 8 * fq, seg = u.seg;
        const int bcur = (seg + 3 * rot) & 3, bnxt = (seg + 1 + 3 * rot) & 3;
        const bf16_t* Gs = G + (size_t)bcur * 4096;
        const bool lastseg = seg == 3;
        const int nxo = lastseg ? 0 : (bnxt - bcur) * 4096;
#pragma unroll
        for (int ai = 0; ai < 2; ++ai) {
            u32x4 gw[4][2], nw[4][2];
#pragma unroll
            for (int m = 0; m < 4; ++m) { const size_t row = (size_t)(row0 + ai * HALF + m * 16);
#pragma unroll
                for (int bj = 0; bj < 2; ++bj) { gw[m][bj] = *(const u32x4*)(Gs + row * ldg + col0 + bj * HALF); nw[m][bj] = *(const u32x4*)(Gs + nxo + row * ldg + col0 + bj * HALF); } }
            asm volatile("" ::: "memory");
#pragma unroll
            for (int m = 0; m < 4; ++m) { const size_t row = (size_t)(row0 + ai * HALF + m * 16);
#pragma unroll
                for (int bj = 0; bj < 2; ++bj) { const u32x4 g = gw[m][bj], q = nw[m][bj];
                    float f[8] = {bf_lo(g.x), bf_hi(g.x), bf_lo(g.y), bf_hi(g.y), bf_lo(g.z), bf_hi(g.z), bf_lo(g.w), bf_hi(g.w)};
                    const float d[8] = {bf_lo(q.x), bf_hi(q.x), bf_lo(q.y), bf_hi(q.y), bf_lo(q.z), bf_hi(q.z), bf_lo(q.w), bf_hi(q.w)};
#pragma unroll
                    for (int e = 0; e < 8; ++e) { const float r = __builtin_amdgcn_rcpf(1.0f + f[e]); f[e] = lastseg ? r : (1.0f + d[e]) * r; }
                    f32x4 v0 = acc[ai][bj][m][0], v1 = acc[ai][bj][m][1];
                    v0[0] *= f[0]; v0[1] *= f[1]; v0[2] *= f[2]; v0[3] *= f[3]; v1[0] *= f[4]; v1[1] *= f[5]; v1[2] *= f[6]; v1[3] *= f[7];
                    acc[ai][bj][m][0] = v0; acc[ai][bj][m][1] = v1;
                    if (lastseg) { u32x4 w; w.x = cvt_pk_bf16(v0[0], v0[1]); w.y = cvt_pk_bf16(v0[2], v0[3]); w.z = cvt_pk_bf16(v1[0], v1[1]); w.w = cvt_pk_bf16(v1[2], v1[3]);
                        *(u32x4*)(Mg + row * ldm + col0 + bj * HALF) = w; } } }
            asm volatile("" ::: "memory");
        }
    }
};
struct EpiRes {
    static constexpr bool PERM = false, AFTER_DRAIN = false;
    const float* base; float* out; int ldc;
    __device__ __forceinline__ bool resets(const Unit&) const { return true; }
    __device__ __forceinline__ void operator()(const f32x4 (&acc)[2][2][4][2], const Unit& u, int wr, int wc, int fr, int fq) const {
        const int col0 = u.pn * BM + wc * 32 + 4 * fq;
#pragma unroll
        for (int ai = 0; ai < 2; ++ai) {
            f32x4 pre[4][2][2];
#pragma unroll
            for (int m = 0; m < 4; ++m) { const size_t off = (size_t)(u.pm * BM + ai * HALF + wr * 64 + m * 16 + fr) * ldc + col0;
#pragma unroll
                for (int bj = 0; bj < 2; ++bj)
#pragma unroll
                    for (int n = 0; n < 2; ++n) pre[m][bj][n] = *(const f32x4*)(base + off + bj * HALF + n * 16); }
            asm volatile("" ::: "memory");
#pragma unroll
            for (int m = 0; m < 4; ++m) { const size_t off = (size_t)(u.pm * BM + ai * HALF + wr * 64 + m * 16 + fr) * ldc + col0;
#pragma unroll
                for (int bj = 0; bj < 2; ++bj)
#pragma unroll
                    for (int n = 0; n < 2; ++n) *(f32x4*)(out + off + bj * HALF + n * 16) = pre[m][bj][n] + acc[ai][bj][m][n]; }
            asm volatile("" ::: "memory");
        }
    }
};
struct EpiRes8 {
    static constexpr bool PERM = false, AFTER_DRAIN = false;
    const float* base; float* out; int ldc; const float* sm; const float* so;
    __device__ __forceinline__ bool resets(const Unit&) const { return true; }
    __device__ __forceinline__ void operator()(const i32x4 (&acc)[2][2][4][2], const Unit& u, int wr, int wc, int fr, int fq) const {
        const int col0 = u.pn * BM + wc * 32 + 4 * fq;
        f32x4 sov[2][2];
#pragma unroll
        for (int bj = 0; bj < 2; ++bj)
#pragma unroll
            for (int n = 0; n < 2; ++n) sov[bj][n] = *(const f32x4*)(so + col0 + bj * HALF + n * 16);
#pragma unroll
        for (int ai = 0; ai < 2; ++ai) {
            f32x4 pre[4][2][2]; float smr[4];
#pragma unroll
            for (int m = 0; m < 4; ++m) { const int row = u.pm * BM + ai * HALF + wr * 64 + m * 16 + fr; const size_t off = (size_t)row * ldc + col0; smr[m] = sm[row];
#pragma unroll
                for (int bj = 0; bj < 2; ++bj)
#pragma unroll
                    for (int n = 0; n < 2; ++n) pre[m][bj][n] = *(const f32x4*)(base + off + bj * HALF + n * 16); }
            asm volatile("" ::: "memory");
#pragma unroll
            for (int m = 0; m < 4; ++m) { const size_t off = (size_t)(u.pm * BM + ai * HALF + wr * 64 + m * 16 + fr) * ldc + col0;
#pragma unroll
                for (int bj = 0; bj < 2; ++bj)
#pragma unroll
                    for (int n = 0; n < 2; ++n) { const i32x4 a = acc[ai][bj][m][n]; f32x4 v; v[0] = (float)a[0]; v[1] = (float)a[1]; v[2] = (float)a[2]; v[3] = (float)a[3];
                        *(f32x4*)(out + off + bj * HALF + n * 16) = pre[m][bj][n] + v * smr[m] * sov[bj][n]; } }
            asm volatile("" ::: "memory");
        }
    }
};

template <class Epi, class Sched, bool ALIGN_EPI = false, bool SP2 = false, class GemmT = Gemm, bool I8 = false>
__device__ __forceinline__ void gemm_phase(PG8_LAS unsigned char* lds, const GemmT g, const Sched& S, const Epi& E, const int wave_in) {
    int tid_ = fresh_tid(wave_in); asm volatile("" : "+v"(tid_));
    const int tid = tid_, wid = __builtin_amdgcn_readfirstlane(tid >> 6), lane = tid & 63, wr = wid >> 2, wc = wid & 3, fr = lane & 15, fq = lane >> 4;
    const int K = g.pitch();
    unsigned voffA[2], voffB[2];
#pragma unroll
    for (int i = 0; i < 2; ++i) { int R, C; stage_rc(tid * 16 + i * 8192, R, C); const int Rb = Epi::PERM ? ((R & ~31) + perm32(R & 31)) : R;
        voffA[i] = (unsigned)(R * K + C) * 2u; voffB[i] = (unsigned)(Rb * K + C) * 2u; }
    const size_t kstep = (size_t)(BK * 2);
    const size_t hstep = (size_t)HALF * K * 2;
    const size_t tstep = 2 * hstep;
    const unsigned ldsw = (unsigned)wid * 1024u;
    const int aoff = lds_byte(wr * 64 + fr, fq * 8), boff = lds_byte(wc * 32 + fr, fq * 8);
#define PG8_SA(b, h) (((b) * 2 + (h)) * HTB)
#define PG8_SB(b, h) ((4 + (b) * 2 + (h)) * HTB)
#define PG8_STAGE(bufoff, gbase, voff) do { _Pragma("unroll") for (int _i = 0; _i < 2; ++_i) \
        __builtin_amdgcn_global_load_lds((const unsigned*)((const char*)(gbase) + (voff)[_i]), (PG8_LAS unsigned*)(lds + (bufoff) + ldsw + _i * 8192), 16, 0, 0); } while (0)
#define PG8_LDA(dst, b, h) do { _Pragma("unroll") for (int m = 0; m < 4; ++m) _Pragma("unroll") for (int k = 0; k < 2; ++k) dst[m][k] = *(const PG8_LAS bf16x8*)(lds + PG8_SA(b, h) + aoff + m * 2048 + k * 1024); } while (0)
#define PG8_LDB(dst, b, h) do { _Pragma("unroll") for (int n = 0; n < 2; ++n) _Pragma("unroll") for (int k = 0; k < 2; ++k) dst[n][k] = *(const PG8_LAS bf16x8*)(lds + PG8_SB(b, h) + boff + n * 2048 + k * 1024); } while (0)
#define PG8_MMA(ai, bj, At, Bt) do { __builtin_amdgcn_s_setprio(1); _Pragma("unroll") for (int m = 0; m < 4; ++m) _Pragma("unroll") for (int n = 0; n < 2; ++n) _Pragma("unroll") for (int k = 0; k < 2; ++k) \
        acc[ai][bj][m][n] = mma1<I8>(Bt[n][k], At[m][k], acc[ai][bj][m][n]); __builtin_amdgcn_s_setprio(0); } while (0)
#define PG8_WAIT_V(n) asm volatile("s_waitcnt vmcnt(" #n ")" ::: "memory")
#define PG8_WAIT_L(n) asm volatile("s_waitcnt lgkmcnt(" #n ")" ::: "memory")
#define PG8_BAR __builtin_amdgcn_s_barrier()
#define PG8_SCHED __builtin_amdgcn_sched_barrier(0)
    Unit cur, nxt; int ui = 0;
    if (!S.next(0, cur)) return;
    int nt = g.ntiles(cur);
    typedef typename AccT<I8>::type acc_t;
    acc_t acc[2][2][4][2];
#pragma unroll
    for (int a = 0; a < 2; ++a)
#pragma unroll
        for (int b = 0; b < 2; ++b)
#pragma unroll
            for (int m = 0; m < 4; ++m)
#pragma unroll
                for (int n = 0; n < 2; ++n) acc[a][b][m][n] = acc_t{};
    bf16x8 At[4][2], B0[2][2], B1[2][2];
    const char* cA = g.a_base(cur, tstep); const char* cB = g.b_base(cur, tstep);
    S.a_ready(cur);
    if constexpr (SP2) {
        PG8_STAGE(PG8_SB(0, 0), cB, voffB); PG8_STAGE(PG8_SB(0, 1), cB + hstep, voffB); PG8_STAGE(PG8_SA(0, 0), cA, voffA); PG8_STAGE(PG8_SA(0, 1), cA + hstep, voffA);
        if (wr == 1) PG8_BAR;
        PG8_WAIT_V(2); PG8_BAR;
        PG8_STAGE(PG8_SB(1, 0), cB + kstep, voffB); PG8_STAGE(PG8_SA(1, 0), cA + kstep, voffA); PG8_STAGE(PG8_SB(1, 1), cB + hstep + kstep, voffB);
        PG8_WAIT_V(6); PG8_BAR;
    } else {
        PG8_STAGE(PG8_SB(0, 0), cB, voffB); PG8_STAGE(PG8_SA(0, 0), cA, voffA); PG8_STAGE(PG8_SB(0, 1), cB + hstep, voffB); PG8_STAGE(PG8_SA(0, 1), cA + hstep, voffA);
        if (wr == 1) PG8_BAR;
        PG8_WAIT_V(4); PG8_BAR;
        PG8_STAGE(PG8_SB(1, 0), cB + kstep, voffB); PG8_STAGE(PG8_SA(1, 0), cA + kstep, voffA); PG8_STAGE(PG8_SB(1, 1), cB + hstep + kstep, voffB);
        PG8_WAIT_V(6); PG8_BAR;
    }
    for (;;) {
        const bool has_next = S.next(ui + 1, nxt);
        const char* nA = has_next ? g.a_base(nxt, tstep) : cA; const char* nB = has_next ? g.b_base(nxt, tstep) : cB;
        for (int t = 0; t < nt; t += 2) {
            const bool last = (t == nt - 2);
            const char* a1 = cA + (size_t)(t + 1) * kstep;
            const char* a2 = last ? nA : cA + (size_t)(t + 2) * kstep; const char* b2 = last ? nB : cB + (size_t)(t + 2) * kstep;
            const char* a3 = a2 + kstep; const char* b3 = b2 + kstep;
            if (last && has_next) S.a_ready(nxt);
            if constexpr (SP2) {
            PG8_LDB(B0, 0, 0); PG8_LDB(B1, 0, 1); PG8_SCHED; PG8_LDA(At, 0, 0); PG8_STAGE(PG8_SA(1, 1), a1 + hstep, voffA);
            PG8_WAIT_V(8); PG8_WAIT_L(0); PG8_BAR; PG8_MMA(0, 0, At, B0); PG8_MMA(0, 1, At, B1); PG8_BAR; PG8_SCHED;
            PG8_LDA(At, 0, 1); PG8_STAGE(PG8_SB(0, 0), b2, voffB); PG8_STAGE(PG8_SB(0, 1), b2 + hstep, voffB); PG8_STAGE(PG8_SA(0, 0), a2, voffA);
            PG8_WAIT_V(8); PG8_WAIT_L(0); PG8_BAR; PG8_MMA(1, 0, At, B0); PG8_MMA(1, 1, At, B1); PG8_BAR; PG8_SCHED;
            PG8_LDB(B0, 1, 0); PG8_LDB(B1, 1, 1); PG8_SCHED; PG8_LDA(At, 1, 0); PG8_STAGE(PG8_SA(0, 1), a2 + hstep, voffA);
            PG8_WAIT_V(8); PG8_WAIT_L(0); PG8_BAR; PG8_MMA(0, 0, At, B0); PG8_MMA(0, 1, At, B1); PG8_BAR; PG8_SCHED;
            PG8_LDA(At, 1, 1); PG8_STAGE(PG8_SB(1, 0), b3, voffB); PG8_STAGE(PG8_SB(1, 1), b3 + hstep, voffB); PG8_STAGE(PG8_SA(1, 0), a3, voffA);
            PG8_WAIT_V(8); PG8_WAIT_L(0); PG8_BAR; PG8_MMA(1, 0, At, B0); PG8_MMA(1, 1, At, B1); PG8_BAR; PG8_SCHED;
            } else {
            PG8_LDB(B0, 0, 0); PG8_SCHED; PG8_LDA(At, 0, 0); PG8_STAGE(PG8_SA(1, 1), a1 + hstep, voffA);
            PG8_WAIT_L(8); PG8_BAR; PG8_WAIT_L(0); PG8_MMA(0, 0, At, B0); PG8_BAR; PG8_SCHED;
            PG8_LDB(B1, 0, 1); PG8_STAGE(PG8_SB(0, 0), b2, voffB);
            PG8_BAR; PG8_WAIT_L(0); PG8_MMA(0, 1, At, B1); PG8_BAR;
            PG8_LDA(At, 0, 1); PG8_STAGE(PG8_SA(0, 0), a2, voffA);
            PG8_BAR; PG8_WAIT_L(0); PG8_MMA(1, 0, At, B0); PG8_BAR; PG8_SCHED;
            PG8_STAGE(PG8_SB(0, 1), b2 + hstep, voffB);
            PG8_WAIT_V(6); PG8_BAR; PG8_MMA(1, 1, At, B1); PG8_BAR;
            PG8_LDB(B0, 1, 0); PG8_SCHED; PG8_LDA(At, 1, 0); PG8_STAGE(PG8_SA(0, 1), a2 + hstep, voffA);
            PG8_WAIT_L(8); PG8_BAR; PG8_WAIT_L(0); PG8_MMA(0, 0, At, B0); PG8_BAR; PG8_SCHED;
            PG8_LDB(B1, 1, 1); PG8_STAGE(PG8_SB(1, 0), b3, voffB);
            PG8_BAR; PG8_WAIT_L(0); PG8_MMA(0, 1, At, B1); PG8_BAR;
            PG8_LDA(At, 1, 1); PG8_STAGE(PG8_SA(1, 0), a3, voffA);
            PG8_BAR; PG8_WAIT_L(0); PG8_MMA(1, 0, At, B0); PG8_BAR; PG8_SCHED;
            PG8_STAGE(PG8_SB(1, 1), b3 + hstep, voffB);
            PG8_WAIT_V(6); PG8_BAR; PG8_MMA(1, 1, At, B1); PG8_BAR;
            }
        }
        if constexpr (ALIGN_EPI) { if (wr == 0) PG8_BAR; }
        if constexpr (!Epi::AFTER_DRAIN) { E(acc, cur, wr, wc, fr, fq); S.done(cur); }
        if (!has_next) break;
        if (E.resets(cur)) {
#pragma unroll
        for (int a = 0; a < 2; ++a)
#pragma unroll
            for (int b = 0; b < 2; ++b)
#pragma unroll
                for (int m = 0; m < 4; ++m)
#pragma unroll
                    for (int n = 0; n < 2; ++n) acc[a][b][m][n] = acc_t{};
        }
        cur = nxt; cA = nA; cB = nB; ++ui; nt = g.ntiles(cur);
        if constexpr (ALIGN_EPI) { if (wr == 1) PG8_BAR; }
    }
    PG8_WAIT_V(0);
    if constexpr (!ALIGN_EPI) { if (wr == 0) PG8_BAR; }
    PG8_BAR;
    if constexpr (Epi::AFTER_DRAIN) { E.fused(acc, cur, wr, wc, fr, fq, lds, wid, lane); S.done(cur); }
#undef PG8_SA
#undef PG8_SB
#undef PG8_STAGE
#undef PG8_LDA
#undef PG8_LDB
#undef PG8_MMA
#undef PG8_WAIT_V
#undef PG8_WAIT_L
#undef PG8_BAR
#undef PG8_SCHED
}
}
namespace att {
typedef unsigned short bf16;
using bf16x8 = __attribute__((ext_vector_type(8))) short;
using s16x4  = __attribute__((ext_vector_type(4))) short;
using f32x16 = __attribute__((ext_vector_type(16))) float;
using u32x4  = __attribute__((ext_vector_type(4))) unsigned;
constexpr int D = 128, NW = 8, QBLK = 32, KVBLK = 64;
constexpr int SHM_V = KVBLK * D * 2, SHM_K = KVBLK * D * 2;
constexpr int OFF_WS = 2 * SHM_V + 2 * SHM_K, OFF_TBL = OFF_WS + NW * 64 * 4, SHM_ATTN = OFF_TBL + 4096;
constexpr float THR2 = 8.f;
constexpr float LOG2E = 1.4426950408889634f;
enum { M_NA = 0, M_DENSE = 1, M_ALIBI = 2, M_DIL = 3 };
#define KSWZ(row, colB) ((row) * 256 + ((colB) ^ (((row) & 7) << 4)))
#define SBAR() __builtin_amdgcn_sched_barrier(0)
__device__ __forceinline__ int crow(int r, int hi) { return (r & 3) + 8 * (r >> 2) + 4 * hi; }
__device__ __forceinline__ unsigned cvtpk(float lo, float hi) { unsigned r; asm volatile("v_cvt_pk_bf16_f32 %0, %1, %2" : "=v"(r) : "v"(lo), "v"(hi)); return r; }
__device__ __forceinline__ unsigned short f2bf1(float f) { unsigned u = __builtin_bit_cast(unsigned, f); return (unsigned short)((u + 0x7fffu + ((u >> 16) & 1u)) >> 16); }
__device__ __forceinline__ float bf2f(unsigned short h) { return __builtin_bit_cast(float, (unsigned)h << 16); }

__device__ __forceinline__ void partialSM(f32x16& p0, f32x16& p1, float& m_reg, float& mn, float& alpha) {
  float pmax = p0[0];
#pragma unroll
  for (int r = 1; r < 16; ++r) pmax = fmaxf(pmax, p0[r]);
#pragma unroll
  for (int r = 0; r < 16; ++r) pmax = fmaxf(pmax, p1[r]);
  { auto rr = __builtin_amdgcn_permlane32_swap(__float_as_uint(pmax), __float_as_uint(pmax), false, false);
    pmax = fmaxf(__uint_as_float(rr[0]), __uint_as_float(rr[1])); }
  if (__builtin_expect(__all(pmax - m_reg <= THR2), 1)) { mn = m_reg; alpha = 1.f; }
  else { mn = fmaxf(m_reg, pmax); alpha = __builtin_amdgcn_exp2f(m_reg - mn); m_reg = mn; }
#pragma unroll
  for (int r = 0; r < 16; ++r) p0[r] = p0[r] - mn;
#pragma unroll
  for (int r = 0; r < 16; ++r) p1[r] = p1[r] - mn;
#pragma unroll
  for (int r = 0; r < 16; ++r) p0[r] = __builtin_amdgcn_exp2f(p0[r]);
}
__device__ __forceinline__ void finishSM(f32x16& p0, f32x16& p1, float alpha, float& l_reg, bf16x8& pa0, bf16x8& pa1, bf16x8& pa2, bf16x8& pa3) {
#pragma unroll
  for (int r = 0; r < 16; ++r) p1[r] = __builtin_amdgcn_exp2f(p1[r]);
  float ps = 0;
#pragma unroll
  for (int r = 0; r < 16; ++r) ps += p0[r];
#pragma unroll
  for (int r = 0; r < 16; ++r) ps += p1[r];
  { auto rr = __builtin_amdgcn_permlane32_swap(__float_as_uint(ps), __float_as_uint(ps), false, false);
    ps = __uint_as_float(rr[0]) + __uint_as_float(rr[1]); }
  l_reg = l_reg * alpha + ps;
#define PK4(P, BASE, OUT) do { unsigned a0 = cvtpk(P[BASE + 0], P[BASE + 1]), a1 = cvtpk(P[BASE + 2], P[BASE + 3]);   \
    unsigned b0 = cvtpk(P[BASE + 4], P[BASE + 5]), b1 = cvtpk(P[BASE + 6], P[BASE + 7]);                              \
    auto r0 = __builtin_amdgcn_permlane32_swap(a0, b0, false, false); auto r1 = __builtin_amdgcn_permlane32_swap(a1, b1, false, false); \
    u32x4 w = {r0[0], r1[0], r0[1], r1[1]}; OUT = *reinterpret_cast<bf16x8*>(&w); } while (0)
  PK4(p0, 0, pa0); PK4(p0, 8, pa1); PK4(p1, 0, pa2); PK4(p1, 8, pa3);
#undef PK4
}
__device__ __forceinline__ void qkt(f32x16& p0, f32x16& p1, const bf16* Ks, const bf16x8* qr, int r32, int hi) {
  p0 = f32x16{}; p1 = f32x16{};
#pragma unroll
  for (int d0 = 0; d0 < 8; ++d0) { int cb = (d0 * 16 + hi * 8) * 2;
    bf16x8 b0 = *reinterpret_cast<const bf16x8*>((const char*)Ks + KSWZ(r32, cb));
    bf16x8 b1 = *reinterpret_cast<const bf16x8*>((const char*)Ks + KSWZ(32 + r32, cb));
    p0 = __builtin_amdgcn_mfma_f32_32x32x16_bf16(b0, qr[d0], p0, 0, 0, 0);
    p1 = __builtin_amdgcn_mfma_f32_32x32x16_bf16(b1, qr[d0], p1, 0, 0, 0); }
}
__device__ __forceinline__ int v_st(int k, int c) { const int kk = (k & ~0xC) | ((k & 4) << 1) | ((k & 8) >> 1); return ((kk >> 3) * 4 + (c >> 5)) * 512 + ((kk & 7) * 32 + (c & 31)) * 2; }
__device__ __forceinline__ int v_rd_base(int lane) { return ((lane & 3) << 3) | (((lane >> 2) & 3) << 6) | (((lane >> 4) & 1) << 5) | (((lane >> 5) & 1) << 8); }
constexpr int v_rd_off(int d0, int ks, int half) { return d0 * 512 + ks * 4096 + half * 2048; }
template <int OFF> __device__ __forceinline__ s16x4 tr_read(int vb) {
  s16x4 r; asm volatile("ds_read_b64_tr_b16 %0, %1 offset:%2" : "=&v"(r) : "v"(vb), "i"(OFF) : "memory"); return r;
}
template <int D0> __device__ __forceinline__ void pv_one(f32x16& od, int vb, bf16x8 pa0, bf16x8 pa1, bf16x8 pa2, bf16x8 pa3) {
  const s16x4 l0 = tr_read<v_rd_off(D0, 0, 0)>(vb), h0 = tr_read<v_rd_off(D0, 0, 1)>(vb), l1 = tr_read<v_rd_off(D0, 1, 0)>(vb), h1 = tr_read<v_rd_off(D0, 1, 1)>(vb);
  const s16x4 l2 = tr_read<v_rd_off(D0, 2, 0)>(vb), h2 = tr_read<v_rd_off(D0, 2, 1)>(vb), l3 = tr_read<v_rd_off(D0, 3, 0)>(vb), h3 = tr_read<v_rd_off(D0, 3, 1)>(vb);
  asm volatile("s_waitcnt lgkmcnt(0)" ::: "memory"); SBAR();
#define PK(L, H) (bf16x8){L[0], L[1], L[2], L[3], H[0], H[1], H[2], H[3]}
  od = __builtin_amdgcn_mfma_f32_32x32x16_bf16(pa0, PK(l0, h0), od, 0, 0, 0);
  od = __builtin_amdgcn_mfma_f32_32x32x16_bf16(pa1, PK(l1, h1), od, 0, 0, 0);
  od = __builtin_amdgcn_mfma_f32_32x32x16_bf16(pa2, PK(l2, h2), od, 0, 0, 0);
  od = __builtin_amdgcn_mfma_f32_32x32x16_bf16(pa3, PK(l3, h3), od, 0, 0, 0);
#undef PK
}
template <int D0> __device__ __forceinline__ void pv_one_lean(f32x16& od, int vb, bf16x8 pa0, bf16x8 pa1, bf16x8 pa2, bf16x8 pa3) {
#define PK(L, H) (bf16x8){L[0], L[1], L[2], L[3], H[0], H[1], H[2], H[3]}
  { const s16x4 l0 = tr_read<v_rd_off(D0, 0, 0)>(vb), h0 = tr_read<v_rd_off(D0, 0, 1)>(vb), l1 = tr_read<v_rd_off(D0, 1, 0)>(vb), h1 = tr_read<v_rd_off(D0, 1, 1)>(vb);
    asm volatile("s_waitcnt lgkmcnt(0)" ::: "memory"); SBAR();
    od = __builtin_amdgcn_mfma_f32_32x32x16_bf16(pa0, PK(l0, h0), od, 0, 0, 0);
    od = __builtin_amdgcn_mfma_f32_32x32x16_bf16(pa1, PK(l1, h1), od, 0, 0, 0); }
  { const s16x4 l2 = tr_read<v_rd_off(D0, 2, 0)>(vb), h2 = tr_read<v_rd_off(D0, 2, 1)>(vb), l3 = tr_read<v_rd_off(D0, 3, 0)>(vb), h3 = tr_read<v_rd_off(D0, 3, 1)>(vb);
    asm volatile("s_waitcnt lgkmcnt(0)" ::: "memory"); SBAR();
    od = __builtin_amdgcn_mfma_f32_32x32x16_bf16(pa2, PK(l2, h2), od, 0, 0, 0);
    od = __builtin_amdgcn_mfma_f32_32x32x16_bf16(pa3, PK(l3, h3), od, 0, 0, 0); }
#undef PK
}
__device__ __forceinline__ void pv_d0_lean(f32x16* o, int vb, bf16x8 pa0, bf16x8 pa1, bf16x8 pa2, bf16x8 pa3) {
  pv_one_lean<0>(o[0], vb, pa0, pa1, pa2, pa3); pv_one_lean<1>(o[1], vb, pa0, pa1, pa2, pa3); pv_one_lean<2>(o[2], vb, pa0, pa1, pa2, pa3); pv_one_lean<3>(o[3], vb, pa0, pa1, pa2, pa3);
}
__device__ __forceinline__ void pv_d0(f32x16* o, int vb, bf16x8 pa0, bf16x8 pa1, bf16x8 pa2, bf16x8 pa3) {
  pv_one<0>(o[0], vb, pa0, pa1, pa2, pa3); pv_one<1>(o[1], vb, pa0, pa1, pa2, pa3); pv_one<2>(o[2], vb, pa0, pa1, pa2, pa3); pv_one<3>(o[3], vb, pa0, pa1, pa2, pa3);
}

struct UA {
  const bf16* Q; long ldq;
  const bf16* K; const bf16* V; long ldk;
  int NT;
  int j0;
  int qk0;
  float slope2;
  int qrow0, krow0;
  const float* tbl;
  bf16* Y; long ldy; const bf16* Z; long ldz;
  float* O; long ldo;
  float* L; long ldl;
};

template <int MODE, int SDEPTH>
__device__ __forceinline__ void attn_unit(const UA& a, char* lds, const int wave_in) {
  int tid_ = fresh_tid(wave_in); asm volatile("" : "+v"(tid_));
  const int tid = tid_, wid = __builtin_amdgcn_readfirstlane(tid >> 6), lane = tid & 63, r32 = lane & 31, hi = lane >> 5;
  bf16* V_lds = (bf16*)lds; bf16* K_lds = (bf16*)(lds + 2 * SHM_V);
  float* ws = (float*)(lds + OFF_WS) + wid * 64; float* li_l = ws; float* al_l = ws + 32;
  float* tbl = (float*)(lds + OFF_TBL) + 64;
  if (MODE == M_NA) { __syncthreads(); for (int i = tid; i < 15 * 31; i += 512) tbl[i] = a.tbl[i] * LOG2E; }
  float m_reg = -1e30f, l_reg = 0; f32x16 o[4] = {}; bf16x8 qr[8];
  const bf16* Qw = a.Q + (long)(wid * QBLK + r32) * a.ldq + hi * 8;
#pragma unroll
  for (int d0 = 0; d0 < 8; ++d0) qr[d0] = *reinterpret_cast<const bf16x8*>(Qw + d0 * 16);
  const int sr = tid >> 4, sc = (tid & 15) * 8, vst0 = v_st(sr, sc), vst1 = v_st(32 + sr, sc);
  const int vb0 = (int)(uintptr_t)V_lds + v_rd_base(lane);
  const bf16* Kh = a.K; const bf16* Vh = a.V; const long LDK = a.ldk;
  struct { bf16x8 vs0, vs1, ks0, ks1; } sr_[SDEPTH];
#define SLOAD(i, k0) do { sr_[i].vs0 = *reinterpret_cast<const bf16x8*>(&Vh[(long)((k0) + sr) * LDK + sc]); sr_[i].vs1 = *reinterpret_cast<const bf16x8*>(&Vh[(long)((k0) + 32 + sr) * LDK + sc]); \
    sr_[i].ks0 = *reinterpret_cast<const bf16x8*>(&Kh[(long)((k0) + sr) * LDK + sc]); sr_[i].ks1 = *reinterpret_cast<const bf16x8*>(&Kh[(long)((k0) + 32 + sr) * LDK + sc]); } while (0)
#define SWRITE(b, i) do { *(bf16x8*)((char*)V_lds + (b) * SHM_V + vst0) = sr_[i].vs0;          \
    *(bf16x8*)((char*)V_lds + (b) * SHM_V + vst1) = sr_[i].vs1; int kc = sc * 2;               \
    *(bf16x8*)((char*)K_lds + (b) * SHM_K + KSWZ(sr, kc)) = sr_[i].ks0;                       \
    *(bf16x8*)((char*)K_lds + (b) * SHM_K + KSWZ(32 + sr, kc)) = sr_[i].ks1; } while (0)
#define SWAIT() do { if constexpr (SDEPTH == 2) asm volatile("s_waitcnt vmcnt(4)" ::: "memory"); else asm volatile("s_waitcnt vmcnt(0)" ::: "memory"); } while (0)
#define RESC(a_) do { if (__any((a_) < 1.f)) { if (hi == 0) al_l[r32] = (a_); asm volatile("s_waitcnt lgkmcnt(0)" ::: "memory"); \
    _Pragma("unroll") for (int d = 0; d < 4; ++d) _Pragma("unroll") for (int r = 0; r < 16; ++r) o[d][r] *= al_l[crow(r, hi)]; } } while (0)
  const float NEG_INF = -__builtin_inff();
  const int qkrel = a.qk0 + wid * 32 + r32 - 4 * hi;
  const float nslope = -a.slope2;
  const int qgr = a.qrow0 + (wid >> 1), cq = 32 * (wid & 1) + r32;
  const int c0 = min(max(cq - 8, 0), 48), r0 = min(max(qgr - 4, 0), 56);
#define MOD(P0, P1, J) do { \
    if (MODE == M_ALIBI || MODE == M_DIL) { const float rel = (float)(qkrel - (J) * 64); \
      _Pragma("unroll") for (int r = 0; r < 16; ++r) { const float cr = (float)((r & 3) + 8 * (r >> 2)); const float d0_ = fabsf(rel - cr), d1_ = fabsf(rel - cr - 32.f); \
        float v0_ = fmaf(nslope, d0_, P0[r]), v1_ = fmaf(nslope, d1_, P1[r]); \
        if (MODE == M_DIL) { v0_ = (d0_ <= 64.f) ? v0_ : NEG_INF; v1_ = (d1_ <= 64.f) ? v1_ : NEG_INF; } \
        P0[r] = v0_; P1[r] = v1_; } } \
    if (MODE == M_NA) { const int kr = a.krow0 + (J); const bool rv = (kr >= r0) && (kr < r0 + 8); \
      if (!rv) { _Pragma("unroll") for (int r = 0; r < 16; ++r) { P0[r] = NEG_INF; P1[r] = NEG_INF; } } \
      else { const float* tp = tbl + (kr - qgr + 7) * 31 + (4 * hi - cq + 15); const int kcb = 4 * hi - c0; \
        _Pragma("unroll") for (int r = 0; r < 16; ++r) { const int cr = (r & 3) + 8 * (r >> 2); \
          const bool ok0 = (unsigned)(kcb + cr) < 16u, ok1 = (unsigned)(kcb + cr + 32) < 16u; \
          const float b0_ = tp[cr], b1_ = tp[cr + 32]; \
          P0[r] = ok0 ? P0[r] + b0_ : NEG_INF; P1[r] = ok1 ? P1[r] + b1_ : NEG_INF; } } } \
  } while (0)
  f32x16 pA0, pA1, pB0, pB1; float mnA, mnB, alA, alB; bf16x8 pa0, pa1, pa2, pa3; const int NT = a.NT;
  constexpr int SE = 0, SO = SDEPTH - 1;
  SLOAD(SE, 0); asm volatile("s_waitcnt vmcnt(0)" ::: "memory"); SWRITE(0, SE); __syncthreads();
  qkt(pA0, pA1, K_lds, qr, r32, hi); MOD(pA0, pA1, 0); partialSM(pA0, pA1, m_reg, mnA, alA);
  SLOAD(SO, KVBLK); if constexpr (SDEPTH == 2) { if (2 < NT) SLOAD(SE, 2 * KVBLK); }
  SWAIT(); SWRITE(1, SO); __syncthreads();
  for (int j = 1; j + 1 < NT; j += 2) {
    SBAR(); qkt(pB0, pB1, (bf16*)((char*)K_lds + SHM_K), qr, r32, hi); MOD(pB0, pB1, j);
    finishSM(pA0, pA1, alA, l_reg, pa0, pa1, pa2, pa3); SBAR();
    SLOAD(SO, (j + SDEPTH) * KVBLK); SBAR();
    pv_d0(o, vb0, pa0, pa1, pa2, pa3); partialSM(pB0, pB1, m_reg, mnB, alB);
    __syncthreads(); SWAIT(); SWRITE(0, SE);
    RESC(alB); __syncthreads();
    SBAR(); qkt(pA0, pA1, K_lds, qr, r32, hi); MOD(pA0, pA1, j + 1);
    finishSM(pB0, pB1, alB, l_reg, pa0, pa1, pa2, pa3); SBAR();
    if (SDEPTH == 1 || j + 3 < NT) SLOAD(SE, (j + 1 + SDEPTH) * KVBLK); SBAR();
    pv_d0(o, vb0 + (int)SHM_V, pa0, pa1, pa2, pa3); partialSM(pA0, pA1, m_reg, mnA, alA);
    __syncthreads(); SWAIT(); SWRITE(1, SO);
    RESC(alA); __syncthreads();
  }
  SBAR(); qkt(pB0, pB1, (bf16*)((char*)K_lds + SHM_K), qr, r32, hi); MOD(pB0, pB1, NT - 1);
  finishSM(pA0, pA1, alA, l_reg, pa0, pa1, pa2, pa3); SBAR();
  pv_d0(o, vb0, pa0, pa1, pa2, pa3); partialSM(pB0, pB1, m_reg, mnB, alB);
  __syncthreads(); RESC(alB);
  finishSM(pB0, pB1, alB, l_reg, pa0, pa1, pa2, pa3); SBAR();
  pv_d0(o, vb0 + (int)SHM_V, pa0, pa1, pa2, pa3);
  if (hi == 0) li_l[r32] = l_reg; asm volatile("s_waitcnt lgkmcnt(0)" ::: "memory");
  float rli[16];
#pragma unroll
  for (int r = 0; r < 16; ++r) rli[r] = __builtin_amdgcn_rcpf(li_l[crow(r, hi)]);
  if (MODE == M_NA || MODE == M_DENSE) {
#pragma unroll
    for (int r = 0; r < 16; ++r) { const long orow = wid * QBLK + crow(r, hi);
#pragma unroll
      for (int d0 = 0; d0 < 4; ++d0) { const float z = bf2f(a.Z[orow * a.ldz + d0 * 32 + r32]); a.Y[orow * a.ldy + d0 * 32 + r32] = f2bf1(o[d0][r] * rli[r] * z); } }
  } else {
#pragma unroll
    for (int r = 0; r < 16; ++r) { const long orow = wid * QBLK + crow(r, hi);
#pragma unroll
      for (int d0 = 0; d0 < 4; ++d0) a.O[orow * a.ldo + d0 * 32 + r32] = o[d0][r] * rli[r]; }
    if (MODE == M_DIL) { if (hi == 0) a.L[(long)(wid * QBLK + r32) * a.ldl] = m_reg + __builtin_amdgcn_logf(l_reg); }
  }
#undef SLOAD
#undef SWRITE
#undef SWAIT
#undef RESC
#undef MOD
}

#define ATT_LAS __attribute__((address_space(3)))
#ifndef PINGPONG_SPLIT
#define PINGPONG_SPLIT 4
#endif
template <int MODE, int NVH>
__device__ __forceinline__ void attn_unit_dma(const UA& a, char* lds, int wsoff, const int wave_in) {
  int tid_ = fresh_tid(wave_in); asm volatile("" : "+v"(tid_));
  const int tid = tid_, wid = __builtin_amdgcn_readfirstlane(tid >> 6), lane = tid & 63, r32 = lane & 31, hi = lane >> 5;
  constexpr int KB = 16384, VB = NVH * 16384, OFF_V2 = 2 * KB;
  char* K_lds = lds;
  float* ws = (float*)(lds + wsoff) + wid * 64; float* li_l = ws; float* al_l = ws + 32;
  float* tbl = (float*)(lds + wsoff + 2048) + 64;
  if (MODE == M_NA) { for (int i = tid; i < 15 * 31; i += 512) tbl[i] = a.tbl[i] * LOG2E; }
  float m_reg = -1e30f, l_reg = 0; f32x16 o[4 * NVH]; bf16x8 qr[8];
#pragma unroll
  for (int d = 0; d < 4 * NVH; ++d) o[d] = f32x16{};
  const bf16* Qw = a.Q + (long)(wid * QBLK + r32) * a.ldq + hi * 8;
#pragma unroll
  for (int d0 = 0; d0 < 8; ++d0) qr[d0] = *reinterpret_cast<const bf16x8*>(Qw + d0 * 16);
  const int vb0 = (int)(uintptr_t)(lds + OFF_V2) + v_rd_base(lane);
  const unsigned ldkb = (unsigned)(a.ldk * 2);
  unsigned koff[2], voff[2 * NVH];
#pragma unroll
  for (int i = 0; i < 2; ++i) { const int row = (wid * 2 + i) * 4 + (lane >> 4), c = (lane & 15) ^ (row & 7); koff[i] = (unsigned)row * ldkb + (unsigned)c * 16u; }
#pragma unroll
  for (int i = 0; i < 2 * NVH; ++i) { const int vb = wid * 2 * NVH + i, half = vb >> 4, b = (vb & 15) * 1024 + lane * 16;
    const int sub = b >> 9, e = (b & 511) >> 1, kk = (sub >> 2) * 8 + (e >> 5), c = (sub & 3) * 32 + (e & 31);
    const int k = (kk & ~0xC) | ((kk & 4) << 1) | ((kk & 8) >> 1);
    voff[i] = (unsigned)k * ldkb + (unsigned)(half * 128 + c) * 2u; }
  const char* Kb = (const char*)a.K; const char* Vb = (const char*)a.V; const size_t tstep = (size_t)KVBLK * ldkb;
  ATT_LAS unsigned char* ldl = (ATT_LAS unsigned char*)lds;
#define TROT(j) (((j) + a.j0 >= NT) ? (j) + a.j0 - NT : (j) + a.j0)
#define DMA(j, ks, vs) do { const int jt_ = TROT(j); const char* kt_ = Kb + (size_t)jt_ * tstep; const char* vt_ = Vb + (size_t)jt_ * tstep; \
    _Pragma("unroll") for (int i_ = 0; i_ < 2; ++i_) __builtin_amdgcn_global_load_lds((const unsigned*)(kt_ + koff[i_]), (ATT_LAS unsigned*)(ldl + (ks) * KB + (wid * 2 + i_) * 1024), 16, 0, 0); \
    _Pragma("unroll") for (int i_ = 0; i_ < 2 * NVH; ++i_) __builtin_amdgcn_global_load_lds((const unsigned*)(vt_ + voff[i_]), (ATT_LAS unsigned*)(ldl + OFF_V2 + (vs) * VB + (wid * 2 * NVH + i_) * 1024), 16, 0, 0); } while (0)
#define RESC(a_) do { if (__any((a_) < 1.f)) { if (hi == 0) al_l[r32] = (a_); asm volatile("s_waitcnt lgkmcnt(0)" ::: "memory"); \
    _Pragma("unroll") for (int d = 0; d < 4 * NVH; ++d) _Pragma("unroll") for (int r = 0; r < 16; ++r) o[d][r] *= al_l[crow(r, hi)]; } } while (0)
  const float NEG_INF = -__builtin_inff();
  const int qkrel = a.qk0 + wid * 32 + r32 - 4 * hi;
  const float nslope = -a.slope2;
  const int qgr = a.qrow0 + (wid >> 1), cq = 32 * (wid & 1) + r32;
  const int c0 = min(max(cq - 8, 0), 48), r0 = min(max(qgr - 4, 0), 56);
#define ROWOK(J) ((MODE == M_NA) ? ((a.krow0 + (J)) >= r0 && (a.krow0 + (J)) < r0 + 8) : (MODE == M_DIL) ? ((J) * 64 <= a.qk0 + wid * 32 + 95 && (J) * 64 + 127 >= a.qk0 + wid * 32) : true)
#define MOD(P0, P1, J) do { \
    if (MODE == M_ALIBI || MODE == M_DIL) { const float rel = (float)(qkrel - (J) * 64); \
      _Pragma("unroll") for (int r = 0; r < 16; ++r) { const float cr = (float)((r & 3) + 8 * (r >> 2)); const float d0_ = fabsf(rel - cr), d1_ = fabsf(rel - cr - 32.f); \
        float v0_ = fmaf(nslope, d0_, P0[r]), v1_ = fmaf(nslope, d1_, P1[r]); \
        if (MODE == M_DIL) { v0_ = (d0_ <= 64.f) ? v0_ : NEG_INF; v1_ = (d1_ <= 64.f) ? v1_ : NEG_INF; } \
        P0[r] = v0_; P1[r] = v1_; } } \
    if (MODE == M_NA) { const int kr = a.krow0 + (J); const float* tp = tbl + (kr - qgr + 7) * 31 + (4 * hi - cq + 15); const int kcb = 4 * hi - c0; \
      _Pragma("unroll") for (int r = 0; r < 16; ++r) { const int cr = (r & 3) + 8 * (r >> 2); \
        const bool ok0 = (unsigned)(kcb + cr) < 16u, ok1 = (unsigned)(kcb + cr + 32) < 16u; \
        const float b0_ = tp[cr], b1_ = tp[cr + 32]; \
        P0[r] = ok0 ? P0[r] + b0_ : NEG_INF; P1[r] = ok1 ? P1[r] + b1_ : NEG_INF; } } \
  } while (0)
  f32x16 p0, p1; float mn, al; bf16x8 pa0, pa1, pa2, pa3; const int NT = a.NT;
#define TOP(j, ks, vs) do { asm volatile("s_waitcnt vmcnt(0)" ::: "memory");        \
    __builtin_amdgcn_s_barrier(); asm volatile("" ::: "memory");                    \
    if ((j) + 1 < NT) DMA((j) + 1, (ks) ^ 1, ((vs) == 2) ? 0 : (vs) + 1); } while (0)
#define QKSM(j, ks) do { SBAR(); qkt(p0, p1, (const bf16*)(K_lds + (ks) * KB), qr, r32, hi); MOD(p0, p1, TROT(j)); \
    partialSM(p0, p1, m_reg, mn, al); RESC(al); finishSM(p0, p1, al, l_reg, pa0, pa1, pa2, pa3); SBAR(); } while (0)
#define PVS(vs) do { _Pragma("unroll") for (int h = 0; h < NVH; ++h) { if (NVH == 2) pv_d0_lean(o + 4 * h, vb0 + (vs) * VB + h * 16384, pa0, pa1, pa2, pa3); else pv_d0(o + 4 * h, vb0 + (vs) * VB + h * 16384, pa0, pa1, pa2, pa3); } } while (0)
  DMA(0, 0, 0);
  if (wid < PINGPONG_SPLIT) {
    int vs = 0;
    for (int j = 0; j < NT; ++j) { const int ks = j & 1;
      TOP(j, ks, vs); if (ROWOK(TROT(j))) { QKSM(j, ks); PVS(vs); }
      vs = (vs == 2) ? 0 : vs + 1; }
  } else {
    int vs = 0, vprev = 0; bool pend = false;
    for (int j = 0; j < NT; ++j) { const int ks = j & 1;
      TOP(j, ks, vs); if (pend) PVS(vprev); pend = ROWOK(TROT(j)); if (pend) QKSM(j, ks);
      vprev = vs; vs = (vs == 2) ? 0 : vs + 1; }
    if (pend) PVS(vprev);
  }
  if (hi == 0) li_l[r32] = l_reg; asm volatile("s_waitcnt lgkmcnt(0)" ::: "memory");
  float rli[16];
#pragma unroll
  for (int r = 0; r < 16; ++r) rli[r] = __builtin_amdgcn_rcpf(li_l[crow(r, hi)]);
  if (MODE == M_DENSE || MODE == M_NA) {
#pragma unroll
    for (int r = 0; r < 16; ++r) { const long orow = wid * QBLK + crow(r, hi);
#pragma unroll
      for (int d0 = 0; d0 < 4 * NVH; ++d0) { const float z = bf2f(a.Z[orow * a.ldz + d0 * 32 + r32]); a.Y[orow * a.ldy + d0 * 32 + r32] = f2bf1(o[d0][r] * rli[r] * z); } }
  } else {
#pragma unroll
    for (int r = 0; r < 16; ++r) { const long orow = wid * QBLK + crow(r, hi);
#pragma unroll
      for (int d0 = 0; d0 < 4 * NVH; ++d0) a.O[orow * a.ldo + d0 * 32 + r32] = o[d0][r] * rli[r]; }
    if (MODE == M_DIL) { if (hi == 0) a.L[(long)(wid * QBLK + r32) * a.ldl] = m_reg + __builtin_amdgcn_logf(l_reg); }
  }
  __builtin_amdgcn_s_barrier(); asm volatile("" ::: "memory");
#undef DMA
#undef RESC
#undef MOD
#undef TOP
#undef QKSM
#undef PVS
#undef ROWOK
#undef TROT
}
#undef KSWZ
#undef SBAR
}
constexpr int NWAVES = 8;
#ifndef MK_ONE_LAUNCH
#define MK_ONE_LAUNCH 1
#endif
constexpr bool ONE_LAUNCH = MK_ONE_LAUNCH != 0;

constexpr int DM = 4096, NB = 2, SEQ = 4096, DEPTH = 2, HD = 128, GRID_W = 64;
constexpr int M = NB * SEQ;
constexpr int LDP = 32256;
constexpr float RMS_EPS = 1e-6f;
constexpr float QSCALE = 0.08838834764831845f * 1.4426950408889634f;
constexpr int CA_Q = 0, CA_K = 1024, CA_V = 2048, CA_Z = 3072;
constexpr int CB_Q = 4096, CB_K = 5120, CB_V = 5376, CB_Z = 5632;
constexpr int CC_Q = 6656, CC_K = 7680, CC_V = 8704, CC_Z = 9728;
constexpr int CD_Q = 10752, CD_K = 12288, CD_V = 13824, CD_Z = 15360;
constexpr int CG = 15872;

constexpr size_t MiB = 1u << 20;
constexpr size_t WS_CTL = 0, CTL_ZERO_BYTES = 1 * MiB;
constexpr int PK = DM + 64, PY = 1024 + 64;
constexpr size_t WS_WIN = 2 * MiB, WIN_LAYER = 256 * MiB;
constexpr size_t WBR_BLOCK = 9 * MiB;
constexpr size_t WS_WBR = WS_WIN + 2 * WIN_LAYER, WBR_LAYER = 4 * WBR_BLOCK;
constexpr size_t WS_WOUT = WS_WBR + 2 * WBR_LAYER, WOUT_LAYER = 33 * MiB;
constexpr size_t WS_XN = WS_WOUT + 2 * WOUT_LAYER;
constexpr size_t WS_PROJ = WS_XN + 66 * MiB;
constexpr size_t WS_OC = WS_PROJ + 504 * MiB;
constexpr size_t WS_OD = WS_OC + 64 * MiB;
constexpr size_t WS_LSE = WS_OD + 48 * MiB;
constexpr size_t Y_BLOCK = 17 * MiB;
constexpr size_t WS_YA = WS_LSE + 1 * MiB, WS_YB = WS_YA + Y_BLOCK, WS_YC = WS_YB + Y_BLOCK, WS_YD = WS_YC + Y_BLOCK;
constexpr size_t WS_MG = WS_YD + Y_BLOCK;
constexpr size_t WS_X1 = WS_MG + 66 * MiB;
constexpr int P8 = DM + 128;
constexpr size_t WS_XN8 = WS_X1 + 128 * MiB;
constexpr size_t WS_SA = WS_XN8 + 33 * MiB;
constexpr int N8 = 110 * 256;
constexpr size_t WS_WG8 = WS_SA + 1 * MiB, WG8_LAYER = 114 * MiB;
constexpr size_t WS_SB = WS_WG8 + 2 * WG8_LAYER;
constexpr size_t WS_MG8 = WS_SB + 1 * MiB;
constexpr size_t WS_SM = WS_MG8 + 33 * MiB;
constexpr size_t WS_WO8 = WS_SM + 1 * MiB, WO8_LAYER = 17 * MiB;
constexpr size_t WS_SO = WS_WO8 + 2 * WO8_LAYER;
constexpr size_t WS_END = WS_SO + 1 * MiB;
static_assert((size_t)DM * P8 <= WO8_LAYER, "d_ws map (int8 w_out)");
static_assert((size_t)M * P8 <= 33 * MiB && (size_t)N8 * P8 <= WG8_LAYER && (size_t)2 * N8 * 4 <= 1 * MiB, "d_ws map (int8)");
static_assert((size_t)LDP * PK * 2 <= WIN_LAYER && (size_t)DM * PY * 2 <= WBR_BLOCK && (size_t)DM * PK * 2 <= WOUT_LAYER && (size_t)M * PK * 2 <= 66 * MiB && (size_t)M * PY * 2 <= Y_BLOCK, "d_ws map");
constexpr int CW_BAR = 4096;

constexpr int RING_OFF = 0, RING_BYTES = 131072;
constexpr int LDSCTL_OFF = RING_BYTES, MISC_OFF = LDSCTL_OFF + 320;
constexpr int XTAB_OFF = RING_BYTES + 1024;
constexpr int LDS_BYTES = 147456;
static_assert(att::SHM_ATTN <= RING_BYTES, "attention scratch fits the ring region");

#define LAS __attribute__((address_space(3)))
typedef unsigned short bf16;
typedef unsigned v4u __attribute__((ext_vector_type(4)));
typedef unsigned v2u __attribute__((ext_vector_type(2)));
typedef float f32x4 __attribute__((ext_vector_type(4)));
#define LDS_WAIT() asm volatile("s_waitcnt lgkmcnt(0)" ::: "memory")
__device__ __forceinline__ unsigned f2bf(float f) { unsigned u = __builtin_bit_cast(unsigned, f); return (u + 0x7fffu + ((u >> 16) & 1u)) >> 16; }
__device__ __forceinline__ unsigned pk2(float lo, float hi) { return f2bf(lo) | (f2bf(hi) << 16); }
__device__ __forceinline__ float bflo(unsigned w) { return __builtin_bit_cast(float, w << 16); }
__device__ __forceinline__ float bfhi(unsigned w) { return __builtin_bit_cast(float, w & 0xffff0000u); }
#define XB_TMO      128
#define XB_XCNT(j)  (256  + 64 * (j))
#define XB_XSUB(j)  (1280 + 64 * (j))
#define XB_XGEN(j)  (2304 + 64 * (j))
#define XB_TOP      3328
#define XB_TOPGEN   3392
#define XCD_BAR_WORDS 3456
#define XB_SPIN_CAP (1u << 22)

__device__ __forceinline__ unsigned xb_ld(unsigned* p)              { return __hip_atomic_load(p, __ATOMIC_RELAXED, __HIP_MEMORY_SCOPE_AGENT); }
__device__ __forceinline__ unsigned xb_add(unsigned* p, unsigned v) { return __hip_atomic_fetch_add(p, v, __ATOMIC_RELAXED, __HIP_MEMORY_SCOPE_AGENT); }
__device__ __forceinline__ unsigned xb_xcc_id() { return (unsigned)__builtin_amdgcn_s_getreg((3 << 11) | 20) & 0xFu; }
#define XB_SPIN(cond, bar) do { unsigned _sp = 0; while (cond) { __builtin_amdgcn_s_sleep(1); \
    if ((++_sp & 255u) == 0u) { if (xb_ld(&(bar)[XB_TMO])) break; if (_sp > XB_SPIN_CAP) { atomicAdd(&(bar)[XB_TMO], 1u); break; } } } } while (0)

struct XcdBarrier {
    unsigned* bar; unsigned x;
    volatile LAS unsigned* st;
};

__device__ __forceinline__ XcdBarrier xcd_barrier_post(unsigned* bar, volatile LAS unsigned* st) {
    XcdBarrier b; b.bar = bar; b.x = xb_xcc_id(); b.st = st;
    if (threadIdx.x == 0) (void)xb_add(&bar[XB_XCNT(b.x)], 1u);
    return b;
}
__device__ __forceinline__ void xcd_barrier_complete(unsigned* bar, unsigned x, unsigned& nloc, unsigned& nx) {
    const unsigned G = gridDim.x * gridDim.y * gridDim.z;
    unsigned sum, cnt, mine, sp = 0u;
    for (;;) {
        sum = 0u; cnt = 0u; mine = 0u;
#pragma unroll 1
        for (unsigned j = 0; j < 16; ++j) { const unsigned c = xb_ld(&bar[XB_XCNT(j)]); sum += c; cnt += (c > 0u) ? 1u : 0u; mine = (j == x) ? c : mine; }
        if (sum == G) break;
        __builtin_amdgcn_s_sleep(1);
        if ((++sp & 255u) == 0u) { if (xb_ld(&bar[XB_TMO])) break; if (sp > XB_SPIN_CAP) { atomicAdd(&bar[XB_TMO], 1u); break; } }
    }
    nloc = mine > 0u ? mine : 1u; nx = cnt > 0u ? cnt : 1u;
}

__device__ __noinline__ void xcd_barrier(const XcdBarrier b, const bool leader  ) {
    asm volatile("s_waitcnt vmcnt(0)" ::: "memory");
    __syncthreads();
    if (leader) {
        unsigned* bar = b.bar;
        __builtin_amdgcn_s_waitcnt(0);
        unsigned nloc = b.st[0], nx = b.st[1];
        if (nloc == 0u) { xcd_barrier_complete(bar, b.x, nloc, nx); b.st[0] = nloc; b.st[1] = nx; }
        const unsigned old = xb_add(&bar[XB_XSUB(b.x)], 1u);
        const unsigned gen = old / nloc;
        if (old + 1u == (gen + 1u) * nloc) {
            __builtin_amdgcn_fence(__ATOMIC_RELEASE, "agent");
            asm volatile("s_waitcnt vmcnt(0)" ::: "memory");
            const unsigned og = xb_add(&bar[XB_TOP], 1u);
            const unsigned tg = og / nx;
            if (og + 1u == (tg + 1u) * nx) xb_add(&bar[XB_TOPGEN], 1u);
            else XB_SPIN(xb_ld(&bar[XB_TOPGEN]) == tg, bar);
            __builtin_amdgcn_fence(__ATOMIC_ACQUIRE, "agent");
            xb_add(&bar[XB_XGEN(b.x)], 1u);
            asm volatile("s_waitcnt vmcnt(0)" ::: "memory");
        } else {
            XB_SPIN(xb_ld(&bar[XB_XGEN(b.x)]) == gen, bar);
            __builtin_amdgcn_fence(__ATOMIC_ACQUIRE, "agent");
            asm volatile("s_waitcnt vmcnt(0)" ::: "memory");
        }
    }
    __syncthreads();
}
struct Frame {
    LAS unsigned char* lds;
    volatile LAS unsigned* MISC;
    unsigned* ctl;
    int tid, lane, wave;
    int vcu, G;
};
__device__ __forceinline__ float wave_sum(float v, const int lane) {
#pragma unroll
    for (int o = 1; o < 64; o <<= 1) v += __builtin_bit_cast(float, __builtin_amdgcn_ds_bpermute((lane ^ o) << 2, __builtin_bit_cast(int, v)));
    return v;
}
__device__ __forceinline__ float wave_max(float v, const int lane) {
#pragma unroll
    for (int o = 1; o < 64; o <<= 1) v = fmaxf(v, __builtin_bit_cast(float, __builtin_amdgcn_ds_bpermute((lane ^ o) << 2, __builtin_bit_cast(int, v))));
    return v;
}
__device__ __forceinline__ unsigned q8(float a, float b, float c, float d, float inv) {
    const int qa = (int)__builtin_rintf(a * inv), qb = (int)__builtin_rintf(b * inv), qc = (int)__builtin_rintf(c * inv), qd = (int)__builtin_rintf(d * inv);
    return (unsigned)(qa & 255) | ((unsigned)(qb & 255) << 8) | ((unsigned)(qc & 255) << 16) | ((unsigned)(qd & 255) << 24);
}
__device__ __forceinline__ void p0_transpose_item(const float* W, int K, int N, bf16* WT, int ldt, LAS float* scr, int item, int lane, int noff = 0, int ncols = 0) {
    const int nblk = (ncols ? ncols : N) / 32, kb = item / nblk, nb = item % nblk, k0 = 64 * kb, n0 = noff + 32 * nb;
    float v[32];
#pragma unroll
    for (int i = 0; i < 32; ++i) { const int kk = 2 * i + (lane >> 5); v[i] = __builtin_nontemporal_load(W + (size_t)(k0 + kk) * N + n0 + (lane & 31)); }
#pragma unroll
    for (int i = 0; i < 32; ++i) { const int kk = 2 * i + (lane >> 5); scr[kk * 33 + (lane & 31)] = v[i]; }
    LDS_WAIT(); asm volatile("" ::: "memory");
    const int c = lane & 7;
#pragma unroll
    for (int j = 0; j < 4; ++j) { const int n = (lane >> 3) + 8 * j; const LAS float* s = scr + (8 * c) * 33 + n;
        v4u o; o.x = pk2(s[0 * 33], s[1 * 33]); o.y = pk2(s[2 * 33], s[3 * 33]); o.z = pk2(s[4 * 33], s[5 * 33]); o.w = pk2(s[6 * 33], s[7 * 33]);
        *(v4u*)(WT + (size_t)(n0 + n) * ldt + k0 + 8 * c) = o; }
    LDS_WAIT(); asm volatile("" ::: "memory");
}
__device__ __forceinline__ void rms_row_to_bf16(const float* xrow, const float* g, bf16* orow, unsigned* qrow, float* sa_row, int lane) {
    const f32x4* xr = (const f32x4*)xrow + lane; const f32x4* gr = (const f32x4*)g + lane;
    f32x4 v[16]; float s = 0.f;
#pragma unroll
    for (int j = 0; j < 16; ++j) { v[j] = xr[64 * j]; s += (v[j].x * v[j].x + v[j].y * v[j].y) + (v[j].z * v[j].z + v[j].w * v[j].w); }
    const float rstd = 1.0f / sqrtf(wave_sum(s, lane) * (1.f / DM) + RMS_EPS);
    v2u* o8 = (v2u*)orow + lane; float mx = 0.f;
#pragma unroll
    for (int j = 0; j < 16; ++j) { const f32x4 gg = gr[64 * j]; v[j].x *= rstd * gg.x; v[j].y *= rstd * gg.y; v[j].z *= rstd * gg.z; v[j].w *= rstd * gg.w;
        mx = fmaxf(fmaxf(mx, fmaxf(fabsf(v[j].x), fabsf(v[j].y))), fmaxf(fabsf(v[j].z), fabsf(v[j].w)));
        v2u w; w.x = pk2(v[j].x, v[j].y); w.y = pk2(v[j].z, v[j].w); o8[64 * j] = w; }
    mx = fmaxf(wave_max(mx, lane), 1e-30f);
    const float inv = 127.0f / mx;
#pragma unroll
    for (int j = 0; j < 16; ++j) qrow[lane + 64 * j] = q8(v[j].x, v[j].y, v[j].z, v[j].w, inv);
    if (lane == 0) *sa_row = mx * (1.0f / 127.0f);
}
__device__ __forceinline__ void quant_row16(const bf16* wrow, unsigned* qrow, float* sc, int lane) {
    v4u w[8]; float mx = 0.f;
#pragma unroll
    for (int j = 0; j < 8; ++j) { w[j] = *((const v4u*)wrow + lane + 64 * j);
        mx = fmaxf(mx, fmaxf(fmaxf(fmaxf(fabsf(bflo(w[j].x)), fabsf(bfhi(w[j].x))), fmaxf(fabsf(bflo(w[j].y)), fabsf(bfhi(w[j].y)))), fmaxf(fmaxf(fabsf(bflo(w[j].z)), fabsf(bfhi(w[j].z))), fmaxf(fabsf(bflo(w[j].w)), fabsf(bfhi(w[j].w)))))); }
    mx = fmaxf(wave_max(mx, lane), 1e-30f);
    const float inv = 127.0f / mx;
#pragma unroll
    for (int j = 0; j < 8; ++j) { v2u o; o.x = q8(bflo(w[j].x), bfhi(w[j].x), bflo(w[j].y), bfhi(w[j].y), inv); o.y = q8(bflo(w[j].z), bfhi(w[j].z), bflo(w[j].w), bfhi(w[j].w), inv);
        *((v2u*)qrow + lane + 64 * j) = o; }
    if (lane == 0) *sc = mx * (1.0f / 127.0f);
}
struct Args;
template <class KPT> __device__ __forceinline__ void phase_prologue(Frame& F, KPT KP, unsigned char* ws) {
#define in_(i) ((const float*)(__attribute__((address_space(1))) const float*)(unsigned long long)KP->in[i])
    LAS float* scr = (LAS float*)(F.lds + RING_OFF + F.wave * 16384);
    const int gw = F.vcu * NWAVES + F.wave, NGW = F.G * NWAVES;
    constexpr int C16 = pg8::NT16 * 256, C16_OFF = 26 * 256;
    constexpr int I_IN = (DM / 64) * (C16 / 32), I_BR = (1024 / 64) * (DM / 32), I_BD = (512 / 64) * (DM / 32);
    constexpr int I_LAYER = I_IN + 3 * I_BR + I_BD;
    for (int it = gw; it < 2 * I_LAYER; it += NGW) {
        const int l = it / I_LAYER; int r = it % I_LAYER;
        bf16* wbr = (bf16*)(ws + WS_WBR + (size_t)l * WBR_LAYER);
        if (r < I_IN) { p0_transpose_item(in_(2) + (size_t)l * DM * LDP, DM, LDP, (bf16*)(ws + WS_WIN + (size_t)l * WIN_LAYER), PK, scr, r, F.lane, C16_OFF, C16); continue; } r -= I_IN;
        if (r < I_BR) { p0_transpose_item(in_(7) + (size_t)l * 1024 * DM, 1024, DM, wbr, PY, scr, r, F.lane); continue; } r -= I_BR;
        if (r < I_BR) { p0_transpose_item(in_(8) + (size_t)l * 1024 * DM, 1024, DM, wbr + 1 * (WBR_BLOCK / 2), PY, scr, r, F.lane); continue; } r -= I_BR;
        if (r < I_BR) { p0_transpose_item(in_(9) + (size_t)l * 1024 * DM, 1024, DM, wbr + 2 * (WBR_BLOCK / 2), PY, scr, r, F.lane); continue; } r -= I_BR;
        p0_transpose_item(in_(10) + (size_t)l * 512 * DM, 512, DM, wbr + 3 * (WBR_BLOCK / 2), PY, scr, r, F.lane);
    }
    {
        LAS float* cm = (LAS float*)(F.lds + RING_OFF + 12288);
        const int lane = F.lane, n = lane & 31, kpar = lane >> 5;
        constexpr int NBQ = N8 / 32;
        for (int it = F.vcu; it < 2 * NBQ + 2 * (DM / 32); it += F.G) {
            const float* W; int ldw; unsigned char* Q; float* SC;
            if (it < 2 * NBQ) { const int l = it / NBQ, n0c = (it % NBQ) * 32, n0 = pg8::map8(n0c >> 8) * 256 + (n0c & 255);
                W = in_(2) + (size_t)l * DM * LDP + n0 + n; ldw = LDP; Q = ws + WS_WG8 + (size_t)l * WG8_LAYER + (size_t)n0c * P8; SC = (float*)(ws + WS_SB) + (size_t)l * N8 + n0c; }
            else { const int r = it - 2 * NBQ, l = r / (DM / 32), n0 = (r % (DM / 32)) * 32;
                W = in_(11) + (size_t)l * DM * DM + n0 + n; ldw = DM; Q = ws + WS_WO8 + (size_t)l * WO8_LAYER + (size_t)n0 * P8; SC = (float*)(ws + WS_SO) + (size_t)l * DM + n0; }
            float mx = 0.f; unsigned pk[8][16];
#pragma unroll
            for (int kb = 0; kb < 8; ++kb) { const int k0 = (F.wave * 8 + kb) * 64;
                float v[32]; const float* wp = W + (size_t)(k0 + kpar) * ldw;
#pragma unroll
                for (int i = 0; i < 32; ++i) { v[i] = __builtin_nontemporal_load(wp); wp += 2 * ldw; asm volatile("" : "+v"(wp)); }
#pragma unroll
                for (int i = 0; i < 32; ++i) mx = fmaxf(mx, fabsf(v[i]));
#pragma unroll
                for (int i = 0; i < 16; ++i) { pk[kb][i] = pk2(v[2 * i], v[2 * i + 1]); asm volatile("" : "+v"(pk[kb][i])); }
                asm volatile("" ::: "memory"); __builtin_amdgcn_sched_barrier(0); }
            mx = fmaxf(mx, __builtin_bit_cast(float, __builtin_amdgcn_ds_bpermute((lane ^ 32) << 2, __builtin_bit_cast(int, mx))));
            if (lane < 32) cm[F.wave * 32 + lane] = mx;
            LDS_WAIT(); __syncthreads();
            float cmax = cm[n];
#pragma unroll
            for (int w = 1; w < 8; ++w) cmax = fmaxf(cmax, cm[w * 32 + n]);
            cmax = fmaxf(cmax, 1e-30f);
            const float inv = 127.0f / cmax;
            if (F.wave == 0 && lane < 32) SC[lane] = cmax * (1.0f / 127.0f);
#pragma unroll
            for (int kb = 0; kb < 8; ++kb) { const int k0 = (F.wave * 8 + kb) * 64;
#pragma unroll
                for (int i = 0; i < 16; ++i) { scr[(4 * i + kpar) * 33 + n] = bflo(pk[kb][i]) * inv; scr[(4 * i + 2 + kpar) * 33 + n] = bfhi(pk[kb][i]) * inv; }
                LDS_WAIT(); asm volatile("" ::: "memory");
                const int c = lane & 7;
#pragma unroll
                for (int j = 0; j < 4; ++j) { const int nn = (lane >> 3) + 8 * j; const LAS float* sp = scr + (8 * c) * 33 + nn;
                    v2u o; o.x = q8(sp[0 * 33], sp[1 * 33], sp[2 * 33], sp[3 * 33], 1.0f); o.y = q8(sp[4 * 33], sp[5 * 33], sp[6 * 33], sp[7 * 33], 1.0f);
                    *(v2u*)(Q + (size_t)nn * P8 + k0 + 8 * c) = o; }
                LDS_WAIT(); asm volatile("" ::: "memory"); __builtin_amdgcn_sched_barrier(0); }
            __syncthreads();
        }
    }
    for (int m = gw; m < M; m += NGW) rms_row_to_bf16(in_(0) + (size_t)m * DM, in_(1), (bf16*)(ws + WS_XN) + (size_t)m * PK, (unsigned*)(ws + WS_XN8 + (size_t)m * P8), (float*)(ws + WS_SA) + m, F.lane);
}
#undef in_
__device__ __forceinline__ void phase_finalize(Frame& F, unsigned char* ws, const float* lam_p  , const float* subln_g  , float lam_init) {
    const int gw = F.vcu * NWAVES + F.wave, NGW = F.G * NWAVES, lane = F.lane;
    const bf16* proj = (const bf16*)(ws + WS_PROJ);
    float d1 = lam_p[lane] * lam_p[128 + lane] + lam_p[64 + lane] * lam_p[192 + lane];
    float d2 = lam_p[256 + lane] * lam_p[384 + lane] + lam_p[320 + lane] * lam_p[448 + lane];
    d1 = wave_sum(d1, lane); d2 = wave_sum(d2, lane);
    const float lam = expf(d1) - expf(d2) + lam_init;
    const float post = 1.0f - lam_init;
    const float* OC = (const float*)(ws + WS_OC);
    const f32x4 sg = *(const f32x4*)(subln_g + 4 * lane);
    bf16* YC = (bf16*)(ws + WS_YC);
    for (int it = gw; it < M * 4; it += NGW) {
        const int t = it >> 2, h = it & 3;
        const f32x4 o0 = *(const f32x4*)(OC + (size_t)t * 2048 + (2 * h) * 256 + 4 * lane);
        const f32x4 o1 = *(const f32x4*)(OC + (size_t)t * 2048 + (2 * h + 1) * 256 + 4 * lane);
        const f32x4 d = o0 - lam * o1;
        const float ss = wave_sum((d.x * d.x + d.y * d.y) + (d.z * d.z + d.w * d.w), lane);
        const float rstd = 1.0f / sqrtf(ss * (1.f / 256.f) + RMS_EPS) * post;
        const v2u zw = *(const v2u*)(proj + (size_t)t * LDP + CC_Z + h * 256 + 4 * lane);
        v2u o; o.x = pk2(d.x * rstd * sg.x * bflo(zw.x), d.y * rstd * sg.y * bfhi(zw.x)); o.y = pk2(d.z * rstd * sg.z * bflo(zw.y), d.w * rstd * sg.w * bfhi(zw.y));
        *(v2u*)(YC + (size_t)t * PY + h * 256 + 4 * lane) = o;
    }
    const float* OD = (const float*)(ws + WS_OD); const float* LSE = (const float*)(ws + WS_LSE);
    bf16* YD = (bf16*)(ws + WS_YD);
    const int hg = lane >> 4, c0 = hg * 128 + (lane & 15) * 8;
    for (int t = gw; t < M; t += NGW) {
        const float l0 = LSE[(size_t)t * 4 + hg], l1 = LSE[(size_t)M * 4 + (size_t)t * 4 + hg], l2 = LSE[(size_t)2 * M * 4 + (size_t)t * 4 + hg];
        const float mx = fmaxf(l0, fmaxf(l1, l2));
        float w0 = __builtin_amdgcn_exp2f(l0 - mx), w1 = __builtin_amdgcn_exp2f(l1 - mx), w2 = __builtin_amdgcn_exp2f(l2 - mx);
        const float inv = 1.0f / (w0 + w1 + w2); w0 *= inv; w1 *= inv; w2 *= inv;
        const float* p0 = OD + (size_t)t * 512 + c0; const float* p1 = p0 + (size_t)M * 512; const float* p2 = p1 + (size_t)M * 512;
        const f32x4 a0 = *(const f32x4*)p0, a1 = *(const f32x4*)(p0 + 4), b0 = *(const f32x4*)p1, b1 = *(const f32x4*)(p1 + 4), c0v = *(const f32x4*)p2, c1v = *(const f32x4*)(p2 + 4);
        const f32x4 r0 = w0 * a0 + w1 * b0 + w2 * c0v, r1 = w0 * a1 + w1 * b1 + w2 * c1v;
        const v4u zw = *(const v4u*)(proj + (size_t)t * LDP + CD_Z + c0);
        v4u o; o.x = pk2(r0.x * bflo(zw.x), r0.y * bfhi(zw.x)); o.y = pk2(r0.z * bflo(zw.y), r0.w * bfhi(zw.y));
        o.z = pk2(r1.x * bflo(zw.z), r1.y * bfhi(zw.z)); o.w = pk2(r1.z * bflo(zw.w), r1.w * bfhi(zw.w));
        *(v4u*)(YD + (size_t)t * PY + c0) = o;
    }
}
#ifndef REP_AB
#define REP_AB 1
#endif
#ifndef REP_AC
#define REP_AC 1
#endif
#ifndef REP_AA
#define REP_AA 1
#endif
#ifndef REP_AD
#define REP_AD 1
#endif
#ifndef SD_DENSE
#define SD_DENSE 2
#endif
#ifndef SD_ALIBI
#define SD_ALIBI 2
#endif
#ifndef SD_NA
#define SD_NA 1
#endif
#ifndef SD_DIL
#define SD_DIL 1
#endif
__device__ __forceinline__ void phase_attention(Frame& F, unsigned char* ws, const float* rel_bias  , char* lds, unsigned* qctr  ) {
    const att::bf16* P = (const att::bf16*)(ws + WS_PROJ);
    for (int rep = 0; rep < REP_AB; ++rep)
    for (int u = F.vcu; u < 256; u += F.G) {
        const int grp = u >> 6, b = grp >> 1, kvh = grp & 1, hq = kvh * 4 + ((u >> 4) & 3), qb = u & 15;
        const size_t tb = (size_t)b * SEQ, tq = tb + 256 * qb;
        att::UA a{};
        a.Q = P + tq * LDP + CB_Q + hq * 128; a.ldq = LDP;
        a.K = P + tb * LDP + CB_K + kvh * 128; a.V = P + tb * LDP + CB_V + kvh * 128; a.ldk = LDP; a.NT = SEQ / 64;
        a.Y = (att::bf16*)(ws + WS_YB) + tq * PY + hq * 128; a.ldy = PY; a.Z = P + tq * LDP + CB_Z + hq * 128; a.ldz = LDP;
        att::attn_unit_dma<att::M_DENSE, 1>(a, lds, 2 * 16384 + 3 * 16384, F.wave);
    }
    for (int rep = 0; rep < REP_AC; ++rep)
    for (int u = F.vcu; u < 256; u += F.G) {
        const int combo = u >> 4, b = combo >> 3, h = (combo >> 1) & 3, mp = combo & 1, qb = u & 15;
        const size_t tb = (size_t)b * SEQ, tq = tb + 256 * qb;
        att::UA a{};
        a.Q = P + tq * LDP + CC_Q + (h * 2 + mp) * 128; a.ldq = LDP;
        a.K = P + tb * LDP + CC_K + (h * 2 + mp) * 128; a.V = P + tb * LDP + CC_V + h * 256; a.ldk = LDP; a.NT = SEQ / 64;
        a.qk0 = 256 * qb; a.slope2 = __builtin_amdgcn_exp2f(-2.0f * (float)(h + 1)) * att::LOG2E; a.j0 = 4 * qb;
        a.O = (float*)(ws + WS_OC) + tq * 2048 + (h * 2 + mp) * 256; a.ldo = 2048;
        att::attn_unit_dma<att::M_ALIBI, 2>(a, lds, XTAB_OFF, F.wave);
    }
    volatile __attribute__((address_space(3))) unsigned* qslot = (volatile __attribute__((address_space(3))) unsigned*)(__attribute__((address_space(3))) char*)(lds + 90112);
    if (fresh_tid(F.wave) == 0) qslot[0] = atomicAdd(qctr, 1u);
    __syncthreads();
    unsigned cur = qslot[0]; int par = 0;
    while (cur < 640u) {
        unsigned nxt = 0u; if (fresh_tid(F.wave) == 0) nxt = atomicAdd(qctr, 1u);
        if (cur < 256u) {
            const int u = (int)cur;
            const int b = u >> 7, h = (u >> 4) & 7, R = u & 15;
            const size_t tb = (size_t)b * SEQ, tq = tb + 256 * R;
            int kr_lo = min(max(4 * R - 4, 0), 56); const int kr_last = min(max(4 * R - 1, 0), 56) + 7; int NT = kr_last - kr_lo + 1;
            att::UA a{};
            a.Q = P + tq * LDP + CA_Q + h * 128; a.ldq = LDP;
            a.K = P + (tb + (size_t)kr_lo * 64) * LDP + CA_K + h * 128; a.V = P + (tb + (size_t)kr_lo * 64) * LDP + CA_V + h * 128; a.ldk = LDP; a.NT = NT;
            a.qrow0 = 4 * R; a.krow0 = kr_lo; a.tbl = rel_bias + h * (15 * 31);
            a.Y = (att::bf16*)(ws + WS_YA) + tq * PY + h * 128; a.ldy = PY; a.Z = P + tq * LDP + CA_Z + h * 128; a.ldz = LDP;
            att::attn_unit_dma<att::M_NA, 1>(a, lds, 2 * 16384 + 3 * 16384, F.wave);
        } else {
            const int u = (int)cur - 256;
            const int bh = u >> 4, b = bh / 12, gh = bh % 12, g = gh >> 2, hg = gh & 3, u16 = u & 15;
            const int dil = (g == 0) ? 1 : ((g == 1) ? 4 : 16);
            const int qb = (g == 0) ? u16 : ((g == 1) ? (u16 & 3) : 0), rho = (g == 0) ? 0 : ((g == 1) ? (u16 >> 2) : u16);
            const int nttot = 64 / dil;
            const int t_lo = max(0, 4 * qb - 1), t_hi = min(nttot, 4 * qb + 5);
            const size_t tb = (size_t)b * SEQ, tq = tb + rho + (size_t)dil * 256 * qb, tk = tb + rho + (size_t)dil * 64 * t_lo;
            att::UA a{};
            a.Q = P + tq * LDP + CD_Q + gh * 128; a.ldq = (long)LDP * dil;
            a.K = P + tk * LDP + CD_K + gh * 128; a.V = P + tk * LDP + CD_V + gh * 128; a.ldk = (long)LDP * dil; a.NT = t_hi - t_lo;
            a.qk0 = 256 * qb - 64 * t_lo; a.slope2 = __builtin_amdgcn_exp2f(-8.0f * (float)(gh + 1) / 12.0f) * (float)dil * att::LOG2E;
            a.O = (float*)(ws + WS_OD) + (size_t)g * M * 512 + tq * 512 + hg * 128; a.ldo = 512L * dil;
            a.L = (float*)(ws + WS_LSE) + (size_t)g * M * 4 + tq * 4 + hg; a.ldl = 4L * dil;
            att::attn_unit_dma<att::M_DIL, 1>(a, lds, 2 * 16384 + 3 * 16384, F.wave);
        }
        if (fresh_tid(F.wave) == 0) qslot[par ^ 1] = nxt;
        LDS_WAIT(); __syncthreads();
        par ^= 1; cur = qslot[par];
    }
}

#ifndef REP_PRO
#define REP_PRO 1
#endif
#ifndef REP_INP
#define REP_INP 1
#endif
#ifndef REP_ATT
#define REP_ATT 1
#endif
#ifndef REP_FIN
#define REP_FIN 1
#endif
#ifndef REP_BRA
#define REP_BRA 1
#endif
#ifndef REP_OUT
#define REP_OUT 1
#endif
#ifndef REP_NRM
#define REP_NRM 1
#endif
constexpr int NPH = 14;
struct Args { const float* in[12]; float* out; unsigned char* ws; int ph_lo, ph_hi; };
__global__ void __launch_bounds__(NWAVES * 64, 2) mega_fwd(Args args) {
    extern __shared__ __attribute__((aligned(16))) unsigned char lds[];
    Frame F;
    F.lds = (LAS unsigned char*)lds;
    F.MISC = (volatile LAS unsigned*)(F.lds + MISC_OFF);
    F.tid = threadIdx.x; F.lane = F.tid & 63; F.wave = __builtin_amdgcn_readfirstlane(F.tid >> 6);
    const int wave0 = F.wave;
    F.G = gridDim.x; { const int bx = blockIdx.x; F.vcu = (F.G % 8 == 0) ? (bx % 8) * (F.G / 8) + bx / 8 : bx; }
    unsigned char* ws = args.ws;
    F.ctl = (unsigned*)(ws + WS_CTL);
    for (int u = F.tid; u < (LDS_BYTES - LDSCTL_OFF) / 4; u += NWAVES * 64) ((LAS unsigned*)(F.lds + LDSCTL_OFF))[u] = 0u;
    __syncthreads();
    XcdBarrier bar; bar.bar = F.ctl + CW_BAR; bar.x = 0; bar.st = nullptr;
    if (ONE_LAUNCH) bar = xcd_barrier_post(F.ctl + CW_BAR, F.MISC + 8);
    const int lo = args.ph_lo, hi = args.ph_hi;
    const __attribute__((address_space(4))) Args* KP = (const __attribute__((address_space(4))) Args*)__builtin_amdgcn_kernarg_segment_ptr();
#define INP(i) ((const float*)(__attribute__((address_space(1))) const float*)(unsigned long long)KP->in[i])
#define PHASE_ENTER() do { unsigned long long kpi_ = (unsigned long long)__builtin_amdgcn_kernarg_segment_ptr(); asm volatile("" : "+s"(kpi_)); KP = (const __attribute__((address_space(4))) Args*)kpi_; \
        unsigned long long wsi_ = (unsigned long long)KP->ws; asm volatile("" : "+s"(wsi_)); ws = (unsigned char*)(__attribute__((address_space(1))) unsigned char*)wsi_; int t_ = fresh_tid(wave0); asm volatile("" : "+v"(t_)); F.tid = t_; F.lane = t_ & 63; F.wave = wave0; } while (0)
#define IN(k) (lo <= (k) && (k) < hi)
#define SEAM(k) do { if (IN(k) && IN((k) + 1)) xcd_barrier(bar, fresh_tid(wave0) == 0); } while (0)

    if (IN(0)) { for (int rep = 0; rep < REP_PRO; ++rep) { PHASE_ENTER(); phase_prologue(F, KP, ws); }
        SEAM(0); }

#pragma unroll 1
    for (int l = 0; l < DEPTH; ++l) {
        const int pb = 1 + 7 * l;
        if (IN(pb)) for (int rep = 0; rep < REP_INP; ++rep) {
            PHASE_ENTER(); bf16* proj = (bf16*)(ws + WS_PROJ);
            {
                pg8::Gemm g8{(const pg8::bf16_t*)(ws + WS_XN8), (const pg8::bf16_t*)(ws + WS_WG8 + (size_t)l * WG8_LAYER), M, N8, DM / 2, P8 / 2};
                pg8::StaticOrder S8; S8.init(M, N8, F.G, (int)blockIdx.x);
                pg8::EpiProjT<true> E8{proj, LDP, INP(3) + (size_t)l * 4 * 2 * HD, (LAS float*)(F.lds + XTAB_OFF), QSCALE, (const float*)(ws + WS_SA), (const float*)(ws + WS_SB) + (size_t)l * N8};
                pg8::gemm_phase<pg8::EpiProjT<true>, pg8::StaticOrder, true, true, pg8::Gemm, true>(F.lds + RING_OFF, g8, S8, E8, F.wave);
            }
            pg8::GemmMap16 g{(const pg8::bf16_t*)(ws + WS_XN), (const pg8::bf16_t*)(ws + WS_WIN + (size_t)l * WIN_LAYER), DM, PK};
            pg8::StaticOrder S; S.init(M, pg8::NT16 * 256, F.G, (int)blockIdx.x);
            pg8::EpiProjT<false> E{proj, LDP, INP(3) + (size_t)l * 4 * 2 * HD, (LAS float*)(F.lds + XTAB_OFF), QSCALE, nullptr, nullptr};
            pg8::gemm_phase<pg8::EpiProjT<false>, pg8::StaticOrder, true, true, pg8::GemmMap16>(F.lds + RING_OFF, g, S, E, F.wave);
            if (rep == REP_INP - 1) SEAM(pb);
        }
        if (IN(pb + 2)) { for (int rep = 0; rep < REP_ATT; ++rep) { PHASE_ENTER(); phase_attention(F, ws, INP(4) + (size_t)l * 8 * 15 * 31, (char*)lds + RING_OFF, F.ctl + 24 + l); } SEAM(pb + 2); }
        if (IN(pb + 3)) for (int rep = 0; rep < REP_FIN; ++rep) {
            PHASE_ENTER();
            const float lam_init = 0.8f - 0.6f * expf(-0.3f * (float)l);
            phase_finalize(F, ws, INP(5) + (size_t)l * 4 * HD, INP(6) + (size_t)l * 2 * HD, lam_init); if (rep == REP_FIN - 1) SEAM(pb + 3);
        }
        if (IN(pb + 4)) for (int rep = 0; rep < REP_BRA; ++rep) {
            PHASE_ENTER(); bf16* proj = (bf16*)(ws + WS_PROJ);
            const int rot = (int)(blockIdx.x & 1);
            pg8::ChainGemm g{(const bf16*)(ws + WS_YA), (const bf16*)(ws + WS_WBR + (size_t)l * WBR_LAYER), Y_BLOCK / 2, WBR_BLOCK / 2, PY, 1024, rot};
            pg8::ChainOrder S; S.T.init(M, DM, F.G, (int)blockIdx.x);
            pg8::EpiChain E{proj + CG, LDP, (bf16*)(ws + WS_MG), PK, rot};
            pg8::gemm_phase<pg8::EpiChain, pg8::ChainOrder, true, true, pg8::ChainGemm>(F.lds + RING_OFF, g, S, E, F.wave);
            if (rep == REP_BRA - 1) SEAM(pb + 4);
        }
        if (IN(pb + 5)) {
            { PHASE_ENTER(); const int gw = F.vcu * NWAVES + F.wave, NGW = F.G * NWAVES;
              for (int m = gw; m < M; m += NGW) quant_row16((const bf16*)(ws + WS_MG) + (size_t)m * PK, (unsigned*)(ws + WS_MG8 + (size_t)m * P8), (float*)(ws + WS_SM) + m, F.lane); }
            xcd_barrier(bar, fresh_tid(wave0) == 0);
            for (int rep = 0; rep < REP_OUT; ++rep) {
            PHASE_ENTER();
            const float* xin = (l == 0) ? INP(0) : (const float*)(ws + WS_X1);
            float* xout = (l == DEPTH - 1) ? (float*)(__attribute__((address_space(1))) float*)(unsigned long long)KP->out : (float*)(ws + WS_X1);
            pg8::Gemm g{(const pg8::bf16_t*)(ws + WS_MG8), (const pg8::bf16_t*)(ws + WS_WO8 + (size_t)l * WO8_LAYER), M, DM, DM / 2, P8 / 2};
            pg8::StaticOrder S; S.init(M, DM, F.G, (int)blockIdx.x);
            pg8::EpiRes8 E{xin, xout, DM, (const float*)(ws + WS_SM), (const float*)(ws + WS_SO) + (size_t)l * DM};
            pg8::gemm_phase<pg8::EpiRes8, pg8::StaticOrder, true, true, pg8::Gemm, true>(F.lds + RING_OFF, g, S, E, F.wave);
            }
            SEAM(pb + 5);
        }
        if (l + 1 < DEPTH && IN(pb + 6)) for (int rep = 0; rep < REP_NRM; ++rep) {
            PHASE_ENTER();
            const int gw = F.vcu * NWAVES + F.wave, NGW = F.G * NWAVES;
            for (int m = gw; m < M; m += NGW) rms_row_to_bf16((const float*)(ws + WS_X1) + (size_t)m * DM, INP(1) + (size_t)(l + 1) * DM, (bf16*)(ws + WS_XN) + (size_t)m * PK, (unsigned*)(ws + WS_XN8 + (size_t)m * P8), (float*)(ws + WS_SA) + m, F.lane);
            if (rep == REP_NRM - 1) SEAM(pb + 6);
        }
    }
#undef IN
#undef SEAM
#undef PHASE_ENTER
#undef INP
}

extern "C" void kernel_launch(void* const* d_in, const int* in_sizes, int n_in, void* d_out, int out_size, void* d_ws, size_t ws_size, hipStream_t stream) {
    static int grid = 0;
    if (grid == 0) {
        if (n_in != 12 || in_sizes[0] != M * DM || out_size != M * DM || ws_size < WS_END) { fprintf(stderr, "kernel_launch: shape/workspace mismatch (n_in %d, in0 %d, out %d, ws %zu, need %zu)\n", n_in, n_in > 0 ? in_sizes[0] : -1, out_size, ws_size, (size_t)WS_END); grid = -1; return; }
        int dev = 0, cus = 0, per_cu = 0;
        if (hipGetDevice(&dev) != hipSuccess || hipDeviceGetAttribute(&cus, hipDeviceAttributeMultiprocessorCount, dev) != hipSuccess) { grid = -1; return; }
        if (hipFuncSetAttribute((const void*)mega_fwd, hipFuncAttributeMaxDynamicSharedMemorySize, LDS_BYTES) != hipSuccess) { fprintf(stderr, "kernel_launch: hipFuncSetAttribute failed\n"); grid = -1; return; }
        if (hipOccupancyMaxActiveBlocksPerMultiprocessor(&per_cu, (const void*)mega_fwd, NWAVES * 64, LDS_BYTES) != hipSuccess || per_cu < 1)
            fprintf(stderr, "kernel_launch: note: occupancy query reports %d workgroups per CU\n", per_cu);
        (void)hipGetLastError();
        grid = cus;
    }
    if (grid < 0) return;
    if (hipMemsetAsync((char*)d_ws + WS_CTL, 0, CTL_ZERO_BYTES, stream) != hipSuccess) { fprintf(stderr, "kernel_launch: hipMemsetAsync failed\n"); return; }
    Args a{};
    for (int i = 0; i < 12; ++i) a.in[i] = (const float*)d_in[i];
    a.out = (float*)d_out; a.ws = (unsigned char*)d_ws;
    if (ONE_LAUNCH) {
        a.ph_lo = 0; a.ph_hi = NPH;
        hipLaunchKernelGGL(mega_fwd, dim3(grid), dim3(NWAVES * 64), LDS_BYTES, stream, a);
    } else {
        for (int p = 0; p < NPH; ++p) { a.ph_lo = p; a.ph_hi = p + 1; hipLaunchKernelGGL(mega_fwd, dim3(grid), dim3(NWAVES * 64), LDS_BYTES, stream, a); }
    }
    const hipError_t le = hipPeekAtLastError();
    if (le != hipSuccess) fprintf(stderr, "kernel_launch: launch failed: %s\n", hipGetErrorName(le));
}
```

```cpp
#include <hip/hip_runtime.h>
#include <cstdio>
#include <cstdint>
__device__ __forceinline__ int fresh_tid(int wave) { unsigned m = ~0u; asm volatile("" : "+s"(m)); return wave * 64 + (int)__builtin_amdgcn_mbcnt_hi(m, __builtin_amdgcn_mbcnt_lo(m, 0u)); }
namespace pg8 {
#define PG8_LAS __attribute__((address_space(3)))
typedef unsigned short bf16_t;
typedef short bf16x8 __attribute__((ext_vector_type(8)));
typedef float f32x4 __attribute__((ext_vector_type(4)));
typedef unsigned u32x4 __attribute__((ext_vector_type(4)));
constexpr int BM = 256, BK = 64, HALF = 128, HTB = HALF * BK * 2  , STAGE_BYTES = 8 * HTB, NXCD = 8, WGM = 8;

__host__ __device__ __forceinline__ int lds_byte(int r, int c) { const int st = (r >> 4) * 2 + (c >> 5), rr = r & 15, cc = c & 31, ob = rr * 64 + cc * 2; return st * 1024 + (ob ^ (((ob >> 9) & 1) << 5)); }
__host__ __device__ __forceinline__ void stage_rc(int b, int& R, int& C) { const int st = b / 1024, sb = b % 1024, swz = sb ^ (((sb >> 9) & 1) << 5); R = (st >> 1) * 16 + swz / 64; C = (st & 1) * 32 + (swz % 64) / 2; }
__host__ __device__ __forceinline__ int perm32(int rho) { const int n = rho >> 4, i = rho & 15; return 8 * (i >> 2) + 4 * n + (i & 3); }

struct Unit { int pm, pn, seg; };
struct Gemm { const bf16_t* A; const bf16_t* Bt; int M, N, K, P;
    __device__ __forceinline__ int pitch() const { return P; }
    __device__ __forceinline__ int ntiles(const Unit&) const { return K / BK; }
    __device__ __forceinline__ const char* a_base(const Unit& u, size_t tstep) const { return (const char*)A + (size_t)u.pm * tstep; }
    __device__ __forceinline__ const char* b_base(const Unit& u, size_t tstep) const { return (const char*)Bt + (size_t)u.pn * tstep; }
};
__host__ __device__ __forceinline__ int map16(int j) { return j + 26; }
__host__ __device__ __forceinline__ int map8(int j) { return j < 26 ? j : j + 16; }
constexpr int NT16 = 16, NT8 = 110;
struct GemmMap16 { const bf16_t* A; const bf16_t* Bt; int K, P;
    __device__ __forceinline__ int pitch() const { return P; }
    __device__ __forceinline__ int ntiles(const Unit&) const { return K / BK; }
    __device__ __forceinline__ const char* a_base(const Unit& u, size_t tstep) const { return (const char*)A + (size_t)u.pm * tstep; }
    __device__ __forceinline__ const char* b_base(const Unit& u, size_t tstep) const { return (const char*)Bt + (size_t)map16(u.pn) * tstep; }
};
struct ChainGemm { const bf16_t* A0; const bf16_t* B0; size_t a_stride, b_stride; int P, K, rot;
    __device__ __forceinline__ int branch(const Unit& u) const { return (u.seg + 3 * rot) & 3; }
    __device__ __forceinline__ int pitch() const { return P; }
    __device__ __forceinline__ int ntiles(const Unit& u) const { return (branch(u) == 3) ? (K / BK) / 2 : K / BK; }
    __device__ __forceinline__ const char* a_base(const Unit& u, size_t tstep) const { return (const char*)(A0 + (size_t)branch(u) * a_stride) + (size_t)u.pm * tstep; }
    __device__ __forceinline__ const char* b_base(const Unit& u, size_t tstep) const { return (const char*)(B0 + (size_t)branch(u) * b_stride) + (size_t)u.pn * tstep; }
};

struct StaticOrder {
    int nM, nN, nwg, G, c;
    __host__ __device__ void init(int M, int N, int G_, int c_) { nM = M / BM; nN = N / BM; nwg = nM * nN; G = G_; c = c_; }
    __host__ __device__ bool next(int i, Unit& u) const {
        const long L = (long)i * G + c; if (L >= nwg) return false;
        int wgid = (int)L; { const int q = nwg / NXCD, r = nwg % NXCD, xcd = wgid % NXCD, off = wgid / NXCD; wgid = (xcd < r ? xcd * (q + 1) : r * (q + 1) + (xcd - r) * q) + off; }
        const int nig = WGM * nN, gid = wgid / nig, fm = gid * WGM, gsz = (nM - fm) < WGM ? (nM - fm) : WGM;
        u.pm = fm + ((wgid % nig) % gsz); u.pn = (wgid % nig) / gsz; u.seg = 0; return true;
    }
    __device__ __forceinline__ void a_ready(const Unit&) const {}
    __device__ __forceinline__ void done(const Unit&) const {}
};
struct ChainOrder { StaticOrder T;
    __device__ __forceinline__ bool next(int i, Unit& u) const { if (!T.next(i >> 2, u)) return false; u.seg = i & 3; return true; }
    __device__ __forceinline__ void a_ready(const Unit&) const {}
    __device__ __forceinline__ void done(const Unit&) const {}
};

__device__ __forceinline__ unsigned cvt_pk_bf16(float lo, float hi) { unsigned r; asm volatile("v_cvt_pk_bf16_f32 %0, %1, %2" : "=v"(r) : "v"(lo), "v"(hi)); return r; }
typedef float f32x2 __attribute__((ext_vector_type(2)));
typedef int i32x4 __attribute__((ext_vector_type(4)));
template <bool I8> struct AccT { typedef f32x4 type; };
template <> struct AccT<true> { typedef i32x4 type; };
template <bool I8> __device__ __forceinline__ typename AccT<I8>::type mma1(bf16x8 b, bf16x8 a, typename AccT<I8>::type c) {
    if constexpr (I8) return __builtin_amdgcn_mfma_i32_16x16x64_i8(__builtin_bit_cast(i32x4, b), __builtin_bit_cast(i32x4, a), c, 0, 0, 0);
    else return __builtin_amdgcn_mfma_f32_16x16x32_bf16(b, a, c, 0, 0, 0);
}
__device__ __forceinline__ float sigmoid_fast(float v) { return __builtin_amdgcn_rcpf(1.0f + __builtin_amdgcn_exp2f(-1.4426950408889634f * v)); }
__device__ __forceinline__ float bf_lo(unsigned w) { return __builtin_bit_cast(float, w << 16); }
__device__ __forceinline__ float bf_hi(unsigned w) { return __builtin_bit_cast(float, w & 0xffff0000u); }
template <bool I8> struct EpiProjT {
    static constexpr bool PERM = true, AFTER_DRAIN = false;
    bf16_t* O; int ldc; const float* qk_gain  ; PG8_LAS float* xtab  ; float qscale; const float* sa; const float* sb;
    __device__ __forceinline__ bool resets(const Unit&) const { return true; }
    __device__ __forceinline__ void operator()(const typename AccT<I8>::type (&acc)[2][2][4][2], const Unit& u, int wr, int wc, int fr, int fq) const {
        const int pn = I8 ? map8(u.pn) : map16(u.pn);
        int kind, br = 0, isk = 0;
        if (pn >= 62) kind = 2;
        else if ((pn >= 12 && pn < 16) || (pn >= 22 && pn < 26) || (pn >= 38 && pn < 42) || pn >= 60) kind = 1;
        else if (pn < 8) { kind = 3; br = 0; isk = pn >= 4; }
        else if (pn >= 16 && pn < 21) { kind = 3; br = 1; isk = pn >= 20; }
        else if (pn >= 26 && pn < 34) { kind = 3; br = 2; isk = pn >= 30; }
        else if (pn >= 42 && pn < 54) { kind = 3; br = 3; isk = pn >= 48; }
        else kind = 0;
        const int row0 = u.pm * BM + wr * 64 + fr, cc0 = wc * 32 + 8 * fq, col0 = pn * BM + cc0;
        f32x4 sbv[2][2];
        if (I8) {
#pragma unroll
            for (int bj = 0; bj < 2; ++bj)
#pragma unroll
                for (int n = 0; n < 2; ++n) sbv[bj][n] = *(const f32x4*)(sb + u.pn * BM + cc0 + bj * HALF + 4 * n);
        }
        float sarr[2][4];
#pragma unroll
        for (int ai = 0; ai < 2; ++ai)
#pragma unroll
            for (int m = 0; m < 4; ++m) sarr[ai][m] = I8 ? sa[row0 + ai * HALF + m * 16] : 1.0f;
        if (I8) asm volatile("" ::: "memory");
#define EPV(ai, bj, m, n, sar) (I8 ? (f32x4){(float)acc[ai][bj][m][n][0], (float)acc[ai][bj][m][n][1], (float)acc[ai][bj][m][n][2], (float)acc[ai][bj][m][n][3]} * (sar) * sbv[bj][n] \
                                   : (f32x4){(float)acc[ai][bj][m][n][0], (float)acc[ai][bj][m][n][1], (float)acc[ai][bj][m][n][2], (float)acc[ai][bj][m][n][3]})
        if (kind != 3) {
#pragma unroll
            for (int ai = 0; ai < 2; ++ai)
#pragma unroll
                for (int m = 0; m < 4; ++m) { const int row = row0 + ai * HALF + m * 16; bf16_t* rowp = O + (size_t)row * ldc + col0; const float sar = sarr[ai][m];
#pragma unroll
                    for (int bj = 0; bj < 2; ++bj) { f32x4 v0 = EPV(ai, bj, m, 0, sar), v1 = EPV(ai, bj, m, 1, sar);
                        if (kind == 1) {
#pragma unroll
                            for (int e = 0; e < 4; ++e) { v0[e] *= sigmoid_fast(v0[e]); v1[e] *= sigmoid_fast(v1[e]); }
                        } else if (kind == 2) {
#pragma unroll
                            for (int e = 0; e < 4; ++e) { v0[e] = fminf(__builtin_amdgcn_exp2f(-1.4426950408889634f * v0[e]), 1e18f); v1[e] = fminf(__builtin_amdgcn_exp2f(-1.4426950408889634f * v1[e]), 1e18f); }
                        }
                        u32x4 w; w.x = cvt_pk_bf16(v0[0], v0[1]); w.y = cvt_pk_bf16(v0[2], v0[3]); w.z = cvt_pk_bf16(v1[0], v1[1]); w.w = cvt_pk_bf16(v1[2], v1[3]);
                        *(u32x4*)(rowp + bj * HALF) = w; } }
            return;
        }
#pragma unroll
        for (int ai = 0; ai < 2; ++ai)
#pragma unroll
            for (int m = 0; m < 4; ++m) { const float sar = sarr[ai][m];
#pragma unroll
                for (int bj = 0; bj < 2; ++bj) { const f32x4 a = EPV(ai, bj, m, 0, sar), b = EPV(ai, bj, m, 1, sar);
                    float s = (a[0] * a[0] + a[1] * a[1]) + (a[2] * a[2] + a[3] * a[3]) + (b[0] * b[0] + b[1] * b[1]) + (b[2] * b[2] + b[3] * b[3]);
                    s += __builtin_bit_cast(float, __builtin_amdgcn_ds_bpermute(((fq * 16 + fr) ^ 16) << 2, __builtin_bit_cast(int, s)));
                    s += __builtin_bit_cast(float, __builtin_amdgcn_ds_bpermute(((fq * 16 + fr) ^ 32) << 2, __builtin_bit_cast(int, s)));
                    if (fq == 0) xtab[((ai * HALF + wr * 64 + m * 16 + fr) * 2 + bj) * 4 + wc] = s; } }
        asm volatile("s_waitcnt lgkmcnt(0)" ::: "memory"); __builtin_amdgcn_s_barrier(); asm volatile("" ::: "memory");
        const float* gp = qk_gain + (br * 2 + isk) * 128 + cc0;
        const f32x4 ga = *(const f32x4*)gp, gb = *(const f32x4*)(gp + 4);
        const float sc = isk ? 1.0f : qscale;
        float invf[4];
#pragma unroll
        for (int i = 0; i < 4; ++i) invf[i] = __builtin_amdgcn_exp2f(-(float)(((cc0 >> 1) + i) & 31) * (13.287712379549449f / 32.f));
#pragma unroll
        for (int ai = 0; ai < 2; ++ai)
#pragma unroll
            for (int m = 0; m < 4; ++m) { const int rl = ai * HALF + wr * 64 + m * 16 + fr; const int row = u.pm * BM + rl;
                bf16_t* rowp = O + (size_t)row * ldc + col0; const float sar = sarr[ai][m];
                const int spos = row & 4095; const float fpos = (wc < 2) ? (float)(spos >> 6) : (float)(spos & 63);
#pragma unroll
                for (int bj = 0; bj < 2; ++bj) { const f32x4 t = *(const PG8_LAS f32x4*)(xtab + (rl * 2 + bj) * 4);
                    const float rstd = sc / sqrtf(((t[0] + t[1]) + (t[2] + t[3])) * (1.0f / 128.0f) + 1e-6f);
                    f32x4 v0 = EPV(ai, bj, m, 0, sar) * rstd * ga, v1 = EPV(ai, bj, m, 1, sar) * rstd * gb;
                    if (br == 1) {
                        float x[8] = {v0[0], v0[1], v0[2], v0[3], v1[0], v1[1], v1[2], v1[3]};
#pragma unroll
                        for (int i = 0; i < 4; ++i) { const float rev = __builtin_amdgcn_fractf(fpos * invf[i] * 0.15915494309189535f);
                            const float sn = __builtin_amdgcn_sinf(rev), cs = __builtin_amdgcn_cosf(rev);
                            const float x1 = x[2 * i], x2 = x[2 * i + 1]; x[2 * i] = x1 * cs - x2 * sn; x[2 * i + 1] = x1 * sn + x2 * cs; }
                        v0 = (f32x4){x[0], x[1], x[2], x[3]}; v1 = (f32x4){x[4], x[5], x[6], x[7]};
                    }
                    u32x4 w; w.x = cvt_pk_bf16(v0[0], v0[1]); w.y = cvt_pk_bf16(v0[2], v0[3]); w.z = cvt_pk_bf16(v1[0], v1[1]); w.w = cvt_pk_bf16(v1[2], v1[3]);
                    *(u32x4*)(rowp + bj * HALF) = w; } }
#undef EPV
    }
};
struct EpiChain {
    static constexpr bool PERM = true, AFTER_DRAIN = false;
    const bf16_t* G; int ldg; bf16_t* Mg; int ldm; int rot;
    __device__ __forceinline__ bool resets(const Unit& u) const { return u.seg == 3; }
    __device__ __forceinline__ void operator()(f32x4 (&acc)[2][2][4][2], const Unit& u, int wr, int wc, int fr, int fq) const {
        const int row0 = u.pm * BM + wr * 64 + fr, col0 = u.pn * BM + wc * 32 + 8 * fq, seg = u.seg;
        const int bcur = (seg + 3 * rot) & 3, bnxt = (seg + 1 + 3 * rot) & 3;
        const bf16_t* Gs = G + (size_t)bcur * 4096;
        const bool lastseg = seg == 3;
        const int nxo = lastseg ? 0 : (bnxt - bcur) * 4096;
#pragma unroll
        for (int ai = 0; ai < 2; ++ai) {
            u32x4 gw[4][2], nw[4][2];
#pragma unroll
            for (int m = 0; m < 4; ++m) { const size_t row = (size_t)(row0 + ai * HALF + m * 16);
#pragma unroll
                for (int bj = 0; bj < 2; ++bj) { gw[m][bj] = *(const u32x4*)(Gs + row * ldg + col0 + bj * HALF); nw[m][bj] = *(const u32x4*)(Gs + nxo + row * ldg + col0 + bj * HALF); } }
            asm volatile("" ::: "memory");
#pragma unroll
            for (int m = 0; m < 4; ++m) { const size_t row = (size_t)(row0 + ai * HALF + m * 16);
#pragma unroll
                for (int bj = 0; bj < 2; ++bj) { const u32x4 g = gw[m][bj], q = nw[m][bj];
                    float f[8] = {bf_lo(g.x), bf_hi(g.x), bf_lo(g.y), bf_hi(g.y), bf_lo(g.z), bf_hi(g.z), bf_lo(g.w), bf_hi(g.w)};
                    const float d[8] = {bf_lo(q.x), bf_hi(q.x), bf_lo(q.y), bf_hi(q.y), bf_lo(q.z), bf_hi(q.z), bf_lo(q.w), bf_hi(q.w)};
#pragma unroll
                    for (int e = 0; e < 8; ++e) { const float r = __builtin_amdgcn_rcpf(1.0f + f[e]); f[e] = lastseg ? r : (1.0f + d[e]) * r; }
                    f32x4 v0 = acc[ai][bj][m][0], v1 = acc[ai][bj][m][1];
                    v0[0] *= f[0]; v0[1] *= f[1]; v0[2] *= f[2]; v0[3] *= f[3]; v1[0] *= f[4]; v1[1] *= f[5]; v1[2] *= f[6]; v1[3] *= f[7];
                    acc[ai][bj][m][0] = v0; acc[ai][bj][m][1] = v1;
                    if (lastseg) { u32x4 w; w.x = cvt_pk_bf16(v0[0], v0[1]); w.y = cvt_pk_bf16(v0[2], v0[3]); w.z = cvt_pk_bf16(v1[0], v1[1]); w.w = cvt_pk_bf16(v1[2], v1[3]);
                        *(u32x4*)(Mg + row * ldm + col0 + bj * HALF) = w; } } }
            asm volatile("" ::: "memory");
        }
    }
};
struct EpiRes {
    static constexpr bool PERM = false, AFTER_DRAIN = false;
    const float* base; float* out; int ldc;
    __device__ __forceinline__ bool resets(const Unit&) const { return true; }
    __device__ __forceinline__ void operator()(const f32x4 (&acc)[2][2][4][2], const Unit& u, int wr, int wc, int fr, int fq) const {
        const int col0 = u.pn * BM + wc * 32 + 4 * fq;
#pragma unroll
        for (int ai = 0; ai < 2; ++ai) {
            f32x4 pre[4][2][2];
#pragma unroll
            for (int m = 0; m < 4; ++m) { const size_t off = (size_t)(u.pm * BM + ai * HALF + wr * 64 + m * 16 + fr) * ldc + col0;
#pragma unroll
                for (int bj = 0; bj < 2; ++bj)
#pragma unroll
                    for (int n = 0; n < 2; ++n) pre[m][bj][n] = *(const f32x4*)(base + off + bj * HALF + n * 16); }
            asm volatile("" ::: "memory");
#pragma unroll
            for (int m = 0; m < 4; ++m) { const size_t off = (size_t)(u.pm * BM + ai * HALF + wr * 64 + m * 16 + fr) * ldc + col0;
#pragma unroll
                for (int bj = 0; bj < 2; ++bj)
#pragma unroll
                    for (int n = 0; n < 2; ++n) *(f32x4*)(out + off + bj * HALF + n * 16) = pre[m][bj][n] + acc[ai][bj][m][n]; }
            asm volatile("" ::: "memory");
        }
    }
};
struct EpiRes8 {
    static constexpr bool PERM = false, AFTER_DRAIN = false;
    const float* base; float* out; int ldc; const float* sm; const float* so;
    __device__ __forceinline__ bool resets(const Unit&) const { return true; }
    __device__ __forceinline__ void operator()(const i32x4 (&acc)[2][2][4][2], const Unit& u, int wr, int wc, int fr, int fq) const {
        const int col0 = u.pn * BM + wc * 32 + 4 * fq;
        f32x4 sov[2][2];
#pragma unroll
        for (int bj = 0; bj < 2; ++bj)
#pragma unroll
            for (int n = 0; n < 2; ++n) sov[bj][n] = *(const f32x4*)(so + col0 + bj * HALF + n * 16);
#pragma unroll
        for (int ai = 0; ai < 2; ++ai) {
            f32x4 pre[4][2][2]; float smr[4];
#pragma unroll
            for (int m = 0; m < 4; ++m) { const int row = u.pm * BM + ai * HALF + wr * 64 + m * 16 + fr; const size_t off = (size_t)row * ldc + col0; smr[m] = sm[row];
#pragma unroll
                for (int bj = 0; bj < 2; ++bj)
#pragma unroll
                    for (int n = 0; n < 2; ++n) pre[m][bj][n] = *(const f32x4*)(base + off + bj * HALF + n * 16); }
            asm volatile("" ::: "memory");
#pragma unroll
            for (int m = 0; m < 4; ++m) { const size_t off = (size_t)(u.pm * BM + ai * HALF + wr * 64 + m * 16 + fr) * ldc + col0;
#pragma unroll
                for (int bj = 0; bj < 2; ++bj)
#pragma unroll
                    for (int n = 0; n < 2; ++n) { const i32x4 a = acc[ai][bj][m][n]; f32x4 v; v[0] = (float)a[0]; v[1] = (float)a[1]; v[2] = (float)a[2]; v[3] = (float)a[3];
                        *(f32x4*)(out + off + bj * HALF + n * 16) = pre[m][bj][n] + v * smr[m] * sov[bj][n]; } }
            asm volatile("" ::: "memory");
        }
    }
};

template <class Epi, class Sched, bool ALIGN_EPI = false, bool SP2 = false, class GemmT = Gemm, bool I8 = false>
__device__ __forceinline__ void gemm_phase(PG8_LAS unsigned char* lds, const GemmT g, const Sched& S, const Epi& E, const int wave_in) {
    int tid_ = fresh_tid(wave_in); asm volatile("" : "+v"(tid_));
    const int tid = tid_, wid = __builtin_amdgcn_readfirstlane(tid >> 6), lane = tid & 63, wr = wid >> 2, wc = wid & 3, fr = lane & 15, fq = lane >> 4;
    const int K = g.pitch();
    unsigned voffA[2], voffB[2];
#pragma unroll
    for (int i = 0; i < 2; ++i) { int R, C; stage_rc(tid * 16 + i * 8192, R, C); const int Rb = Epi::PERM ? ((R & ~31) + perm32(R & 31)) : R;
        voffA[i] = (unsigned)(R * K + C) * 2u; voffB[i] = (unsigned)(Rb * K + C) * 2u; }
    const size_t kstep = (size_t)(BK * 2);
    const size_t hstep = (size_t)HALF * K * 2;
    const size_t tstep = 2 * hstep;
    const unsigned ldsw = (unsigned)wid * 1024u;
    const int aoff = lds_byte(wr * 64 + fr, fq * 8), boff = lds_byte(wc * 32 + fr, fq * 8);
#define PG8_SA(b, h) (((b) * 2 + (h)) * HTB)
#define PG8_SB(b, h) ((4 + (b) * 2 + (h)) * HTB)
#define PG8_STAGE(bufoff, gbase, voff) do { _Pragma("unroll") for (int _i = 0; _i < 2; ++_i) \
        __builtin_amdgcn_global_load_lds((const unsigned*)((const char*)(gbase) + (voff)[_i]), (PG8_LAS unsigned*)(lds + (bufoff) + ldsw + _i * 8192), 16, 0, 0); } while (0)
#define PG8_LDA(dst, b, h) do { _Pragma("unroll") for (int m = 0; m < 4; ++m) _Pragma("unroll") for (int k = 0; k < 2; ++k) dst[m][k] = *(const PG8_LAS bf16x8*)(lds + PG8_SA(b, h) + aoff + m * 2048 + k * 1024); } while (0)
#define PG8_LDB(dst, b, h) do { _Pragma("unroll") for (int n = 0; n < 2; ++n) _Pragma("unroll") for (int k = 0; k < 2; ++k) dst[n][k] = *(const PG8_LAS bf16x8*)(lds + PG8_SB(b, h) + boff + n * 2048 + k * 1024); } while (0)
#define PG8_MMA(ai, bj, At, Bt) do { __builtin_amdgcn_s_setprio(1); _Pragma("unroll") for (int m = 0; m < 4; ++m) _Pragma("unroll") for (int n = 0; n < 2; ++n) _Pragma("unroll") for (int k = 0; k < 2; ++k) \
        acc[ai][bj][m][n] = mma1<I8>(Bt[n][k], At[m][k], acc[ai][bj][m][n]); __builtin_amdgcn_s_setprio(0); } while (0)
#define PG8_WAIT_V(n) asm volatile("s_waitcnt vmcnt(" #n ")" ::: "memory")
#define PG8_WAIT_L(n) asm volatile("s_waitcnt lgkmcnt(" #n ")" ::: "memory")
#define PG8_BAR __builtin_amdgcn_s_barrier()
#define PG8_SCHED __builtin_amdgcn_sched_barrier(0)
    Unit cur, nxt; int ui = 0;
    if (!S.next(0, cur)) return;
    int nt = g.ntiles(cur);
    typedef typename AccT<I8>::type acc_t;
    acc_t acc[2][2][4][2];
#pragma unroll
    for (int a = 0; a < 2; ++a)
#pragma unroll
        for (int b = 0; b < 2; ++b)
#pragma unroll
            for (int m = 0; m < 4; ++m)
#pragma unroll
                for (int n = 0; n < 2; ++n) acc[a][b][m][n] = acc_t{};
    bf16x8 At[4][2], B0[2][2], B1[2][2];
    const char* cA = g.a_base(cur, tstep); const char* cB = g.b_base(cur, tstep);
    S.a_ready(cur);
    if constexpr (SP2) {
        PG8_STAGE(PG8_SB(0, 0), cB, voffB); PG8_STAGE(PG8_SB(0, 1), cB + hstep, voffB); PG8_STAGE(PG8_SA(0, 0), cA, voffA); PG8_STAGE(PG8_SA(0, 1), cA + hstep, voffA);
        if (wr == 1) PG8_BAR;
        PG8_WAIT_V(2); PG8_BAR;
        PG8_STAGE(PG8_SB(1, 0), cB + kstep, voffB); PG8_STAGE(PG8_SA(1, 0), cA + kstep, voffA); PG8_STAGE(PG8_SB(1, 1), cB + hstep + kstep, voffB);
        PG8_WAIT_V(6); PG8_BAR;
    } else {
        PG8_STAGE(PG8_SB(0, 0), cB, voffB); PG8_STAGE(PG8_SA(0, 0), cA, voffA); PG8_STAGE(PG8_SB(0, 1), cB + hstep, voffB); PG8_STAGE(PG8_SA(0, 1), cA + hstep, voffA);
        if (wr == 1) PG8_BAR;
        PG8_WAIT_V(4); PG8_BAR;
        PG8_STAGE(PG8_SB(1, 0), cB + kstep, voffB); PG8_STAGE(PG8_SA(1, 0), cA + kstep, voffA); PG8_STAGE(PG8_SB(1, 1), cB + hstep + kstep, voffB);
        PG8_WAIT_V(6); PG8_BAR;
    }
    for (;;) {
        const bool has_next = S.next(ui + 1, nxt);
        const char* nA = has_next ? g.a_base(nxt, tstep) : cA; const char* nB = has_next ? g.b_base(nxt, tstep) : cB;
        for (int t = 0; t < nt; t += 2) {
            const bool last = (t == nt - 2);
            const char* a1 = cA + (size_t)(t + 1) * kstep;
            const char* a2 = last ? nA : cA + (size_t)(t + 2) * kstep; const char* b2 = last ? nB : cB + (size_t)(t + 2) * kstep;
            const char* a3 = a2 + kstep; const char* b3 = b2 + kstep;
            if (last && has_next) S.a_ready(nxt);
            if constexpr (SP2) {
            PG8_LDB(B0, 0, 0); PG8_LDB(B1, 0, 1); PG8_SCHED; PG8_LDA(At, 0, 0); PG8_STAGE(PG8_SA(1, 1), a1 + hstep, voffA);
            PG8_WAIT_V(8); PG8_WAIT_L(0); PG8_BAR; PG8_MMA(0, 0, At, B0); PG8_MMA(0, 1, At, B1); PG8_BAR; PG8_SCHED;
            PG8_LDA(At, 0, 1); PG8_STAGE(PG8_SB(0, 0), b2, voffB); PG8_STAGE(PG8_SB(0, 1), b2 + hstep, voffB); PG8_STAGE(PG8_SA(0, 0), a2, voffA);
            PG8_WAIT_V(8); PG8_WAIT_L(0); PG8_BAR; PG8_MMA(1, 0, At, B0); PG8_MMA(1, 1, At, B1); PG8_BAR; PG8_SCHED;
            PG8_LDB(B0, 1, 0); PG8_LDB(B1, 1, 1); PG8_SCHED; PG8_LDA(At, 1, 0); PG8_STAGE(PG8_SA(0, 1), a2 + hstep, voffA);
            PG8_WAIT_V(8); PG8_WAIT_L(0); PG8_BAR; PG8_MMA(0, 0, At, B0); PG8_MMA(0, 1, At, B1); PG8_BAR; PG8_SCHED;
            PG8_LDA(At, 1, 1); PG8_STAGE(PG8_SB(1, 0), b3, voffB); PG8_STAGE(PG8_SB(1, 1), b3 + hstep, voffB); PG8_STAGE(PG8_SA(1, 0), a3, voffA);
            PG8_WAIT_V(8); PG8_WAIT_L(0); PG8_BAR; PG8_MMA(1, 0, At, B0); PG8_MMA(1, 1, At, B1); PG8_BAR; PG8_SCHED;
            } else {
            PG8_LDB(B0, 0, 0); PG8_SCHED; PG8_LDA(At, 0, 0); PG8_STAGE(PG8_SA(1, 1), a1 + hstep, voffA);
            PG8_WAIT_L(8); PG8_BAR; PG8_WAIT_L(0); PG8_MMA(0, 0, At, B0); PG8_BAR; PG8_SCHED;
            PG8_LDB(B1, 0, 1); PG8_STAGE(PG8_SB(0, 0), b2, voffB);
            PG8_BAR; PG8_WAIT_L(0); PG8_MMA(0, 1, At, B1); PG8_BAR;
            PG8_LDA(At, 0, 1); PG8_STAGE(PG8_SA(0, 0), a2, voffA);
            PG8_BAR; PG8_WAIT_L(0); PG8_MMA(1, 0, At, B0); PG8_BAR; PG8_SCHED;
            PG8_STAGE(PG8_SB(0, 1), b2 + hstep, voffB);
            PG8_WAIT_V(6); PG8_BAR; PG8_MMA(1, 1, At, B1); PG8_BAR;
            PG8_LDB(B0, 1, 0); PG8_SCHED; PG8_LDA(At, 1, 0); PG8_STAGE(PG8_SA(0, 1), a2 + hstep, voffA);
            PG8_WAIT_L(8); PG8_BAR; PG8_WAIT_L(0); PG8_MMA(0, 0, At, B0); PG8_BAR; PG8_SCHED;
            PG8_LDB(B1, 1, 1); PG8_STAGE(PG8_SB(1, 0), b3, voffB);
            PG8_BAR; PG8_WAIT_L(0); PG8_MMA(0, 1, At, B1); PG8_BAR;
            PG8_LDA(At, 1, 1); PG8_STAGE(PG8_SA(1, 0), a3, voffA);
            PG8_BAR; PG8_WAIT_L(0); PG8_MMA(1, 0, At, B0); PG8_BAR; PG8_SCHED;
            PG8_STAGE(PG8_SB(1, 1), b3 + hstep, voffB);
            PG8_WAIT_V(6); PG8_BAR; PG8_MMA(1, 1, At, B1); PG8_BAR;
            }
        }
        if constexpr (ALIGN_EPI) { if (wr == 0) PG8_BAR; }
        if constexpr (!Epi::AFTER_DRAIN) { E(acc, cur, wr, wc, fr, fq); S.done(cur); }
        if (!has_next) break;
        if (E.resets(cur)) {
#pragma unroll
        for (int a = 0; a < 2; ++a)
#pragma unroll
            for (int b = 0; b < 2; ++b)
#pragma unroll
                for (int m = 0; m < 4; ++m)
#pragma unroll
                    for (int n = 0; n < 2; ++n) acc[a][b][m][n] = acc_t{};
        }
        cur = nxt; cA = nA; cB = nB; ++ui; nt = g.ntiles(cur);
        if constexpr (ALIGN_EPI) { if (wr == 1) PG8_BAR; }
    }
    PG8_WAIT_V(0);
    if constexpr (!ALIGN_EPI) { if (wr == 0) PG8_BAR; }
    PG8_BAR;
    if constexpr (Epi::AFTER_DRAIN) { E.fused(acc, cur, wr, wc, fr, fq, lds, wid, lane); S.done(cur); }
#undef PG8_SA
#undef PG8_SB
#undef PG8_STAGE
#undef PG8_LDA
#undef PG8_LDB
#undef PG8_MMA
#undef PG8_WAIT_V
#undef PG8_WAIT_L
#undef PG8_BAR
#undef PG8_SCHED
}
}
namespace att {
typedef unsigned short bf16;
using bf16x8 = __attribute__((ext_vector_type(8))) short;
using s16x4  = __attribute__((ext_vector_type(4))) short;
using f32x16 = __attribute__((ext_vector_type(16))) float;
using u32x4  = __attribute__((ext_vector_type(4))) unsigned;
constexpr int D = 128, NW = 8, QBLK = 32, KVBLK = 64;
constexpr int SHM_V = KVBLK * D * 2, SHM_K = KVBLK * D * 2;
constexpr int OFF_WS = 2 * SHM_V + 2 * SHM_K, OFF_TBL = OFF_WS + NW * 64 * 4, SHM_ATTN = OFF_TBL + 4096;
constexpr float THR2 = 8.f;
constexpr float LOG2E = 1.4426950408889634f;
enum { M_NA = 0, M_DENSE = 1, M_ALIBI = 2, M_DIL = 3 };
#define KSWZ(row, colB) ((row) * 256 + ((colB) ^ (((row) & 7) << 4)))
#define SBAR() __builtin_amdgcn_sched_barrier(0)
__device__ __forceinline__ int crow(int r, int hi) { return (r & 3) + 8 * (r >> 2) + 4 * hi; }
__device__ __forceinline__ unsigned cvtpk(float lo, float hi) { unsigned r; asm volatile("v_cvt_pk_bf16_f32 %0, %1, %2" : "=v"(r) : "v"(lo), "v"(hi)); return r; }
__device__ __forceinline__ unsigned short f2bf1(float f) { unsigned u = __builtin_bit_cast(unsigned, f); return (unsigned short)((u + 0x7fffu + ((u >> 16) & 1u)) >> 16); }
__device__ __forceinline__ float bf2f(unsigned short h) { return __builtin_bit_cast(float, (unsigned)h << 16); }

__device__ __forceinline__ void partialSM(f32x16& p0, f32x16& p1, float& m_reg, float& mn, float& alpha) {
  float pmax = p0[0];
#pragma unroll
  for (int r = 1; r < 16; ++r) pmax = fmaxf(pmax, p0[r]);
#pragma unroll
  for (int r = 0; r < 16; ++r) pmax = fmaxf(pmax, p1[r]);
  { auto rr = __builtin_amdgcn_permlane32_swap(__float_as_uint(pmax), __float_as_uint(pmax), false, false);
    pmax = fmaxf(__uint_as_float(rr[0]), __uint_as_float(rr[1])); }
  if (__builtin_expect(__all(pmax - m_reg <= THR2), 1)) { mn = m_reg; alpha = 1.f; }
  else { mn = fmaxf(m_reg, pmax); alpha = __builtin_amdgcn_exp2f(m_reg - mn); m_reg = mn; }
#pragma unroll
  for (int r = 0; r < 16; ++r) p0[r] = p0[r] - mn;
#pragma unroll
  for (int r = 0; r < 16; ++r) p1[r] = p1[r] - mn;
#pragma unroll
  for (int r = 0; r < 16; ++r) p0[r] = __builtin_amdgcn_exp2f(p0[r]);
}
__device__ __forceinline__ void finishSM(f32x16& p0, f32x16& p1, float alpha, float& l_reg, bf16x8& pa0, bf16x8& pa1, bf16x8& pa2, bf16x8& pa3) {
#pragma unroll
  for (int r = 0; r < 16; ++r) p1[r] = __builtin_amdgcn_exp2f(p1[r]);
  float ps = 0;
#pragma unroll
  for (int r = 0; r < 16; ++r) ps += p0[r];
#pragma unroll
  for (int r = 0; r < 16; ++r) ps += p1[r];
  { auto rr = __builtin_amdgcn_permlane32_swap(__float_as_uint(ps), __float_as_uint(ps), false, false);
    ps = __uint_as_float(rr[0]) + __uint_as_float(rr[1]); }
  l_reg = l_reg * alpha + ps;
#define PK4(P, BASE, OUT) do { unsigned a0 = cvtpk(P[BASE + 0], P[BASE + 1]), a1 = cvtpk(P[BASE + 2], P[BASE + 3]);   \
    unsigned b0 = cvtpk(P[BASE + 4], P[BASE + 5]), b1 = cvtpk(P[BASE + 6], P[BASE + 7]);                              \
    auto r0 = __builtin_amdgcn_permlane32_swap(a0, b0, false, false); auto r1 = __builtin_amdgcn_permlane32_swap(a1, b1, false, false); \
    u32x4 w = {r0[0], r1[0], r0[1], r1[1]}; OUT = *reinterpret_cast<bf16x8*>(&w); } while (0)
  PK4(p0, 0, pa0); PK4(p0, 8, pa1); PK4(p1, 0, pa2); PK4(p1, 8, pa3);
#undef PK4
}
__device__ __forceinline__ void qkt(f32x16& p0, f32x16& p1, const bf16* Ks, const bf16x8* qr, int r32, int hi) {
  p0 = f32x16{}; p1 = f32x16{};
#pragma unroll
  for (int d0 = 0; d0 < 8; ++d0) { int cb = (d0 * 16 + hi * 8) * 2;
    bf16x8 b0 = *reinterpret_cast<const bf16x8*>((const char*)Ks + KSWZ(r32, cb));
    bf16x8 b1 = *reinterpret_cast<const bf16x8*>((const char*)Ks + KSWZ(32 + r32, cb));
    p0 = __builtin_amdgcn_mfma_f32_32x32x16_bf16(b0, qr[d0], p0, 0, 0, 0);
    p1 = __builtin_amdgcn_mfma_f32_32x32x16_bf16(b1, qr[d0], p1, 0, 0, 0); }
}
__device__ __forceinline__ int v_st(int k, int c) { const int kk = (k & ~0xC) | ((k & 4) << 1) | ((k & 8) >> 1); return ((kk >> 3) * 4 + (c >> 5)) * 512 + ((kk & 7) * 32 + (c & 31)) * 2; }
__device__ __forceinline__ int v_rd_base(int lane) { return ((lane & 3) << 3) | (((lane >> 2) & 3) << 6) | (((lane >> 4) & 1) << 5) | (((lane >> 5) & 1) << 8); }
constexpr int v_rd_off(int d0, int ks, int half) { return d0 * 512 + ks * 4096 + half * 2048; }
template <int OFF> __device__ __forceinline__ s16x4 tr_read(int vb) {
  s16x4 r; asm volatile("ds_read_b64_tr_b16 %0, %1 offset:%2" : "=&v"(r) : "v"(vb), "i"(OFF) : "memory"); return r;
}
template <int D0> __device__ __forceinline__ void pv_one(f32x16& od, int vb, bf16x8 pa0, bf16x8 pa1, bf16x8 pa2, bf16x8 pa3) {
  const s16x4 l0 = tr_read<v_rd_off(D0, 0, 0)>(vb), h0 = tr_read<v_rd_off(D0, 0, 1)>(vb), l1 = tr_read<v_rd_off(D0, 1, 0)>(vb), h1 = tr_read<v_rd_off(D0, 1, 1)>(vb);
  const s16x4 l2 = tr_read<v_rd_off(D0, 2, 0)>(vb), h2 = tr_read<v_rd_off(D0, 2, 1)>(vb), l3 = tr_read<v_rd_off(D0, 3, 0)>(vb), h3 = tr_read<v_rd_off(D0, 3, 1)>(vb);
  asm volatile("s_waitcnt lgkmcnt(0)" ::: "memory"); SBAR();
#define PK(L, H) (bf16x8){L[0], L[1], L[2], L[3], H[0], H[1], H[2], H[3]}
  od = __builtin_amdgcn_mfma_f32_32x32x16_bf16(pa0, PK(l0, h0), od, 0, 0, 0);
  od = __builtin_amdgcn_mfma_f32_32x32x16_bf16(pa1, PK(l1, h1), od, 0, 0, 0);
  od = __builtin_amdgcn_mfma_f32_32x32x16_bf16(pa2, PK(l2, h2), od, 0, 0, 0);
  od = __builtin_amdgcn_mfma_f32_32x32x16_bf16(pa3, PK(l3, h3), od, 0, 0, 0);
#undef PK
}
template <int D0> __device__ __forceinline__ void pv_one_lean(f32x16& od, int vb, bf16x8 pa0, bf16x8 pa1, bf16x8 pa2, bf16x8 pa3) {
#define PK(L, H) (bf16x8){L[0], L[1], L[2], L[3], H[0], H[1], H[2], H[3]}
  { const s16x4 l0 = tr_read<v_rd_off(D0, 0, 0)>(vb), h0 = tr_read<v_rd_off(D0, 0, 1)>(vb), l1 = tr_read<v_rd_off(D0, 1, 0)>(vb), h1 = tr_read<v_rd_off(D0, 1, 1)>(vb);
    asm volatile("s_waitcnt lgkmcnt(0)" ::: "memory"); SBAR();
    od = __builtin_amdgcn_mfma_f32_32x32x16_bf16(pa0, PK(l0, h0), od, 0, 0, 0);
    od = __builtin_amdgcn_mfma_f32_32x32x16_bf16(pa1, PK(l1, h1), od, 0, 0, 0); }
  { const s16x4 l2 = tr_read<v_rd_off(D0, 2, 0)>(vb), h2 = tr_read<v_rd_off(D0, 2, 1)>(vb), l3 = tr_read<v_rd_off(D0, 3, 0)>(vb), h3 = tr_read<v_rd_off(D0, 3, 1)>(vb);
    asm volatile("s_waitcnt lgkmcnt(0)" ::: "memory"); SBAR();
    od = __builtin_amdgcn_mfma_f32_32x32x16_bf16(pa2, PK(l2, h2), od, 0, 0, 0);
    od = __builtin_amdgcn_mfma_f32_32x32x16_bf16(pa3, PK(l3, h3), od, 0, 0, 0); }
#undef PK
}
__device__ __forceinline__ void pv_d0_lean(f32x16* o, int vb, bf16x8 pa0, bf16x8 pa1, bf16x8 pa2, bf16x8 pa3) {
  pv_one_lean<0>(o[0], vb, pa0, pa1, pa2, pa3); pv_one_lean<1>(o[1], vb, pa0, pa1, pa2, pa3); pv_one_lean<2>(o[2], vb, pa0, pa1, pa2, pa3); pv_one_lean<3>(o[3], vb, pa0, pa1, pa2, pa3);
}
__device__ __forceinline__ void pv_d0(f32x16* o, int vb, bf16x8 pa0, bf16x8 pa1, bf16x8 pa2, bf16x8 pa3) {
  pv_one<0>(o[0], vb, pa0, pa1, pa2, pa3); pv_one<1>(o[1], vb, pa0, pa1, pa2, pa3); pv_one<2>(o[2], vb, pa0, pa1, pa2, pa3); pv_one<3>(o[3], vb, pa0, pa1, pa2, pa3);
}

struct UA {
  const bf16* Q; long ldq;
  const bf16* K; const bf16* V; long ldk;
  int NT;
  int j0;
  int qk0;
  float slope2;
  int qrow0, krow0;
  const float* tbl;
  bf16* Y; long ldy; const bf16* Z; long ldz;
  float* O; long ldo;
  float* L; long ldl;
};

template <int MODE, int SDEPTH>
__device__ __forceinline__ void attn_unit(const UA& a, char* lds, const int wave_in) {
  int tid_ = fresh_tid(wave_in); asm volatile("" : "+v"(tid_));
  const int tid = tid_, wid = __builtin_amdgcn_readfirstlane(tid >> 6), lane = tid & 63, r32 = lane & 31, hi = lane >> 5;
  bf16* V_lds = (bf16*)lds; bf16* K_lds = (bf16*)(lds + 2 * SHM_V);
  float* ws = (float*)(lds + OFF_WS) + wid * 64; float* li_l = ws; float* al_l = ws + 32;
  float* tbl = (float*)(lds + OFF_TBL) + 64;
  if (MODE == M_NA) { __syncthreads(); for (int i = tid; i < 15 * 31; i += 512) tbl[i] = a.tbl[i] * LOG2E; }
  float m_reg = -1e30f, l_reg = 0; f32x16 o[4] = {}; bf16x8 qr[8];
  const bf16* Qw = a.Q + (long)(wid * QBLK + r32) * a.ldq + hi * 8;
#pragma unroll
  for (int d0 = 0; d0 < 8; ++d0) qr[d0] = *reinterpret_cast<const bf16x8*>(Qw + d0 * 16);
  const int sr = tid >> 4, sc = (tid & 15) * 8, vst0 = v_st(sr, sc), vst1 = v_st(32 + sr, sc);
  const int vb0 = (int)(uintptr_t)V_lds + v_rd_base(lane);
  const bf16* Kh = a.K; const bf16* Vh = a.V; const long LDK = a.ldk;
  struct { bf16x8 vs0, vs1, ks0, ks1; } sr_[SDEPTH];
#define SLOAD(i, k0) do { sr_[i].vs0 = *reinterpret_cast<const bf16x8*>(&Vh[(long)((k0) + sr) * LDK + sc]); sr_[i].vs1 = *reinterpret_cast<const bf16x8*>(&Vh[(long)((k0) + 32 + sr) * LDK + sc]); \
    sr_[i].ks0 = *reinterpret_cast<const bf16x8*>(&Kh[(long)((k0) + sr) * LDK + sc]); sr_[i].ks1 = *reinterpret_cast<const bf16x8*>(&Kh[(long)((k0) + 32 + sr) * LDK + sc]); } while (0)
#define SWRITE(b, i) do { *(bf16x8*)((char*)V_lds + (b) * SHM_V + vst0) = sr_[i].vs0;          \
    *(bf16x8*)((char*)V_lds + (b) * SHM_V + vst1) = sr_[i].vs1; int kc = sc * 2;               \
    *(bf16x8*)((char*)K_lds + (b) * SHM_K + KSWZ(sr, kc)) = sr_[i].ks0;                       \
    *(bf16x8*)((char*)K_lds + (b) * SHM_K + KSWZ(32 + sr, kc)) = sr_[i].ks1; } while (0)
#define SWAIT() do { if constexpr (SDEPTH == 2) asm volatile("s_waitcnt vmcnt(4)" ::: "memory"); else asm volatile("s_waitcnt vmcnt(0)" ::: "memory"); } while (0)
#define RESC(a_) do { if (__any((a_) < 1.f)) { if (hi == 0) al_l[r32] = (a_); asm volatile("s_waitcnt lgkmcnt(0)" ::: "memory"); \
    _Pragma("unroll") for (int d = 0; d < 4; ++d) _Pragma("unroll") for (int r = 0; r < 16; ++r) o[d][r] *= al_l[crow(r, hi)]; } } while (0)
  const float NEG_INF = -__builtin_inff();
  const int qkrel = a.qk0 + wid * 32 + r32 - 4 * hi;
  const float nslope = -a.slope2;
  const int qgr = a.qrow0 + (wid >> 1), cq = 32 * (wid & 1) + r32;
  const int c0 = min(max(cq - 8, 0), 48), r0 = min(max(qgr - 4, 0), 56);
#define MOD(P0, P1, J) do { \
    if (MODE == M_ALIBI || MODE == M_DIL) { const float rel = (float)(qkrel - (J) * 64); \
      _Pragma("unroll") for (int r = 0; r < 16; ++r) { const float cr = (float)((r & 3) + 8 * (r >> 2)); const float d0_ = fabsf(rel - cr), d1_ = fabsf(rel - cr - 32.f); \
        float v0_ = fmaf(nslope, d0_, P0[r]), v1_ = fmaf(nslope, d1_, P1[r]); \
        if (MODE == M_DIL) { v0_ = (d0_ <= 64.f) ? v0_ : NEG_INF; v1_ = (d1_ <= 64.f) ? v1_ : NEG_INF; } \
        P0[r] = v0_; P1[r] = v1_; } } \
    if (MODE == M_NA) { const int kr = a.krow0 + (J); const bool rv = (kr >= r0) && (kr < r0 + 8); \
      if (!rv) { _Pragma("unroll") for (int r = 0; r < 16; ++r) { P0[r] = NEG_INF; P1[r] = NEG_INF; } } \
      else { const float* tp = tbl + (kr - qgr + 7) * 31 + (4 * hi - cq + 15); const int kcb = 4 * hi - c0; \
        _Pragma("unroll") for (int r = 0; r < 16; ++r) { const int cr = (r & 3) + 8 * (r >> 2); \
          const bool ok0 = (unsigned)(kcb + cr) < 16u, ok1 = (unsigned)(kcb + cr + 32) < 16u; \
          const float b0_ = tp[cr], b1_ = tp[cr + 32]; \
          P0[r] = ok0 ? P0[r] + b0_ : NEG_INF; P1[r] = ok1 ? P1[r] + b1_ : NEG_INF; } } } \
  } while (0)
  f32x16 pA0, pA1, pB0, pB1; float mnA, mnB, alA, alB; bf16x8 pa0, pa1, pa2, pa3; const int NT = a.NT;
  constexpr int SE = 0, SO = SDEPTH - 1;
  SLOAD(SE, 0); asm volatile("s_waitcnt vmcnt(0)" ::: "memory"); SWRITE(0, SE); __syncthreads();
  qkt(pA0, pA1, K_lds, qr, r32, hi); MOD(pA0, pA1, 0); partialSM(pA0, pA1, m_reg, mnA, alA);
  SLOAD(SO, KVBLK); if constexpr (SDEPTH == 2) { if (2 < NT) SLOAD(SE, 2 * KVBLK); }
  SWAIT(); SWRITE(1, SO); __syncthreads();
  for (int j = 1; j + 1 < NT; j += 2) {
    SBAR(); qkt(pB0, pB1, (bf16*)((char*)K_lds + SHM_K), qr, r32, hi); MOD(pB0, pB1, j);
    finishSM(pA0, pA1, alA, l_reg, pa0, pa1, pa2, pa3); SBAR();
    SLOAD(SO, (j + SDEPTH) * KVBLK); SBAR();
    pv_d0(o, vb0, pa0, pa1, pa2, pa3); partialSM(pB0, pB1, m_reg, mnB, alB);
    __syncthreads(); SWAIT(); SWRITE(0, SE);
    RESC(alB); __syncthreads();
    SBAR(); qkt(pA0, pA1, K_lds, qr, r32, hi); MOD(pA0, pA1, j + 1);
    finishSM(pB0, pB1, alB, l_reg, pa0, pa1, pa2, pa3); SBAR();
    if (SDEPTH == 1 || j + 3 < NT) SLOAD(SE, (j + 1 + SDEPTH) * KVBLK); SBAR();
    pv_d0(o, vb0 + (int)SHM_V, pa0, pa1, pa2, pa3); partialSM(pA0, pA1, m_reg, mnA, alA);
    __syncthreads(); SWAIT(); SWRITE(1, SO);
    RESC(alA); __syncthreads();
  }
  SBAR(); qkt(pB0, pB1, (bf16*)((char*)K_lds + SHM_K), qr, r32, hi); MOD(pB0, pB1, NT - 1);
  finishSM(pA0, pA1, alA, l_reg, pa0, pa1, pa2, pa3); SBAR();
  pv_d0(o, vb0, pa0, pa1, pa2, pa3); partialSM(pB0, pB1, m_reg, mnB, alB);
  __syncthreads(); RESC(alB);
  finishSM(pB0, pB1, alB, l_reg, pa0, pa1, pa2, pa3); SBAR();
  pv_d0(o, vb0 + (int)SHM_V, pa0, pa1, pa2, pa3);
  if (hi == 0) li_l[r32] = l_reg; asm volatile("s_waitcnt lgkmcnt(0)" ::: "memory");
  float rli[16];
#pragma unroll
  for (int r = 0; r < 16; ++r) rli[r] = __builtin_amdgcn_rcpf(li_l[crow(r, hi)]);
  if (MODE == M_NA || MODE == M_DENSE) {
#pragma unroll
    for (int r = 0; r < 16; ++r) { const long orow = wid * QBLK + crow(r, hi);
#pragma unroll
      for (int d0 = 0; d0 < 4; ++d0) { const float z = bf2f(a.Z[orow * a.ldz + d0 * 32 + r32]); a.Y[orow * a.ldy + d0 * 32 + r32] = f2bf1(o[d0][r] * rli[r] * z); } }
  } else {
#pragma unroll
    for (int r = 0; r < 16; ++r) { const long orow = wid * QBLK + crow(r, hi);
#pragma unroll
      for (int d0 = 0; d0 < 4; ++d0) a.O[orow * a.ldo + d0 * 32 + r32] = o[d0][r] * rli[r]; }
    if (MODE == M_DIL) { if (hi == 0) a.L[(long)(wid * QBLK + r32) * a.ldl] = m_reg + __builtin_amdgcn_logf(l_reg); }
  }
#undef SLOAD
#undef SWRITE
#undef SWAIT
#undef RESC
#undef MOD
}

#define ATT_LAS __attribute__((address_space(3)))
#ifndef PINGPONG_SPLIT
#define PINGPONG_SPLIT 4
#endif
template <int MODE, int NVH>
__device__ __forceinline__ void attn_unit_dma(const UA& a, char* lds, int wsoff, const int wave_in) {
  int tid_ = fresh_tid(wave_in); asm volatile("" : "+v"(tid_));
  const int tid = tid_, wid = __builtin_amdgcn_readfirstlane(tid >> 6), lane = tid & 63, r32 = lane & 31, hi = lane >> 5;
  constexpr int KB = 16384, VB = NVH * 16384, OFF_V2 = 2 * KB;
  char* K_lds = lds;
  float* ws = (float*)(lds + wsoff) + wid * 64; float* li_l = ws; float* al_l = ws + 32;
  float* tbl = (float*)(lds + wsoff + 2048) + 64;
  if (MODE == M_NA) { for (int i = tid; i < 15 * 31; i += 512) tbl[i] = a.tbl[i] * LOG2E; }
  float m_reg = -1e30f, l_reg = 0; f32x16 o[4 * NVH]; bf16x8 qr[8];
#pragma unroll
  for (int d = 0; d < 4 * NVH; ++d) o[d] = f32x16{};
  const bf16* Qw = a.Q + (long)(wid * QBLK + r32) * a.ldq + hi * 8;
#pragma unroll
  for (int d0 = 0; d0 < 8; ++d0) qr[d0] = *reinterpret_cast<const bf16x8*>(Qw + d0 * 16);
  const int vb0 = (int)(uintptr_t)(lds + OFF_V2) + v_rd_base(lane);
  const unsigned ldkb = (unsigned)(a.ldk * 2);
  unsigned koff[2], voff[2 * NVH];
#pragma unroll
  for (int i = 0; i < 2; ++i) { const int row = (wid * 2 + i) * 4 + (lane >> 4), c = (lane & 15) ^ (row & 7); koff[i] = (unsigned)row * ldkb + (unsigned)c * 16u; }
#pragma unroll
  for (int i = 0; i < 2 * NVH; ++i) { const int vb = wid * 2 * NVH + i, half = vb >> 4, b = (vb & 15) * 1024 + lane * 16;
    const int sub = b >> 9, e = (b & 511) >> 1, kk = (sub >> 2) * 8 + (e >> 5), c = (sub & 3) * 32 + (e & 31);
    const int k = (kk & ~0xC) | ((kk & 4) << 1) | ((kk & 8) >> 1);
    voff[i] = (unsigned)k * ldkb + (unsigned)(half * 128 + c) * 2u; }
  const char* Kb = (const char*)a.K; const char* Vb = (const char*)a.V; const size_t tstep = (size_t)KVBLK * ldkb;
  ATT_LAS unsigned char* ldl = (ATT_LAS unsigned char*)lds;
#define TROT(j) (((j) + a.j0 >= NT) ? (j) + a.j0 - NT : (j) + a.j0)
#define DMA(j, ks, vs) do { const int jt_ = TROT(j); const char* kt_ = Kb + (size_t)jt_ * tstep; const char* vt_ = Vb + (size_t)jt_ * tstep; \
    _Pragma("unroll") for (int i_ = 0; i_ < 2; ++i_) __builtin_amdgcn_global_load_lds((const unsigned*)(kt_ + koff[i_]), (ATT_LAS unsigned*)(ldl + (ks) * KB + (wid * 2 + i_) * 1024), 16, 0, 0); \
    _Pragma("unroll") for (int i_ = 0; i_ < 2 * NVH; ++i_) __builtin_amdgcn_global_load_lds((const unsigned*)(vt_ + voff[i_]), (ATT_LAS unsigned*)(ldl + OFF_V2 + (vs) * VB + (wid * 2 * NVH + i_) * 1024), 16, 0, 0); } while (0)
#define RESC(a_) do { if (__any((a_) < 1.f)) { if (hi == 0) al_l[r32] = (a_); asm volatile("s_waitcnt lgkmcnt(0)" ::: "memory"); \
    _Pragma("unroll") for (int d = 0; d < 4 * NVH; ++d) _Pragma("unroll") for (int r = 0; r < 16; ++r) o[d][r] *= al_l[crow(r, hi)]; } } while (0)
  const float NEG_INF = -__builtin_inff();
  const int qkrel = a.qk0 + wid * 32 + r32 - 4 * hi;
  const float nslope = -a.slope2;
  const int qgr = a.qrow0 + (wid >> 1), cq = 32 * (wid & 1) + r32;
  const int c0 = min(max(cq - 8, 0), 48), r0 = min(max(qgr - 4, 0), 56);
#define ROWOK(J) ((MODE == M_NA) ? ((a.krow0 + (J)) >= r0 && (a.krow0 + (J)) < r0 + 8) : (MODE == M_DIL) ? ((J) * 64 <= a.qk0 + wid * 32 + 95 && (J) * 64 + 127 >= a.qk0 + wid * 32) : true)
#define MOD(P0, P1, J) do { \
    if (MODE == M_ALIBI || MODE == M_DIL) { const float rel = (float)(qkrel - (J) * 64); \
      _Pragma("unroll") for (int r = 0; r < 16; ++r) { const float cr = (float)((r & 3) + 8 * (r >> 2)); const float d0_ = fabsf(rel - cr), d1_ = fabsf(rel - cr - 32.f); \
        float v0_ = fmaf(nslope, d0_, P0[r]), v1_ = fmaf(nslope, d1_, P1[r]); \
        if (MODE == M_DIL) { v0_ = (d0_ <= 64.f) ? v0_ : NEG_INF; v1_ = (d1_ <= 64.f) ? v1_ : NEG_INF; } \
        P0[r] = v0_; P1[r] = v1_; } } \
    if (MODE == M_NA) { const int kr = a.krow0 + (J); const float* tp = tbl + (kr - qgr + 7) * 31 + (4 * hi - cq + 15); const int kcb = 4 * hi - c0; \
      _Pragma("unroll") for (int r = 0; r < 16; ++r) { const int cr = (r & 3) + 8 * (r >> 2); \
        const bool ok0 = (unsigned)(kcb + cr) < 16u, ok1 = (unsigned)(kcb + cr + 32) < 16u; \
        const float b0_ = tp[cr], b1_ = tp[cr + 32]; \
        P0[r] = ok0 ? P0[r] + b0_ : NEG_INF; P1[r] = ok1 ? P1[r] + b1_ : NEG_INF; } } \
  } while (0)
  f32x16 p0, p1; float mn, al; bf16x8 pa0, pa1, pa2, pa3; const int NT = a.NT;
#define TOP(j, ks, vs) do { asm volatile("s_waitcnt vmcnt(0)" ::: "memory");        \
    __builtin_amdgcn_s_barrier(); asm volatile("" ::: "memory");                    \
    if ((j) + 1 < NT) DMA((j) + 1, (ks) ^ 1, ((vs) == 2) ? 0 : (vs) + 1); } while (0)
#define QKSM(j, ks) do { SBAR(); qkt(p0, p1, (const bf16*)(K_lds + (ks) * KB), qr, r32, hi); MOD(p0, p1, TROT(j)); \
    partialSM(p0, p1, m_reg, mn, al); RESC(al); finishSM(p0, p1, al, l_reg, pa0, pa1, pa2, pa3); SBAR(); } while (0)
#define PVS(vs) do { _Pragma("unroll") for (int h = 0; h < NVH; ++h) { if (NVH == 2) pv_d0_lean(o + 4 * h, vb0 + (vs) * VB + h * 16384, pa0, pa1, pa2, pa3); else pv_d0(o + 4 * h, vb0 + (vs) * VB + h * 16384, pa0, pa1, pa2, pa3); } } while (0)
  DMA(0, 0, 0);
  if (wid < PINGPONG_SPLIT) {
    int vs = 0;
    for (int j = 0; j < NT; ++j) { const int ks = j & 1;
      TOP(j, ks, vs); if (ROWOK(TROT(j))) { QKSM(j, ks); PVS(vs); }
      vs = (vs == 2) ? 0 : vs + 1; }
  } else {
    int vs = 0, vprev = 0; bool pend = false;
    for (int j = 0; j < NT; ++j) { const int ks = j & 1;
      TOP(j, ks, vs); if (pend) PVS(vprev); pend = ROWOK(TROT(j)); if (pend) QKSM(j, ks);
      vprev = vs; vs = (vs == 2) ? 0 : vs + 1; }
    if (pend) PVS(vprev);
  }
  if (hi == 0) li_l[r32] = l_reg; asm volatile("s_waitcnt lgkmcnt(0)" ::: "memory");
  float rli[16];
#pragma unroll
  for (int r = 0; r < 16; ++r) rli[r] = __builtin_amdgcn_rcpf(li_l[crow(r, hi)]);
  if (MODE == M_DENSE || MODE == M_NA) {
#pragma unroll
    for (int r = 0; r < 16; ++r) { const long orow = wid * QBLK + crow(r, hi);
#pragma unroll
      for (int d0 = 0; d0 < 4 * NVH; ++d0) { const float z = bf2f(a.Z[orow * a.ldz + d0 * 32 + r32]); a.Y[orow * a.ldy + d0 * 32 + r32] = f2bf1(o[d0][r] * rli[r] * z); } }
  } else {
#pragma unroll
    for (int r = 0; r < 16; ++r) { const long orow = wid * QBLK + crow(r, hi);
#pragma unroll
      for (int d0 = 0; d0 < 4 * NVH; ++d0) a.O[orow * a.ldo + d0 * 32 + r32] = o[d0][r] * rli[r]; }
    if (MODE == M_DIL) { if (hi == 0) a.L[(long)(wid * QBLK + r32) * a.ldl] = m_reg + __builtin_amdgcn_logf(l_reg); }
  }
  __builtin_amdgcn_s_barrier(); asm volatile("" ::: "memory");
#undef DMA
#undef RESC
#undef MOD
#undef TOP
#undef QKSM
#undef PVS
#undef ROWOK
#undef TROT
}
#undef KSWZ
#undef SBAR
}
constexpr int NWAVES = 8;
#ifndef MK_ONE_LAUNCH
#define MK_ONE_LAUNCH 1
#endif
constexpr bool ONE_LAUNCH = MK_ONE_LAUNCH != 0;

constexpr int DM = 4096, NB = 2, SEQ = 4096, DEPTH = 2, HD = 128, GRID_W = 64;
constexpr int M = NB * SEQ;
constexpr int LDP = 32256;
constexpr float RMS_EPS = 1e-6f;
constexpr float QSCALE = 0.08838834764831845f * 1.4426950408889634f;
constexpr int CA_Q = 0, CA_K = 1024, CA_V = 2048, CA_Z = 3072;
constexpr int CB_Q = 4096, CB_K = 5120, CB_V = 5376, CB_Z = 5632;
constexpr int CC_Q = 6656, CC_K = 7680, CC_V = 8704, CC_Z = 9728;
constexpr int CD_Q = 10752, CD_K = 12288, CD_V = 13824, CD_Z = 15360;
constexpr int CG = 15872;

constexpr size_t MiB = 1u << 20;
constexpr size_t WS_CTL = 0, CTL_ZERO_BYTES = 1 * MiB;
constexpr int PK = DM + 64, PY = 1024 + 64;
constexpr size_t WS_WIN = 2 * MiB, WIN_LAYER = 256 * MiB;
constexpr size_t WBR_BLOCK = 9 * MiB;
constexpr size_t WS_WBR = WS_WIN + 2 * WIN_LAYER, WBR_LAYER = 4 * WBR_BLOCK;
constexpr size_t WS_WOUT = WS_WBR + 2 * WBR_LAYER, WOUT_LAYER = 33 * MiB;
constexpr size_t WS_XN = WS_WOUT + 2 * WOUT_LAYER;
constexpr size_t WS_PROJ = WS_XN + 66 * MiB;
constexpr size_t WS_OC = WS_PROJ + 504 * MiB;
constexpr size_t WS_OD = WS_OC + 64 * MiB;
constexpr size_t WS_LSE = WS_OD + 48 * MiB;
constexpr size_t Y_BLOCK = 17 * MiB;
constexpr size_t WS_YA = WS_LSE + 1 * MiB, WS_YB = WS_YA + Y_BLOCK, WS_YC = WS_YB + Y_BLOCK, WS_YD = WS_YC + Y_BLOCK;
constexpr size_t WS_MG = WS_YD + Y_BLOCK;
constexpr size_t WS_X1 = WS_MG + 66 * MiB;
constexpr int P8 = DM + 128;
constexpr size_t WS_XN8 = WS_X1 + 128 * MiB;
constexpr size_t WS_SA = WS_XN8 + 33 * MiB;
constexpr int N8 = 110 * 256;
constexpr size_t WS_WG8 = WS_SA + 1 * MiB, WG8_LAYER = 114 * MiB;
constexpr size_t WS_SB = WS_WG8 + 2 * WG8_LAYER;
constexpr size_t WS_MG8 = WS_SB + 1 * MiB;
constexpr size_t WS_SM = WS_MG8 + 33 * MiB;
constexpr size_t WS_WO8 = WS_SM + 1 * MiB, WO8_LAYER = 17 * MiB;
constexpr size_t WS_SO = WS_WO8 + 2 * WO8_LAYER;
constexpr size_t WS_END = WS_SO + 1 * MiB;
static_assert((size_t)DM * P8 <= WO8_LAYER, "d_ws map (int8 w_out)");
static_assert((size_t)M * P8 <= 33 * MiB && (size_t)N8 * P8 <= WG8_LAYER && (size_t)2 * N8 * 4 <= 1 * MiB, "d_ws map (int8)");
static_assert((size_t)LDP * PK * 2 <= WIN_LAYER && (size_t)DM * PY * 2 <= WBR_BLOCK && (size_t)DM * PK * 2 <= WOUT_LAYER && (size_t)M * PK * 2 <= 66 * MiB && (size_t)M * PY * 2 <= Y_BLOCK, "d_ws map");
constexpr int CW_BAR = 4096;

constexpr int RING_OFF = 0, RING_BYTES = 131072;
constexpr int LDSCTL_OFF = RING_BYTES, MISC_OFF = LDSCTL_OFF + 320;
constexpr int XTAB_OFF = RING_BYTES + 1024;
constexpr int LDS_BYTES = 147456;
static_assert(att::SHM_ATTN <= RING_BYTES, "attention scratch fits the ring region");

#define LAS __attribute__((address_space(3)))
typedef unsigned short bf16;
typedef unsigned v4u __attribute__((ext_vector_type(4)));
typedef unsigned v2u __attribute__((ext_vector_type(2)));
typedef float f32x4 __attribute__((ext_vector_type(4)));
#define LDS_WAIT() asm volatile("s_waitcnt lgkmcnt(0)" ::: "memory")
__device__ __forceinline__ unsigned f2bf(float f) { unsigned u = __builtin_bit_cast(unsigned, f); return (u + 0x7fffu + ((u >> 16) & 1u)) >> 16; }
__device__ __forceinline__ unsigned pk2(float lo, float hi) { return f2bf(lo) | (f2bf(hi) << 16); }
__device__ __forceinline__ float bflo(unsigned w) { return __builtin_bit_cast(float, w << 16); }
__device__ __forceinline__ float bfhi(unsigned w) { return __builtin_bit_cast(float, w & 0xffff0000u); }
#define XB_TMO      128
#define XB_XCNT(j)  (256  + 64 * (j))
#define XB_XSUB(j)  (1280 + 64 * (j))
#define XB_XGEN(j)  (2304 + 64 * (j))
#define XB_TOP      3328
#define XB_TOPGEN   3392
#define XCD_BAR_WORDS 3456
#define XB_SPIN_CAP (1u << 22)

__device__ __forceinline__ unsigned xb_ld(unsigned* p)              { return __hip_atomic_load(p, __ATOMIC_RELAXED, __HIP_MEMORY_SCOPE_AGENT); }
__device__ __forceinline__ unsigned xb_add(unsigned* p, unsigned v) { return __hip_atomic_fetch_add(p, v, __ATOMIC_RELAXED, __HIP_MEMORY_SCOPE_AGENT); }
__device__ __forceinline__ unsigned xb_xcc_id() { return (unsigned)__builtin_amdgcn_s_getreg((3 << 11) | 20) & 0xFu; }
#define XB_SPIN(cond, bar) do { unsigned _sp = 0; while (cond) { __builtin_amdgcn_s_sleep(1); \
    if ((++_sp & 255u) == 0u) { if (xb_ld(&(bar)[XB_TMO])) break; if (_sp > XB_SPIN_CAP) { atomicAdd(&(bar)[XB_TMO], 1u); break; } } } } while (0)

struct XcdBarrier {
    unsigned* bar; unsigned x;
    volatile LAS unsigned* st;
};

__device__ __forceinline__ XcdBarrier xcd_barrier_post(unsigned* bar, volatile LAS unsigned* st) {
    XcdBarrier b; b.bar = bar; b.x = xb_xcc_id(); b.st = st;
    if (threadIdx.x == 0) (void)xb_add(&bar[XB_XCNT(b.x)], 1u);
    return b;
}
__device__ __forceinline__ void xcd_barrier_complete(unsigned* bar, unsigned x, unsigned& nloc, unsigned& nx) {
    const unsigned G = gridDim.x * gridDim.y * gridDim.z;
    unsigned sum, cnt, mine, sp = 0u;
    for (;;) {
        sum = 0u; cnt = 0u; mine = 0u;
#pragma unroll 1
        for (unsigned j = 0; j < 16; ++j) { const unsigned c = xb_ld(&bar[XB_XCNT(j)]); sum += c; cnt += (c > 0u) ? 1u : 0u; mine = (j == x) ? c : mine; }
        if (sum == G) break;
        __builtin_amdgcn_s_sleep(1);
        if ((++sp & 255u) == 0u) { if (xb_ld(&bar[XB_TMO])) break; if (sp > XB_SPIN_CAP) { atomicAdd(&bar[XB_TMO], 1u); break; } }
    }
    nloc = mine > 0u ? mine : 1u; nx = cnt > 0u ? cnt : 1u;
}

__device__ __noinline__ void xcd_barrier(const XcdBarrier b, const bool leader  ) {
    asm volatile("s_waitcnt vmcnt(0)" ::: "memory");
    __syncthreads();
    if (leader) {
        unsigned* bar = b.bar;
        __builtin_amdgcn_s_waitcnt(0);
        unsigned nloc = b.st[0], nx = b.st[1];
        if (nloc == 0u) { xcd_barrier_complete(bar, b.x, nloc, nx); b.st[0] = nloc; b.st[1] = nx; }
        const unsigned old = xb_add(&bar[XB_XSUB(b.x)], 1u);
        const unsigned gen = old / nloc;
        if (old + 1u == (gen + 1u) * nloc) {
            __builtin_amdgcn_fence(__ATOMIC_RELEASE, "agent");
            asm volatile("s_waitcnt vmcnt(0)" ::: "memory");
            const unsigned og = xb_add(&bar[XB_TOP], 1u);
            const unsigned tg = og / nx;
            if (og + 1u == (tg + 1u) * nx) xb_add(&bar[XB_TOPGEN], 1u);
            else XB_SPIN(xb_ld(&bar[XB_TOPGEN]) == tg, bar);
            __builtin_amdgcn_fence(__ATOMIC_ACQUIRE, "agent");
            xb_add(&bar[XB_XGEN(b.x)], 1u);
            asm volatile("s_waitcnt vmcnt(0)" ::: "memory");
        } else {
            XB_SPIN(xb_ld(&bar[XB_XGEN(b.x)]) == gen, bar);
            __builtin_amdgcn_fence(__ATOMIC_ACQUIRE, "agent");
            asm volatile("s_waitcnt vmcnt(0)" ::: "memory");
        }
    }
    __syncthreads();
}
struct Frame {
    LAS unsigned char* lds;
    volatile LAS unsigned* MISC;
    unsigned* ctl;
    int tid, lane, wave;
    int vcu, G;
};
__device__ __forceinline__ float wave_sum(float v, const int lane) {
#pragma unroll
    for (int o = 1; o < 64; o <<= 1) v += __builtin_bit_cast(float, __builtin_amdgcn_ds_bpermute((lane ^ o) << 2, __builtin_bit_cast(int, v)));
    return v;
}
__device__ __forceinline__ float wave_max(float v, const int lane) {
#pragma unroll
    for (int o = 1; o < 64; o <<= 1) v = fmaxf(v, __builtin_bit_cast(float, __builtin_amdgcn_ds_bpermute((lane ^ o) << 2, __builtin_bit_cast(int, v))));
    return v;
}
__device__ __forceinline__ unsigned q8(float a, float b, float c, float d, float inv) {
    const int qa = (int)__builtin_rintf(a * inv), qb = (int)__builtin_rintf(b * inv), qc = (int)__builtin_rintf(c * inv), qd = (int)__builtin_rintf(d * inv);
    return (unsigned)(qa & 255) | ((unsigned)(qb & 255) << 8) | ((unsigned)(qc & 255) << 16) | ((unsigned)(qd & 255) << 24);
}
__device__ __forceinline__ void p0_transpose_item(const float* W, int K, int N, bf16* WT, int ldt, LAS float* scr, int item, int lane, int noff = 0, int ncols = 0) {
    const int nblk = (ncols ? ncols : N) / 32, kb = item / nblk, nb = item % nblk, k0 = 64 * kb, n0 = noff + 32 * nb;
    float v[32];
#pragma unroll
    for (int i = 0; i < 32; ++i) { const int kk = 2 * i + (lane >> 5); v[i] = __builtin_nontemporal_load(W + (size_t)(k0 + kk) * N + n0 + (lane & 31)); }
#pragma unroll
    for (int i = 0; i < 32; ++i) { const int kk = 2 * i + (lane >> 5); scr[kk * 33 + (lane & 31)] = v[i]; }
    LDS_WAIT(); asm volatile("" ::: "memory");
    const int c = lane & 7;
#pragma unroll
    for (int j = 0; j < 4; ++j) { const int n = (lane >> 3) + 8 * j; const LAS float* s = scr + (8 * c) * 33 + n;
        v4u o; o.x = pk2(s[0 * 33], s[1 * 33]); o.y = pk2(s[2 * 33], s[3 * 33]); o.z = pk2(s[4 * 33], s[5 * 33]); o.w = pk2(s[6 * 33], s[7 * 33]);
        *(v4u*)(WT + (size_t)(n0 + n) * ldt + k0 + 8 * c) = o; }
    LDS_WAIT(); asm volatile("" ::: "memory");
}
__device__ __forceinline__ void rms_row_to_bf16(const float* xrow, const float* g, bf16* orow, unsigned* qrow, float* sa_row, int lane) {
    const f32x4* xr = (const f32x4*)xrow + lane; const f32x4* gr = (const f32x4*)g + lane;
    f32x4 v[16]; float s = 0.f;
#pragma unroll
    for (int j = 0; j < 16; ++j) { v[j] = xr[64 * j]; s += (v[j].x * v[j].x + v[j].y * v[j].y) + (v[j].z * v[j].z + v[j].w * v[j].w); }
    const float rstd = 1.0f / sqrtf(wave_sum(s, lane) * (1.f / DM) + RMS_EPS);
    v2u* o8 = (v2u*)orow + lane; float mx = 0.f;
#pragma unroll
    for (int j = 0; j < 16; ++j) { const f32x4 gg = gr[64 * j]; v[j].x *= rstd * gg.x; v[j].y *= rstd * gg.y; v[j].z *= rstd * gg.z; v[j].w *= rstd * gg.w;
        mx = fmaxf(fmaxf(mx, fmaxf(fabsf(v[j].x), fabsf(v[j].y))), fmaxf(fabsf(v[j].z), fabsf(v[j].w)));
        v2u w; w.x = pk2(v[j].x, v[j].y); w.y = pk2(v[j].z, v[j].w); o8[64 * j] = w; }
    mx = fmaxf(wave_max(mx, lane), 1e-30f);
    const float inv = 127.0f / mx;
#pragma unroll
    for (int j = 0; j < 16; ++j) qrow[lane + 64 * j] = q8(v[j].x, v[j].y, v[j].z, v[j].w, inv);
    if (lane == 0) *sa_row = mx * (1.0f / 127.0f);
}
__device__ __forceinline__ void quant_row16(const bf16* wrow, unsigned* qrow, float* sc, int lane) {
    v4u w[8]; float mx = 0.f;
#pragma unroll
    for (int j = 0; j < 8; ++j) { w[j] = *((const v4u*)wrow + lane + 64 * j);
        mx = fmaxf(mx, fmaxf(fmaxf(fmaxf(fabsf(bflo(w[j].x)), fabsf(bfhi(w[j].x))), fmaxf(fabsf(bflo(w[j].y)), fabsf(bfhi(w[j].y)))), fmaxf(fmaxf(fabsf(bflo(w[j].z)), fabsf(bfhi(w[j].z))), fmaxf(fabsf(bflo(w[j].w)), fabsf(bfhi(w[j].w)))))); }
    mx = fmaxf(wave_max(mx, lane), 1e-30f);
    const float inv = 127.0f / mx;
#pragma unroll
    for (int j = 0; j < 8; ++j) { v2u o; o.x = q8(bflo(w[j].x), bfhi(w[j].x), bflo(w[j].y), bfhi(w[j].y), inv); o.y = q8(bflo(w[j].z), bfhi(w[j].z), bflo(w[j].w), bfhi(w[j].w), inv);
        *((v2u*)qrow + lane + 64 * j) = o; }
    if (lane == 0) *sc = mx * (1.0f / 127.0f);
}
struct Args;
template <class KPT> __device__ __forceinline__ void phase_prologue(Frame& F, KPT KP, unsigned char* ws) {
#define in_(i) ((const float*)(__attribute__((address_space(1))) const float*)(unsigned long long)KP->in[i])
    LAS float* scr = (LAS float*)(F.lds + RING_OFF + F.wave * 16384);
    const int gw = F.vcu * NWAVES + F.wave, NGW = F.G * NWAVES;
    constexpr int C16 = pg8::NT16 * 256, C16_OFF = 26 * 256;
    constexpr int I_IN = (DM / 64) * (C16 / 32), I_BR = (1024 / 64) * (DM / 32), I_BD = (512 / 64) * (DM / 32);
    constexpr int I_LAYER = I_IN + 3 * I_BR + I_BD;
    for (int it = gw; it < 2 * I_LAYER; it += NGW) {
        const int l = it / I_LAYER; int r = it % I_LAYER;
        bf16* wbr = (bf16*)(ws + WS_WBR + (size_t)l * WBR_LAYER);
        if (r < I_IN) { p0_transpose_item(in_(2) + (size_t)l * DM * LDP, DM, LDP, (bf16*)(ws + WS_WIN + (size_t)l * WIN_LAYER), PK, scr, r, F.lane, C16_OFF, C16); continue; } r -= I_IN;
        if (r < I_BR) { p0_transpose_item(in_(7) + (size_t)l * 1024 * DM, 1024, DM, wbr, PY, scr, r, F.lane); continue; } r -= I_BR;
        if (r < I_BR) { p0_transpose_item(in_(8) + (size_t)l * 1024 * DM, 1024, DM, wbr + 1 * (WBR_BLOCK / 2), PY, scr, r, F.lane); continue; } r -= I_BR;
        if (r < I_BR) { p0_transpose_item(in_(9) + (size_t)l * 1024 * DM, 1024, DM, wbr + 2 * (WBR_BLOCK / 2), PY, scr, r, F.lane); continue; } r -= I_BR;
        p0_transpose_item(in_(10) + (size_t)l * 512 * DM, 512, DM, wbr + 3 * (WBR_BLOCK / 2), PY, scr, r, F.lane);
    }
    {
        LAS float* cm = (LAS float*)(F.lds + RING_OFF + 12288);
        const int lane = F.lane, n = lane & 31, kpar = lane >> 5;
        constexpr int NBQ = N8 / 32;
        for (int it = F.vcu; it < 2 * NBQ + 2 * (DM / 32); it += F.G) {
            const float* W; int ldw; unsigned char* Q; float* SC;
            if (it < 2 * NBQ) { const int l = it / NBQ, n0c = (it % NBQ) * 32, n0 = pg8::map8(n0c >> 8) * 256 + (n0c & 255);
                W = in_(2) + (size_t)l * DM * LDP + n0 + n; ldw = LDP; Q = ws + WS_WG8 + (size_t)l * WG8_LAYER + (size_t)n0c * P8; SC = (float*)(ws + WS_SB) + (size_t)l * N8 + n0c; }
            else { const int r = it - 2 * NBQ, l = r / (DM / 32), n0 = (r % (DM / 32)) * 32;
                W = in_(11) + (size_t)l * DM * DM + n0 + n; ldw = DM; Q = ws + WS_WO8 + (size_t)l * WO8_LAYER + (size_t)n0 * P8; SC = (float*)(ws + WS_SO) + (size_t)l * DM + n0; }
            float mx = 0.f; unsigned pk[8][16];
#pragma unroll
            for (int kb = 0; kb < 8; ++kb) { const int k0 = (F.wave * 8 + kb) * 64;
                float v[32]; const float* wp = W + (size_t)(k0 + kpar) * ldw;
#pragma unroll
                for (int i = 0; i < 32; ++i) { v[i] = __builtin_nontemporal_load(wp); wp += 2 * ldw; asm volatile("" : "+v"(wp)); }
#pragma unroll
                for (int i = 0; i < 32; ++i) mx = fmaxf(mx, fabsf(v[i]));
#pragma unroll
                for (int i = 0; i < 16; ++i) { pk[kb][i] = pk2(v[2 * i], v[2 * i + 1]); asm volatile("" : "+v"(pk[kb][i])); }
                asm volatile("" ::: "memory"); __builtin_amdgcn_sched_barrier(0); }
            mx = fmaxf(mx, __builtin_bit_cast(float, __builtin_amdgcn_ds_bpermute((lane ^ 32) << 2, __builtin_bit_cast(int, mx))));
            if (lane < 32) cm[F.wave * 32 + lane] = mx;
            LDS_WAIT(); __syncthreads();
            float cmax = cm[n];
#pragma unroll
            for (int w = 1; w < 8; ++w) cmax = fmaxf(cmax, cm[w * 32 + n]);
            cmax = fmaxf(cmax, 1e-30f);
            const float inv = 127.0f / cmax;
            if (F.wave == 0 && lane < 32) SC[lane] = cmax * (1.0f / 127.0f);
#pragma unroll
            for (int kb = 0; kb < 8; ++kb) { const int k0 = (F.wave * 8 + kb) * 64;
#pragma unroll
                for (int i = 0; i < 16; ++i) { scr[(4 * i + kpar) * 33 + n] = bflo(pk[kb][i]) * inv; scr[(4 * i + 2 + kpar) * 33 + n] = bfhi(pk[kb][i]) * inv; }
                LDS_WAIT(); asm volatile("" ::: "memory");
                const int c = lane & 7;
#pragma unroll
                for (int j = 0; j < 4; ++j) { const int nn = (lane >> 3) + 8 * j; const LAS float* sp = scr + (8 * c) * 33 + nn;
                    v2u o; o.x = q8(sp[0 * 33], sp[1 * 33], sp[2 * 33], sp[3 * 33], 1.0f); o.y = q8(sp[4 * 33], sp[5 * 33], sp[6 * 33], sp[7 * 33], 1.0f);
                    *(v2u*)(Q + (size_t)nn * P8 + k0 + 8 * c) = o; }
                LDS_WAIT(); asm volatile("" ::: "memory"); __builtin_amdgcn_sched_barrier(0); }
            __syncthreads();
        }
    }
    for (int m = gw; m < M; m += NGW) rms_row_to_bf16(in_(0) + (size_t)m * DM, in_(1), (bf16*)(ws + WS_XN) + (size_t)m * PK, (unsigned*)(ws + WS_XN8 + (size_t)m * P8), (float*)(ws + WS_SA) + m, F.lane);
}
#undef in_
__device__ __forceinline__ void phase_finalize(Frame& F, unsigned char* ws, const float* lam_p  , const float* subln_g  , float lam_init) {
    const int gw = F.vcu * NWAVES + F.wave, NGW = F.G * NWAVES, lane = F.lane;
    const bf16* proj = (const bf16*)(ws + WS_PROJ);
    float d1 = lam_p[lane] * lam_p[128 + lane] + lam_p[64 + lane] * lam_p[192 + lane];
    float d2 = lam_p[256 + lane] * lam_p[384 + lane] + lam_p[320 + lane] * lam_p[448 + lane];
    d1 = wave_sum(d1, lane); d2 = wave_sum(d2, lane);
    const float lam = expf(d1) - expf(d2) + lam_init;
    const float post = 1.0f - lam_init;
    const float* OC = (const float*)(ws + WS_OC);
    const f32x4 sg = *(const f32x4*)(subln_g + 4 * lane);
    bf16* YC = (bf16*)(ws + WS_YC);
    for (int it = gw; it < M * 4; it += NGW) {
        const int t = it >> 2, h = it & 3;
        const f32x4 o0 = *(const f32x4*)(OC + (size_t)t * 2048 + (2 * h) * 256 + 4 * lane);
        const f32x4 o1 = *(const f32x4*)(OC + (size_t)t * 2048 + (2 * h + 1) * 256 + 4 * lane);
        const f32x4 d = o0 - lam * o1;
        const float ss = wave_sum((d.x * d.x + d.y * d.y) + (d.z * d.z + d.w * d.w), lane);
        const float rstd = 1.0f / sqrtf(ss * (1.f / 256.f) + RMS_EPS) * post;
        const v2u zw = *(const v2u*)(proj + (size_t)t * LDP + CC_Z + h * 256 + 4 * lane);
        v2u o; o.x = pk2(d.x * rstd * sg.x * bflo(zw.x), d.y * rstd * sg.y * bfhi(zw.x)); o.y = pk2(d.z * rstd * sg.z * bflo(zw.y), d.w * rstd * sg.w * bfhi(zw.y));
        *(v2u*)(YC + (size_t)t * PY + h * 256 + 4 * lane) = o;
    }
    const float* OD = (const float*)(ws + WS_OD); const float* LSE = (const float*)(ws + WS_LSE);
    bf16* YD = (bf16*)(ws + WS_YD);
    const int hg = lane >> 4, c0 = hg * 128 + (lane & 15) * 8;
    for (int t = gw; t < M; t += NGW) {
        const float l0 = LSE[(size_t)t * 4 + hg], l1 = LSE[(size_t)M * 4 + (size_t)t * 4 + hg], l2 = LSE[(size_t)2 * M * 4 + (size_t)t * 4 + hg];
        const float mx = fmaxf(l0, fmaxf(l1, l2));
        float w0 = __builtin_amdgcn_exp2f(l0 - mx), w1 = __builtin_amdgcn_exp2f(l1 - mx), w2 = __builtin_amdgcn_exp2f(l2 - mx);
        const float inv = 1.0f / (w0 + w1 + w2); w0 *= inv; w1 *= inv; w2 *= inv;
        const float* p0 = OD + (size_t)t * 512 + c0; const float* p1 = p0 + (size_t)M * 512; const float* p2 = p1 + (size_t)M * 512;
        const f32x4 a0 = *(const f32x4*)p0, a1 = *(const f32x4*)(p0 + 4), b0 = *(const f32x4*)p1, b1 = *(const f32x4*)(p1 + 4), c0v = *(const f32x4*)p2, c1v = *(const f32x4*)(p2 + 4);
        const f32x4 r0 = w0 * a0 + w1 * b0 + w2 * c0v, r1 = w0 * a1 + w1 * b1 + w2 * c1v;
        const v4u zw = *(const v4u*)(proj + (size_t)t * LDP + CD_Z + c0);
        v4u o; o.x = pk2(r0.x * bflo(zw.x), r0.y * bfhi(zw.x)); o.y = pk2(r0.z * bflo(zw.y), r0.w * bfhi(zw.y));
        o.z = pk2(r1.x * bflo(zw.z), r1.y * bfhi(zw.z)); o.w = pk2(r1.z * bflo(zw.w), r1.w * bfhi(zw.w));
        *(v4u*)(YD + (size_t)t * PY + c0) = o;
    }
}
#ifndef REP_AB
#define REP_AB 1
#endif
#ifndef REP_AC
#define REP_AC 1
#endif
#ifndef REP_AA
#define REP_AA 1
#endif
#ifndef REP_AD
#define REP_AD 1
#endif
#ifndef SD_DENSE
#define SD_DENSE 2
#endif
#ifndef SD_ALIBI
#define SD_ALIBI 2
#endif
#ifndef SD_NA
#define SD_NA 1
#endif
#ifndef SD_DIL
#define SD_DIL 1
#endif
__device__ __forceinline__ void phase_attention(Frame& F, unsigned char* ws, const float* rel_bias  , char* lds) {
    const att::bf16* P = (const att::bf16*)(ws + WS_PROJ);
    for (int rep = 0; rep < REP_AB; ++rep)
    for (int u = F.vcu; u < 256; u += F.G) {
        const int grp = u >> 6, b = grp >> 1, kvh = grp & 1, hq = kvh * 4 + ((u >> 4) & 3), qb = u & 15;
        const size_t tb = (size_t)b * SEQ, tq = tb + 256 * qb;
        att::UA a{};
        a.Q = P + tq * LDP + CB_Q + hq * 128; a.ldq = LDP;
        a.K = P + tb * LDP + CB_K + kvh * 128; a.V = P + tb * LDP + CB_V + kvh * 128; a.ldk = LDP; a.NT = SEQ / 64;
        a.Y = (att::bf16*)(ws + WS_YB) + tq * PY + hq * 128; a.ldy = PY; a.Z = P + tq * LDP + CB_Z + hq * 128; a.ldz = LDP;
        att::attn_unit_dma<att::M_DENSE, 1>(a, lds, 2 * 16384 + 3 * 16384, F.wave);
    }
    for (int rep = 0; rep < REP_AC; ++rep)
    for (int u = F.vcu; u < 256; u += F.G) {
        const int combo = u >> 4, b = combo >> 3, h = (combo >> 1) & 3, mp = combo & 1, qb = u & 15;
        const size_t tb = (size_t)b * SEQ, tq = tb + 256 * qb;
        att::UA a{};
        a.Q = P + tq * LDP + CC_Q + (h * 2 + mp) * 128; a.ldq = LDP;
        a.K = P + tb * LDP + CC_K + (h * 2 + mp) * 128; a.V = P + tb * LDP + CC_V + h * 256; a.ldk = LDP; a.NT = SEQ / 64;
        a.qk0 = 256 * qb; a.slope2 = __builtin_amdgcn_exp2f(-2.0f * (float)(h + 1)) * att::LOG2E; a.j0 = 4 * qb;
        a.O = (float*)(ws + WS_OC) + tq * 2048 + (h * 2 + mp) * 256; a.ldo = 2048;
        att::attn_unit_dma<att::M_ALIBI, 2>(a, lds, XTAB_OFF, F.wave);
    }
    for (int rep = 0; rep < REP_AA; ++rep)
    for (int u = F.vcu; u < 256; u += F.G) {
        const int b = u >> 7, h = (u >> 4) & 7, R = u & 15;
        const size_t tb = (size_t)b * SEQ, tq = tb + 256 * R;
        int kr_lo = min(max(4 * R - 4, 0), 56); const int kr_last = min(max(4 * R - 1, 0), 56) + 7; int NT = kr_last - kr_lo + 1;
        att::UA a{};
        a.Q = P + tq * LDP + CA_Q + h * 128; a.ldq = LDP;
        a.K = P + (tb + (size_t)kr_lo * 64) * LDP + CA_K + h * 128; a.V = P + (tb + (size_t)kr_lo * 64) * LDP + CA_V + h * 128; a.ldk = LDP; a.NT = NT;
        a.qrow0 = 4 * R; a.krow0 = kr_lo; a.tbl = rel_bias + h * (15 * 31);
        a.Y = (att::bf16*)(ws + WS_YA) + tq * PY + h * 128; a.ldy = PY; a.Z = P + tq * LDP + CA_Z + h * 128; a.ldz = LDP;
        att::attn_unit_dma<att::M_NA, 1>(a, lds, 2 * 16384 + 3 * 16384, F.wave);
    }
    for (int rep = 0; rep < REP_AD; ++rep)
    for (int u = F.vcu; u < 384; u += F.G) {
        const int bh = u >> 4, b = bh / 12, gh = bh % 12, g = gh >> 2, hg = gh & 3, u16 = u & 15;
        const int dil = (g == 0) ? 1 : ((g == 1) ? 4 : 16);
        const int qb = (g == 0) ? u16 : ((g == 1) ? (u16 & 3) : 0), rho = (g == 0) ? 0 : ((g == 1) ? (u16 >> 2) : u16);
        const int nttot = 64 / dil;
        const int t_lo = max(0, 4 * qb - 1), t_hi = min(nttot, 4 * qb + 5);
        const size_t tb = (size_t)b * SEQ, tq = tb + rho + (size_t)dil * 256 * qb, tk = tb + rho + (size_t)dil * 64 * t_lo;
        att::UA a{};
        a.Q = P + tq * LDP + CD_Q + gh * 128; a.ldq = (long)LDP * dil;
        a.K = P + tk * LDP + CD_K + gh * 128; a.V = P + tk * LDP + CD_V + gh * 128; a.ldk = (long)LDP * dil; a.NT = t_hi - t_lo;
        a.qk0 = 256 * qb - 64 * t_lo; a.slope2 = __builtin_amdgcn_exp2f(-8.0f * (float)(gh + 1) / 12.0f) * (float)dil * att::LOG2E;
        a.O = (float*)(ws + WS_OD) + (size_t)g * M * 512 + tq * 512 + hg * 128; a.ldo = 512L * dil;
        a.L = (float*)(ws + WS_LSE) + (size_t)g * M * 4 + tq * 4 + hg; a.ldl = 4L * dil;
        att::attn_unit_dma<att::M_DIL, 1>(a, lds, 2 * 16384 + 3 * 16384, F.wave);
    }
}

#ifndef REP_PRO
#define REP_PRO 1
#endif
#ifndef REP_INP
#define REP_INP 1
#endif
#ifndef REP_ATT
#define REP_ATT 1
#endif
#ifndef REP_FIN
#define REP_FIN 1
#endif
#ifndef REP_BRA
#define REP_BRA 1
#endif
#ifndef REP_OUT
#define REP_OUT 1
#endif
#ifndef REP_NRM
#define REP_NRM 1
#endif
constexpr int NPH = 14;
struct Args { const float* in[12]; float* out; unsigned char* ws; int ph_lo, ph_hi; };
__global__ void __launch_bounds__(NWAVES * 64, 2) mega_fwd(Args args) {
    extern __shared__ __attribute__((aligned(16))) unsigned char lds[];
    Frame F;
    F.lds = (LAS unsigned char*)lds;
    F.MISC = (volatile LAS unsigned*)(F.lds + MISC_OFF);
    F.tid = threadIdx.x; F.lane = F.tid & 63; F.wave = __builtin_amdgcn_readfirstlane(F.tid >> 6);
    const int wave0 = F.wave;
    F.G = gridDim.x; { const int bx = blockIdx.x; F.vcu = (F.G % 8 == 0) ? (bx % 8) * (F.G / 8) + bx / 8 : bx; }
    unsigned char* ws = args.ws;
    F.ctl = (unsigned*)(ws + WS_CTL);
    for (int u = F.tid; u < (LDS_BYTES - LDSCTL_OFF) / 4; u += NWAVES * 64) ((LAS unsigned*)(F.lds + LDSCTL_OFF))[u] = 0u;
    __syncthreads();
    XcdBarrier bar; bar.bar = F.ctl + CW_BAR; bar.x = 0; bar.st = nullptr;
    if (ONE_LAUNCH) bar = xcd_barrier_post(F.ctl + CW_BAR, F.MISC + 8);
    const int lo = args.ph_lo, hi = args.ph_hi;
    const __attribute__((address_space(4))) Args* KP = (const __attribute__((address_space(4))) Args*)__builtin_amdgcn_kernarg_segment_ptr();
#define INP(i) ((const float*)(__attribute__((address_space(1))) const float*)(unsigned long long)KP->in[i])
#define PHASE_ENTER() do { unsigned long long kpi_ = (unsigned long long)__builtin_amdgcn_kernarg_segment_ptr(); asm volatile("" : "+s"(kpi_)); KP = (const __attribute__((address_space(4))) Args*)kpi_; \
        unsigned long long wsi_ = (unsigned long long)KP->ws; asm volatile("" : "+s"(wsi_)); ws = (unsigned char*)(__attribute__((address_space(1))) unsigned char*)wsi_; int t_ = fresh_tid(wave0); asm volatile("" : "+v"(t_)); F.tid = t_; F.lane = t_ & 63; F.wave = wave0; } while (0)
#define IN(k) (lo <= (k) && (k) < hi)
#define SEAM(k) do { if (IN(k) && IN((k) + 1)) xcd_barrier(bar, fresh_tid(wave0) == 0); } while (0)

    if (IN(0)) { for (int rep = 0; rep < REP_PRO; ++rep) { PHASE_ENTER(); phase_prologue(F, KP, ws); }
        SEAM(0); }

#pragma unroll 1
    for (int l = 0; l < DEPTH; ++l) {
        const int pb = 1 + 7 * l;
        if (IN(pb)) for (int rep = 0; rep < REP_INP; ++rep) {
            PHASE_ENTER(); bf16* proj = (bf16*)(ws + WS_PROJ);
            {
                pg8::Gemm g8{(const pg8::bf16_t*)(ws + WS_XN8), (const pg8::bf16_t*)(ws + WS_WG8 + (size_t)l * WG8_LAYER), M, N8, DM / 2, P8 / 2};
                pg8::StaticOrder S8; S8.init(M, N8, F.G, (int)blockIdx.x);
                pg8::EpiProjT<true> E8{proj, LDP, INP(3) + (size_t)l * 4 * 2 * HD, (LAS float*)(F.lds + XTAB_OFF), QSCALE, (const float*)(ws + WS_SA), (const float*)(ws + WS_SB) + (size_t)l * N8};
                pg8::gemm_phase<pg8::EpiProjT<true>, pg8::StaticOrder, true, true, pg8::Gemm, true>(F.lds + RING_OFF, g8, S8, E8, F.wave);
            }
            pg8::GemmMap16 g{(const pg8::bf16_t*)(ws + WS_XN), (const pg8::bf16_t*)(ws + WS_WIN + (size_t)l * WIN_LAYER), DM, PK};
            pg8::StaticOrder S; S.init(M, pg8::NT16 * 256, F.G, (int)blockIdx.x);
            pg8::EpiProjT<false> E{proj, LDP, INP(3) + (size_t)l * 4 * 2 * HD, (LAS float*)(F.lds + XTAB_OFF), QSCALE, nullptr, nullptr};
            pg8::gemm_phase<pg8::EpiProjT<false>, pg8::StaticOrder, true, true, pg8::GemmMap16>(F.lds + RING_OFF, g, S, E, F.wave);
            if (rep == REP_INP - 1) SEAM(pb);
        }
        if (IN(pb + 2)) { for (int rep = 0; rep < REP_ATT; ++rep) { PHASE_ENTER(); phase_attention(F, ws, INP(4) + (size_t)l * 8 * 15 * 31, (char*)lds + RING_OFF); } SEAM(pb + 2); }
        if (IN(pb + 3)) for (int rep = 0; rep < REP_FIN; ++rep) {
            PHASE_ENTER();
            const float lam_init = 0.8f - 0.6f * expf(-0.3f * (float)l);
            phase_finalize(F, ws, INP(5) + (size_t)l * 4 * HD, INP(6) + (size_t)l * 2 * HD, lam_init); if (rep == REP_FIN - 1) SEAM(pb + 3);
        }
        if (IN(pb + 4)) for (int rep = 0; rep < REP_BRA; ++rep) {
            PHASE_ENTER(); bf16* proj = (bf16*)(ws + WS_PROJ);
            const int rot = (int)(blockIdx.x & 1);
            pg8::ChainGemm g{(const bf16*)(ws + WS_YA), (const bf16*)(ws + WS_WBR + (size_t)l * WBR_LAYER), Y_BLOCK / 2, WBR_BLOCK / 2, PY, 1024, rot};
            pg8::ChainOrder S; S.T.init(M, DM, F.G, (int)blockIdx.x);
            pg8::EpiChain E{proj + CG, LDP, (bf16*)(ws + WS_MG), PK, rot};
            pg8::gemm_phase<pg8::EpiChain, pg8::ChainOrder, true, true, pg8::ChainGemm>(F.lds + RING_OFF, g, S, E, F.wave);
            if (rep == REP_BRA - 1) SEAM(pb + 4);
        }
        if (IN(pb + 5)) {
            { PHASE_ENTER(); const int gw = F.vcu * NWAVES + F.wave, NGW = F.G * NWAVES;
              for (int m = gw; m < M; m += NGW) quant_row16((const bf16*)(ws + WS_MG) + (size_t)m * PK, (unsigned*)(ws + WS_MG8 + (size_t)m * P8), (float*)(ws + WS_SM) + m, F.lane); }
            xcd_barrier(bar, fresh_tid(wave0) == 0);
            for (int rep = 0; rep < REP_OUT; ++rep) {
            PHASE_ENTER();
            const float* xin = (l == 0) ? INP(0) : (const float*)(ws + WS_X1);
            float* xout = (l == DEPTH - 1) ? (float*)(__attribute__((address_space(1))) float*)(unsigned long long)KP->out : (float*)(ws + WS_X1);
            pg8::Gemm g{(const pg8::bf16_t*)(ws + WS_MG8), (const pg8::bf16_t*)(ws + WS_WO8 + (size_t)l * WO8_LAYER), M, DM, DM / 2, P8 / 2};
            pg8::StaticOrder S; S.init(M, DM, F.G, (int)blockIdx.x);
            pg8::EpiRes8 E{xin, xout, DM, (const float*)(ws + WS_SM), (const float*)(ws + WS_SO) + (size_t)l * DM};
            pg8::gemm_phase<pg8::EpiRes8, pg8::StaticOrder, true, true, pg8::Gemm, true>(F.lds + RING_OFF, g, S, E, F.wave);
            }
            SEAM(pb + 5);
        }
        if (l + 1 < DEPTH && IN(pb + 6)) for (int rep = 0; rep < REP_NRM; ++rep) {
            PHASE_ENTER();
            const int gw = F.vcu * NWAVES + F.wave, NGW = F.G * NWAVES;
            for (int m = gw; m < M; m += NGW) rms_row_to_bf16((const float*)(ws + WS_X1) + (size_t)m * DM, INP(1) + (size_t)(l + 1) * DM, (bf16*)(ws + WS_XN) + (size_t)m * PK, (unsigned*)(ws + WS_XN8 + (size_t)m * P8), (float*)(ws + WS_SA) + m, F.lane);
            if (rep == REP_NRM - 1) SEAM(pb + 6);
        }
    }
#undef IN
#undef SEAM
#undef PHASE_ENTER
#undef INP
}

extern "C" void kernel_launch(void* const* d_in, const int* in_sizes, int n_in, void* d_out, int out_size, void* d_ws, size_t ws_size, hipStream_t stream) {
    static int grid = 0;
    if (grid == 0) {
        if (n_in != 12 || in_sizes[0] != M * DM || out_size != M * DM || ws_size < WS_END) { fprintf(stderr, "kernel_launch: shape/workspace mismatch (n_in %d, in0 %d, out %d, ws %zu, need %zu)\n", n_in, n_in > 0 ? in_sizes[0] : -1, out_size, ws_size, (size_t)WS_END); grid = -1; return; }
        int dev = 0, cus = 0, per_cu = 0;
        if (hipGetDevice(&dev) != hipSuccess || hipDeviceGetAttribute(&cus, hipDeviceAttributeMultiprocessorCount, dev) != hipSuccess) { grid = -1; return; }
        if (hipFuncSetAttribute((const void*)mega_fwd, hipFuncAttributeMaxDynamicSharedMemorySize, LDS_BYTES) != hipSuccess) { fprintf(stderr, "kernel_launch: hipFuncSetAttribute failed\n"); grid = -1; return; }
        if (hipOccupancyMaxActiveBlocksPerMultiprocessor(&per_cu, (const void*)mega_fwd, NWAVES * 64, LDS_BYTES) != hipSuccess || per_cu < 1)
            fprintf(stderr, "kernel_launch: note: occupancy query reports %d workgroups per CU\n", per_cu);
        (void)hipGetLastError();
        grid = cus;
    }
    if (grid < 0) return;
    if (hipMemsetAsync((char*)d_ws + WS_CTL, 0, CTL_ZERO_BYTES, stream) != hipSuccess) { fprintf(stderr, "kernel_launch: hipMemsetAsync failed\n"); return; }
    Args a{};
    for (int i = 0; i < 12; ++i) a.in[i] = (const float*)d_in[i];
    a.out = (float*)d_out; a.ws = (unsigned char*)d_ws;
    if (ONE_LAUNCH) {
        a.ph_lo = 0; a.ph_hi = NPH;
        hipLaunchKernelGGL(mega_fwd, dim3(grid), dim3(NWAVES * 64), LDS_BYTES, stream, a);
    } else {
        for (int p = 0; p < NPH; ++p) { a.ph_lo = p; a.ph_hi = p + 1; hipLaunchKernelGGL(mega_fwd, dim3(grid), dim3(NWAVES * 64), LDS_BYTES, stream, a); }
    }
    const hipError_t le = hipPeekAtLastError();
    if (le != hipSuccess) fprintf(stderr, "kernel_launch: launch failed: %s\n", hipGetErrorName(le));
}
```

```cpp
#include <hip/hip_runtime.h>
#include <cstdio>
#include <cstdint>
__device__ __forceinline__ int fresh_tid(int wave) { unsigned m = ~0u; asm volatile("" : "+s"(m)); return wave * 64 + (int)__builtin_amdgcn_mbcnt_hi(m, __builtin_amdgcn_mbcnt_lo(m, 0u)); }
namespace pg8 {
#define PG8_LAS __attribute__((address_space(3)))
typedef unsigned short bf16_t;
typedef short bf16x8 __attribute__((ext_vector_type(8)));
typedef float f32x4 __attribute__((ext_vector_type(4)));
typedef unsigned u32x4 __attribute__((ext_vector_type(4)));
constexpr int BM = 256, BK = 64, HALF = 128, HTB = HALF * BK * 2  , STAGE_BYTES = 8 * HTB, NXCD = 8, WGM = 8;

__host__ __device__ __forceinline__ int lds_byte(int r, int c) { const int st = (r >> 4) * 2 + (c >> 5), rr = r & 15, cc = c & 31, ob = rr * 64 + cc * 2; return st * 1024 + (ob ^ (((ob >> 9) & 1) << 5)); }
__host__ __device__ __forceinline__ void stage_rc(int b, int& R, int& C) { const int st = b / 1024, sb = b % 1024, swz = sb ^ (((sb >> 9) & 1) << 5); R = (st >> 1) * 16 + swz / 64; C = (st & 1) * 32 + (swz % 64) / 2; }
__host__ __device__ __forceinline__ int perm32(int rho) { const int n = rho >> 4, i = rho & 15; return 8 * (i >> 2) + 4 * n + (i & 3); }

struct Unit { int pm, pn, seg; };
struct Gemm { const bf16_t* A; const bf16_t* Bt; int M, N, K, P;
    __device__ __forceinline__ int pitch() const { return P; }
    __device__ __forceinline__ int ntiles(const Unit&) const { return K / BK; }
    __device__ __forceinline__ const char* a_base(const Unit& u, size_t tstep) const { return (const char*)A + (size_t)u.pm * tstep; }
    __device__ __forceinline__ const char* b_base(const Unit& u, size_t tstep) const { return (const char*)Bt + (size_t)u.pn * tstep; }
};
__host__ __device__ __forceinline__ int map16(int j) { return j + 26; }
__host__ __device__ __forceinline__ int map8(int j) { return j < 26 ? j : j + 16; }
constexpr int NT16 = 16, NT8 = 110;
struct GemmMap16 { const bf16_t* A; const bf16_t* Bt; int K, P;
    __device__ __forceinline__ int pitch() const { return P; }
    __device__ __forceinline__ int ntiles(const Unit&) const { return K / BK; }
    __device__ __forceinline__ const char* a_base(const Unit& u, size_t tstep) const { return (const char*)A + (size_t)u.pm * tstep; }
    __device__ __forceinline__ const char* b_base(const Unit& u, size_t tstep) const { return (const char*)Bt + (size_t)map16(u.pn) * tstep; }
};
struct ChainGemm { const bf16_t* A0; const bf16_t* B0; size_t a_stride, b_stride; int P, K, rot;
    __device__ __forceinline__ int branch(const Unit& u) const { return (u.seg + 3 * rot) & 3; }
    __device__ __forceinline__ int pitch() const { return P; }
    __device__ __forceinline__ int ntiles(const Unit& u) const { return (branch(u) == 3) ? (K / BK) / 2 : K / BK; }
    __device__ __forceinline__ const char* a_base(const Unit& u, size_t tstep) const { return (const char*)(A0 + (size_t)branch(u) * a_stride) + (size_t)u.pm * tstep; }
    __device__ __forceinline__ const char* b_base(const Unit& u, size_t tstep) const { return (const char*)(B0 + (size_t)branch(u) * b_stride) + (size_t)u.pn * tstep; }
};

struct StaticOrder {
    int nM, nN, nwg, G, c;
    __host__ __device__ void init(int M, int N, int G_, int c_) { nM = M / BM; nN = N / BM; nwg = nM * nN; G = G_; c = c_; }
    __host__ __device__ bool next(int i, Unit& u) const {
        const long L = (long)i * G + c; if (L >= nwg) return false;
        int wgid = (int)L; { const int q = nwg / NXCD, r = nwg % NXCD, xcd = wgid % NXCD, off = wgid / NXCD; wgid = (xcd < r ? xcd * (q + 1) : r * (q + 1) + (xcd - r) * q) + off; }
        const int nig = WGM * nN, gid = wgid / nig, fm = gid * WGM, gsz = (nM - fm) < WGM ? (nM - fm) : WGM;
        u.pm = fm + ((wgid % nig) % gsz); u.pn = (wgid % nig) / gsz; u.seg = 0; return true;
    }
    __device__ __forceinline__ void a_ready(const Unit&) const {}
    __device__ __forceinline__ void done(const Unit&) const {}
};
struct ChainOrder { StaticOrder T;
    __device__ __forceinline__ bool next(int i, Unit& u) const { if (!T.next(i >> 2, u)) return false; u.seg = i & 3; return true; }
    __device__ __forceinline__ void a_ready(const Unit&) const {}
    __device__ __forceinline__ void done(const Unit&) const {}
};

__device__ __forceinline__ unsigned cvt_pk_bf16(float lo, float hi) { unsigned r; asm volatile("v_cvt_pk_bf16_f32 %0, %1, %2" : "=v"(r) : "v"(lo), "v"(hi)); return r; }
typedef float f32x2 __attribute__((ext_vector_type(2)));
typedef int i32x4 __attribute__((ext_vector_type(4)));
template <bool I8> struct AccT { typedef f32x4 type; };
template <> struct AccT<true> { typedef i32x4 type; };
template <bool I8> __device__ __forceinline__ typename AccT<I8>::type mma1(bf16x8 b, bf16x8 a, typename AccT<I8>::type c) {
    if constexpr (I8) return __builtin_amdgcn_mfma_i32_16x16x64_i8(__builtin_bit_cast(i32x4, b), __builtin_bit_cast(i32x4, a), c, 0, 0, 0);
    else return __builtin_amdgcn_mfma_f32_16x16x32_bf16(b, a, c, 0, 0, 0);
}
__device__ __forceinline__ float sigmoid_fast(float v) { return __builtin_amdgcn_rcpf(1.0f + __builtin_amdgcn_exp2f(-1.4426950408889634f * v)); }
__device__ __forceinline__ float bf_lo(unsigned w) { return __builtin_bit_cast(float, w << 16); }
__device__ __forceinline__ float bf_hi(unsigned w) { return __builtin_bit_cast(float, w & 0xffff0000u); }
template <bool I8> struct EpiProjT {
    static constexpr bool PERM = true, AFTER_DRAIN = false;
    bf16_t* O; int ldc; const float* qk_gain  ; PG8_LAS float* xtab  ; float qscale; const float* sa; const float* sb;
    __device__ __forceinline__ bool resets(const Unit&) const { return true; }
    __device__ __forceinline__ void operator()(const typename AccT<I8>::type (&acc)[2][2][4][2], const Unit& u, int wr, int wc, int fr, int fq) const {
        const int pn = I8 ? map8(u.pn) : map16(u.pn);
        int kind, br = 0, isk = 0;
        if (pn >= 62) kind = 2;
        else if ((pn >= 12 && pn < 16) || (pn >= 22 && pn < 26) || (pn >= 38 && pn < 42) || pn >= 60) kind = 1;
        else if (pn < 8) { kind = 3; br = 0; isk = pn >= 4; }
        else if (pn >= 16 && pn < 21) { kind = 3; br = 1; isk = pn >= 20; }
        else if (pn >= 26 && pn < 34) { kind = 3; br = 2; isk = pn >= 30; }
        else if (pn >= 42 && pn < 54) { kind = 3; br = 3; isk = pn >= 48; }
        else kind = 0;
        const int row0 = u.pm * BM + wr * 64 + fr, cc0 = wc * 32 + 8 * fq, col0 = pn * BM + cc0;
        f32x4 sbv[2][2];
        if (I8) {
#pragma unroll
            for (int bj = 0; bj < 2; ++bj)
#pragma unroll
                for (int n = 0; n < 2; ++n) sbv[bj][n] = *(const f32x4*)(sb + u.pn * BM + cc0 + bj * HALF + 4 * n);
        }
        float sarr[2][4];
#pragma unroll
        for (int ai = 0; ai < 2; ++ai)
#pragma unroll
            for (int m = 0; m < 4; ++m) sarr[ai][m] = I8 ? sa[row0 + ai * HALF + m * 16] : 1.0f;
        if (I8) asm volatile("" ::: "memory");
#define EPV(ai, bj, m, n, sar) (I8 ? (f32x4){(float)acc[ai][bj][m][n][0], (float)acc[ai][bj][m][n][1], (float)acc[ai][bj][m][n][2], (float)acc[ai][bj][m][n][3]} * (sar) * sbv[bj][n] \
                                   : (f32x4){(float)acc[ai][bj][m][n][0], (float)acc[ai][bj][m][n][1], (float)acc[ai][bj][m][n][2], (float)acc[ai][bj][m][n][3]})
        if (kind != 3) {
#pragma unroll
            for (int ai = 0; ai < 2; ++ai)
#pragma unroll
                for (int m = 0; m < 4; ++m) { const int row = row0 + ai * HALF + m * 16; bf16_t* rowp = O + (size_t)row * ldc + col0; const float sar = sarr[ai][m];
#pragma unroll
                    for (int bj = 0; bj < 2; ++bj) { f32x4 v0 = EPV(ai, bj, m, 0, sar), v1 = EPV(ai, bj, m, 1, sar);
                        if (kind == 1) {
#pragma unroll
                            for (int e = 0; e < 4; ++e) { v0[e] *= sigmoid_fast(v0[e]); v1[e] *= sigmoid_fast(v1[e]); }
                        } else if (kind == 2) {
#pragma unroll
                            for (int e = 0; e < 4; ++e) { v0[e] = fminf(__builtin_amdgcn_exp2f(-1.4426950408889634f * v0[e]), 1e18f); v1[e] = fminf(__builtin_amdgcn_exp2f(-1.4426950408889634f * v1[e]), 1e18f); }
                        }
                        u32x4 w; w.x = cvt_pk_bf16(v0[0], v0[1]); w.y = cvt_pk_bf16(v0[2], v0[3]); w.z = cvt_pk_bf16(v1[0], v1[1]); w.w = cvt_pk_bf16(v1[2], v1[3]);
                        *(u32x4*)(rowp + bj * HALF) = w; } }
            return;
        }
#pragma unroll
        for (int ai = 0; ai < 2; ++ai)
#pragma unroll
            for (int m = 0; m < 4; ++m) { const float sar = sarr[ai][m];
#pragma unroll
                for (int bj = 0; bj < 2; ++bj) { const f32x4 a = EPV(ai, bj, m, 0, sar), b = EPV(ai, bj, m, 1, sar);
                    float s = (a[0] * a[0] + a[1] * a[1]) + (a[2] * a[2] + a[3] * a[3]) + (b[0] * b[0] + b[1] * b[1]) + (b[2] * b[2] + b[3] * b[3]);
                    s += __builtin_bit_cast(float, __builtin_amdgcn_ds_bpermute(((fq * 16 + fr) ^ 16) << 2, __builtin_bit_cast(int, s)));
                    s += __builtin_bit_cast(float, __builtin_amdgcn_ds_bpermute(((fq * 16 + fr) ^ 32) << 2, __builtin_bit_cast(int, s)));
                    if (fq == 0) xtab[((ai * HALF + wr * 64 + m * 16 + fr) * 2 + bj) * 4 + wc] = s; } }
        asm volatile("s_waitcnt lgkmcnt(0)" ::: "memory"); __builtin_amdgcn_s_barrier(); asm volatile("" ::: "memory");
        const float* gp = qk_gain + (br * 2 + isk) * 128 + cc0;
        const f32x4 ga = *(const f32x4*)gp, gb = *(const f32x4*)(gp + 4);
        const float sc = isk ? 1.0f : qscale;
        float invf[4];
#pragma unroll
        for (int i = 0; i < 4; ++i) invf[i] = __builtin_amdgcn_exp2f(-(float)(((cc0 >> 1) + i) & 31) * (13.287712379549449f / 32.f));
#pragma unroll
        for (int ai = 0; ai < 2; ++ai)
#pragma unroll
            for (int m = 0; m < 4; ++m) { const int rl = ai * HALF + wr * 64 + m * 16 + fr; const int row = u.pm * BM + rl;
                bf16_t* rowp = O + (size_t)row * ldc + col0; const float sar = sarr[ai][m];
                const int spos = row & 4095; const float fpos = (wc < 2) ? (float)(spos >> 6) : (float)(spos & 63);
#pragma unroll
                for (int bj = 0; bj < 2; ++bj) { const f32x4 t = *(const PG8_LAS f32x4*)(xtab + (rl * 2 + bj) * 4);
                    const float rstd = sc / sqrtf(((t[0] + t[1]) + (t[2] + t[3])) * (1.0f / 128.0f) + 1e-6f);
                    f32x4 v0 = EPV(ai, bj, m, 0, sar) * rstd * ga, v1 = EPV(ai, bj, m, 1, sar) * rstd * gb;
                    if (br == 1) {
                        float x[8] = {v0[0], v0[1], v0[2], v0[3], v1[0], v1[1], v1[2], v1[3]};
#pragma unroll
                        for (int i = 0; i < 4; ++i) { const float rev = __builtin_amdgcn_fractf(fpos * invf[i] * 0.15915494309189535f);
                            const float sn = __builtin_amdgcn_sinf(rev), cs = __builtin_amdgcn_cosf(rev);
                            const float x1 = x[2 * i], x2 = x[2 * i + 1]; x[2 * i] = x1 * cs - x2 * sn; x[2 * i + 1] = x1 * sn + x2 * cs; }
                        v0 = (f32x4){x[0], x[1], x[2], x[3]}; v1 = (f32x4){x[4], x[5], x[6], x[7]};
                    }
                    u32x4 w; w.x = cvt_pk_bf16(v0[0], v0[1]); w.y = cvt_pk_bf16(v0[2], v0[3]); w.z = cvt_pk_bf16(v1[0], v1[1]); w.w = cvt_pk_bf16(v1[2], v1[3]);
                    *(u32x4*)(rowp + bj * HALF) = w; } }
#undef EPV
    }
};
struct EpiChain {
    static constexpr bool PERM = true, AFTER_DRAIN = false;
    const bf16_t* G; int ldg; bf16_t* Mg; int ldm; int rot;
    __device__ __forceinline__ bool resets(const Unit& u) const { return u.seg == 3; }
    __device__ __forceinline__ void operator()(f32x4 (&acc)[2][2][4][2], const Unit& u, int wr, int wc, int fr, int fq) const {
        const int row0 = u.pm * BM + wr * 64 + fr, col0 = u.pn * BM + wc * 32 + 8 * fq, seg = u.seg;
        const int bcur = (seg + 3 * rot) & 3, bnxt = (seg + 1 + 3 * rot) & 3;
        const bf16_t* Gs = G + (size_t)bcur * 4096;
        const bool lastseg = seg == 3;
        const int nxo = lastseg ? 0 : (bnxt - bcur) * 4096;
#pragma unroll
        for (int ai = 0; ai < 2; ++ai) {
            u32x4 gw[4][2], nw[4][2];
#pragma unroll
            for (int m = 0; m < 4; ++m) { const size_t row = (size_t)(row0 + ai * HALF + m * 16);
#pragma unroll
                for (int bj = 0; bj < 2; ++bj) { gw[m][bj] = *(const u32x4*)(Gs + row * ldg + col0 + bj * HALF); nw[m][bj] = *(const u32x4*)(Gs + nxo + row * ldg + col0 + bj * HALF); } }
            asm volatile("" ::: "memory");
#pragma unroll
            for (int m = 0; m < 4; ++m) { const size_t row = (size_t)(row0 + ai * HALF + m * 16);
#pragma unroll
                for (int bj = 0; bj < 2; ++bj) { const u32x4 g = gw[m][bj], q = nw[m][bj];
                    float f[8] = {bf_lo(g.x), bf_hi(g.x), bf_lo(g.y), bf_hi(g.y), bf_lo(g.z), bf_hi(g.z), bf_lo(g.w), bf_hi(g.w)};
                    const float d[8] = {bf_lo(q.x), bf_hi(q.x), bf_lo(q.y), bf_hi(q.y), bf_lo(q.z), bf_hi(q.z), bf_lo(q.w), bf_hi(q.w)};
#pragma unroll
                    for (int e = 0; e < 8; ++e) { const float r = __builtin_amdgcn_rcpf(1.0f + f[e]); f[e] = lastseg ? r : (1.0f + d[e]) * r; }
                    f32x4 v0 = acc[ai][bj][m][0], v1 = acc[ai][bj][m][1];
                    v0[0] *= f[0]; v0[1] *= f[1]; v0[2] *= f[2]; v0[3] *= f[3]; v1[0] *= f[4]; v1[1] *= f[5]; v1[2] *= f[6]; v1[3] *= f[7];
                    acc[ai][bj][m][0] = v0; acc[ai][bj][m][1] = v1;
                    if (lastseg) { u32x4 w; w.x = cvt_pk_bf16(v0[0], v0[1]); w.y = cvt_pk_bf16(v0[2], v0[3]); w.z = cvt_pk_bf16(v1[0], v1[1]); w.w = cvt_pk_bf16(v1[2], v1[3]);
                        *(u32x4*)(Mg + row * ldm + col0 + bj * HALF) = w; } } }
            asm volatile("" ::: "memory");
        }
    }
};
struct EpiRes {
    static constexpr bool PERM = false, AFTER_DRAIN = false;
    const float* base; float* out; int ldc;
    __device__ __forceinline__ bool resets(const Unit&) const { return true; }
    __device__ __forceinline__ void operator()(const f32x4 (&acc)[2][2][4][2], const Unit& u, int wr, int wc, int fr, int fq) const {
        const int col0 = u.pn * BM + wc * 32 + 4 * fq;
#pragma unroll
        for (int ai = 0; ai < 2; ++ai) {
            f32x4 pre[4][2][2];
#pragma unroll
            for (int m = 0; m < 4; ++m) { const size_t off = (size_t)(u.pm * BM + ai * HALF + wr * 64 + m * 16 + fr) * ldc + col0;
#pragma unroll
                for (int bj = 0; bj < 2; ++bj)
#pragma unroll
                    for (int n = 0; n < 2; ++n) pre[m][bj][n] = *(const f32x4*)(base + off + bj * HALF + n * 16); }
            asm volatile("" ::: "memory");
#pragma unroll
            for (int m = 0; m < 4; ++m) { const size_t off = (size_t)(u.pm * BM + ai * HALF + wr * 64 + m * 16 + fr) * ldc + col0;
#pragma unroll
                for (int bj = 0; bj < 2; ++bj)
#pragma unroll
                    for (int n = 0; n < 2; ++n) *(f32x4*)(out + off + bj * HALF + n * 16) = pre[m][bj][n] + acc[ai][bj][m][n]; }
            asm volatile("" ::: "memory");
        }
    }
};
struct EpiRes8 {
    static constexpr bool PERM = false, AFTER_DRAIN = false;
    const float* base; float* out; int ldc; const float* sm; const float* so;
    __device__ __forceinline__ bool resets(const Unit&) const { return true; }
    __device__ __forceinline__ void operator()(const i32x4 (&acc)[2][2][4][2], const Unit& u, int wr, int wc, int fr, int fq) const {
        const int col0 = u.pn * BM + wc * 32 + 4 * fq;
        f32x4 sov[2][2];
#pragma unroll
        for (int bj = 0; bj < 2; ++bj)
#pragma unroll
            for (int n = 0; n < 2; ++n) sov[bj][n] = *(const f32x4*)(so + col0 + bj * HALF + n * 16);
#pragma unroll
        for (int ai = 0; ai < 2; ++ai) {
            f32x4 pre[4][2][2]; float smr[4];
#pragma unroll
            for (int m = 0; m < 4; ++m) { const int row = u.pm * BM + ai * HALF + wr * 64 + m * 16 + fr; const size_t off = (size_t)row * ldc + col0; smr[m] = sm[row];
#pragma unroll
                for (int bj = 0; bj < 2; ++bj)
#pragma unroll
                    for (int n = 0; n < 2; ++n) pre[m][bj][n] = *(const f32x4*)(base + off + bj * HALF + n * 16); }
            asm volatile("" ::: "memory");
#pragma unroll
            for (int m = 0; m < 4; ++m) { const size_t off = (size_t)(u.pm * BM + ai * HALF + wr * 64 + m * 16 + fr) * ldc + col0;
#pragma unroll
                for (int bj = 0; bj < 2; ++bj)
#pragma unroll
                    for (int n = 0; n < 2; ++n) { const i32x4 a = acc[ai][bj][m][n]; f32x4 v; v[0] = (float)a[0]; v[1] = (float)a[1]; v[2] = (float)a[2]; v[3] = (float)a[3];
                        *(f32x4*)(out + off + bj * HALF + n * 16) = pre[m][bj][n] + v * smr[m] * sov[bj][n]; } }
            asm volatile("" ::: "memory");
        }
    }
};

template <class Epi, class Sched, bool ALIGN_EPI = false, bool SP2 = false, class GemmT = Gemm, bool I8 = false>
__device__ __forceinline__ void gemm_phase(PG8_LAS unsigned char* lds, const GemmT g, const Sched& S, const Epi& E, const int wave_in) {
    int tid_ = fresh_tid(wave_in); asm volatile("" : "+v"(tid_));
    const int tid = tid_, wid = __builtin_amdgcn_readfirstlane(tid >> 6), lane = tid & 63, wr = wid >> 2, wc = wid & 3, fr = lane & 15, fq = lane >> 4;
    const int K = g.pitch();
    unsigned voffA[2], voffB[2];
#pragma unroll
    for (int i = 0; i < 2; ++i) { int R, C; stage_rc(tid * 16 + i * 8192, R, C); const int Rb = Epi::PERM ? ((R & ~31) + perm32(R & 31)) : R;
        voffA[i] = (unsigned)(R * K + C) * 2u; voffB[i] = (unsigned)(Rb * K + C) * 2u; }
    const size_t kstep = (size_t)(BK * 2);
    const size_t hstep = (size_t)HALF * K * 2;
    const size_t tstep = 2 * hstep;
    const unsigned ldsw = (unsigned)wid * 1024u;
    const int aoff = lds_byte(wr * 64 + fr, fq * 8), boff = lds_byte(wc * 32 + fr, fq * 8);
#define PG8_SA(b, h) (((b) * 2 + (h)) * HTB)
#define PG8_SB(b, h) ((4 + (b) * 2 + (h)) * HTB)
#define PG8_STAGE(bufoff, gbase, voff) do { _Pragma("unroll") for (int _i = 0; _i < 2; ++_i) \
        __builtin_amdgcn_global_load_lds((const unsigned*)((const char*)(gbase) + (voff)[_i]), (PG8_LAS unsigned*)(lds + (bufoff) + ldsw + _i * 8192), 16, 0, 0); } while (0)
#define PG8_LDA(dst, b, h) do { _Pragma("unroll") for (int m = 0; m < 4; ++m) _Pragma("unroll") for (int k = 0; k < 2; ++k) dst[m][k] = *(const PG8_LAS bf16x8*)(lds + PG8_SA(b, h) + aoff + m * 2048 + k * 1024); } while (0)
#define PG8_LDB(dst, b, h) do { _Pragma("unroll") for (int n = 0; n < 2; ++n) _Pragma("unroll") for (int k = 0; k < 2; ++k) dst[n][k] = *(const PG8_LAS bf16x8*)(lds + PG8_SB(b, h) + boff + n * 2048 + k * 1024); } while (0)
#define PG8_MMA(ai, bj, At, Bt) do { __builtin_amdgcn_s_setprio(1); _Pragma("unroll") for (int m = 0; m < 4; ++m) _Pragma("unroll") for (int n = 0; n < 2; ++n) _Pragma("unroll") for (int k = 0; k < 2; ++k) \
        acc[ai][bj][m][n] = mma1<I8>(Bt[n][k], At[m][k], acc[ai][bj][m][n]); __builtin_amdgcn_s_setprio(0); } while (0)
#define PG8_WAIT_V(n) asm volatile("s_waitcnt vmcnt(" #n ")" ::: "memory")
#define PG8_WAIT_L(n) asm volatile("s_waitcnt lgkmcnt(" #n ")" ::: "memory")
#define PG8_BAR __builtin_amdgcn_s_barrier()
#define PG8_SCHED __builtin_amdgcn_sched_barrier(0)
    Unit cur, nxt; int ui = 0;
    if (!S.next(0, cur)) return;
    int nt = g.ntiles(cur);
    typedef typename AccT<I8>::type acc_t;
    acc_t acc[2][2][4][2];
#pragma unroll
    for (int a = 0; a < 2; ++a)
#pragma unroll
        for (int b = 0; b < 2; ++b)
#pragma unroll
            for (int m = 0; m < 4; ++m)
#pragma unroll
                for (int n = 0; n < 2; ++n) acc[a][b][m][n] = acc_t{};
    bf16x8 At[4][2], B0[2][2], B1[2][2];
    const char* cA = g.a_base(cur, tstep); const char* cB = g.b_base(cur, tstep);
    S.a_ready(cur);
    if constexpr (SP2) {
        PG8_STAGE(PG8_SB(0, 0), cB, voffB); PG8_STAGE(PG8_SB(0, 1), cB + hstep, voffB); PG8_STAGE(PG8_SA(0, 0), cA, voffA); PG8_STAGE(PG8_SA(0, 1), cA + hstep, voffA);
        if (wr == 1) PG8_BAR;
        PG8_WAIT_V(2); PG8_BAR;
        PG8_STAGE(PG8_SB(1, 0), cB + kstep, voffB); PG8_STAGE(PG8_SA(1, 0), cA + kstep, voffA); PG8_STAGE(PG8_SB(1, 1), cB + hstep + kstep, voffB);
        PG8_WAIT_V(6); PG8_BAR;
    } else {
        PG8_STAGE(PG8_SB(0, 0), cB, voffB); PG8_STAGE(PG8_SA(0, 0), cA, voffA); PG8_STAGE(PG8_SB(0, 1), cB + hstep, voffB); PG8_STAGE(PG8_SA(0, 1), cA + hstep, voffA);
        if (wr == 1) PG8_BAR;
        PG8_WAIT_V(4); PG8_BAR;
        PG8_STAGE(PG8_SB(1, 0), cB + kstep, voffB); PG8_STAGE(PG8_SA(1, 0), cA + kstep, voffA); PG8_STAGE(PG8_SB(1, 1), cB + hstep + kstep, voffB);
        PG8_WAIT_V(6); PG8_BAR;
    }
    for (;;) {
        const bool has_next = S.next(ui + 1, nxt);
        const char* nA = has_next ? g.a_base(nxt, tstep) : cA; const char* nB = has_next ? g.b_base(nxt, tstep) : cB;
        for (int t = 0; t < nt; t += 2) {
            const bool last = (t == nt - 2);
            const char* a1 = cA + (size_t)(t + 1) * kstep;
            const char* a2 = last ? nA : cA + (size_t)(t + 2) * kstep; const char* b2 = last ? nB : cB + (size_t)(t + 2) * kstep;
            const char* a3 = a2 + kstep; const char* b3 = b2 + kstep;
            if (last && has_next) S.a_ready(nxt);
            if constexpr (SP2) {
            PG8_LDB(B0, 0, 0); PG8_LDB(B1, 0, 1); PG8_SCHED; PG8_LDA(At, 0, 0); PG8_STAGE(PG8_SA(1, 1), a1 + hstep, voffA);
            PG8_WAIT_V(8); PG8_WAIT_L(0); PG8_BAR; PG8_MMA(0, 0, At, B0); PG8_MMA(0, 1, At, B1); PG8_BAR; PG8_SCHED;
            PG8_LDA(At, 0, 1); PG8_STAGE(PG8_SB(0, 0), b2, voffB); PG8_STAGE(PG8_SB(0, 1), b2 + hstep, voffB); PG8_STAGE(PG8_SA(0, 0), a2, voffA);
            PG8_WAIT_V(8); PG8_WAIT_L(0); PG8_BAR; PG8_MMA(1, 0, At, B0); PG8_MMA(1, 1, At, B1); PG8_BAR; PG8_SCHED;
            PG8_LDB(B0, 1, 0); PG8_LDB(B1, 1, 1); PG8_SCHED; PG8_LDA(At, 1, 0); PG8_STAGE(PG8_SA(0, 1), a2 + hstep, voffA);
            PG8_WAIT_V(8); PG8_WAIT_L(0); PG8_BAR; PG8_MMA(0, 0, At, B0); PG8_MMA(0, 1, At, B1); PG8_BAR; PG8_SCHED;
            PG8_LDA(At, 1, 1); PG8_STAGE(PG8_SB(1, 0), b3, voffB); PG8_STAGE(PG8_SB(1, 1), b3 + hstep, voffB); PG8_STAGE(PG8_SA(1, 0), a3, voffA);
            PG8_WAIT_V(8); PG8_WAIT_L(0); PG8_BAR; PG8_MMA(1, 0, At, B0); PG8_MMA(1, 1, At, B1); PG8_BAR; PG8_SCHED;
            } else {
            PG8_LDB(B0, 0, 0); PG8_SCHED; PG8_LDA(At, 0, 0); PG8_STAGE(PG8_SA(1, 1), a1 + hstep, voffA);
            PG8_WAIT_L(8); PG8_BAR; PG8_WAIT_L(0); PG8_MMA(0, 0, At, B0); PG8_BAR; PG8_SCHED;
            PG8_LDB(B1, 0, 1); PG8_STAGE(PG8_SB(0, 0), b2, voffB);
            PG8_BAR; PG8_WAIT_L(0); PG8_MMA(0, 1, At, B1); PG8_BAR;
            PG8_LDA(At, 0, 1); PG8_STAGE(PG8_SA(0, 0), a2, voffA);
            PG8_BAR; PG8_WAIT_L(0); PG8_MMA(1, 0, At, B0); PG8_BAR; PG8_SCHED;
            PG8_STAGE(PG8_SB(0, 1), b2 + hstep, voffB);
            PG8_WAIT_V(6); PG8_BAR; PG8_MMA(1, 1, At, B1); PG8_BAR;
            PG8_LDB(B0, 1, 0); PG8_SCHED; PG8_LDA(At, 1, 0); PG8_STAGE(PG8_SA(0, 1), a2 + hstep, voffA);
            PG8_WAIT_L(8); PG8_BAR; PG8_WAIT_L(0); PG8_MMA(0, 0, At, B0); PG8_BAR; PG8_SCHED;
            PG8_LDB(B1, 1, 1); PG8_STAGE(PG8_SB(1, 0), b3, voffB);
            PG8_BAR; PG8_WAIT_L(0); PG8_MMA(0, 1, At, B1); PG8_BAR;
            PG8_LDA(At, 1, 1); PG8_STAGE(PG8_SA(1, 0), a3, voffA);
            PG8_BAR; PG8_WAIT_L(0); PG8_MMA(1, 0, At, B0); PG8_BAR; PG8_SCHED;
            PG8_STAGE(PG8_SB(1, 1), b3 + hstep, voffB);
            PG8_WAIT_V(6); PG8_BAR; PG8_MMA(1, 1, At, B1); PG8_BAR;
            }
        }
        if constexpr (ALIGN_EPI) { if (wr == 0) PG8_BAR; }
        if constexpr (!Epi::AFTER_DRAIN) { E(acc, cur, wr, wc, fr, fq); S.done(cur); }
        if (!has_next) break;
        if (E.resets(cur)) {
#pragma unroll
        for (int a = 0; a < 2; ++a)
#pragma unroll
            for (int b = 0; b < 2; ++b)
#pragma unroll
                for (int m = 0; m < 4; ++m)
#pragma unroll
                    for (int n = 0; n < 2; ++n) acc[a][b][m][n] = acc_t{};
        }
        cur = nxt; cA = nA; cB = nB; ++ui; nt = g.ntiles(cur);
        if constexpr (ALIGN_EPI) { if (wr == 1) PG8_BAR; }
    }
    PG8_WAIT_V(0);
    if constexpr (!ALIGN_EPI) { if (wr == 0) PG8_BAR; }
    PG8_BAR;
    if constexpr (Epi::AFTER_DRAIN) { E.fused(acc, cur, wr, wc, fr, fq, lds, wid, lane); S.done(cur); }
#undef PG8_SA
#undef PG8_SB
#undef PG8_STAGE
#undef PG8_LDA
#undef PG8_LDB
#undef PG8_MMA
#undef PG8_WAIT_V
#undef PG8_WAIT_L
#undef PG8_BAR
#undef PG8_SCHED
}
}
namespace att {
typedef unsigned short bf16;
using bf16x8 = __attribute__((ext_vector_type(8))) short;
using s16x4  = __attribute__((ext_vector_type(4))) short;
using f32x16 = __attribute__((ext_vector_type(16))) float;
using u32x4  = __attribute__((ext_vector_type(4))) unsigned;
constexpr int D = 128, NW = 8, QBLK = 32, KVBLK = 64;
constexpr int SHM_V = KVBLK * D * 2, SHM_K = KVBLK * D * 2;
constexpr int OFF_WS = 2 * SHM_V + 2 * SHM_K, OFF_TBL = OFF_WS + NW * 64 * 4, SHM_ATTN = OFF_TBL + 4096;
constexpr float THR2 = 8.f;
constexpr float LOG2E = 1.4426950408889634f;
enum { M_NA = 0, M_DENSE = 1, M_ALIBI = 2, M_DIL = 3 };
#define KSWZ(row, colB) ((row) * 256 + ((colB) ^ (((row) & 7) << 4)))
#define SBAR() __builtin_amdgcn_sched_barrier(0)
__device__ __forceinline__ int crow(int r, int hi) { return (r & 3) + 8 * (r >> 2) + 4 * hi; }
__device__ __forceinline__ unsigned cvtpk(float lo, float hi) { unsigned r; asm volatile("v_cvt_pk_bf16_f32 %0, %1, %2" : "=v"(r) : "v"(lo), "v"(hi)); return r; }
__device__ __forceinline__ unsigned short f2bf1(float f) { unsigned u = __builtin_bit_cast(unsigned, f); return (unsigned short)((u + 0x7fffu + ((u >> 16) & 1u)) >> 16); }
__device__ __forceinline__ float bf2f(unsigned short h) { return __builtin_bit_cast(float, (unsigned)h << 16); }

__device__ __forceinline__ void partialSM(f32x16& p0, f32x16& p1, float& m_reg, float& mn, float& alpha) {
  float pmax = p0[0];
#pragma unroll
  for (int r = 1; r < 16; ++r) pmax = fmaxf(pmax, p0[r]);
#pragma unroll
  for (int r = 0; r < 16; ++r) pmax = fmaxf(pmax, p1[r]);
  { auto rr = __builtin_amdgcn_permlane32_swap(__float_as_uint(pmax), __float_as_uint(pmax), false, false);
    pmax = fmaxf(__uint_as_float(rr[0]), __uint_as_float(rr[1])); }
  if (__builtin_expect(__all(pmax - m_reg <= THR2), 1)) { mn = m_reg; alpha = 1.f; }
  else { mn = fmaxf(m_reg, pmax); alpha = __builtin_amdgcn_exp2f(m_reg - mn); m_reg = mn; }
#pragma unroll
  for (int r = 0; r < 16; ++r) p0[r] = p0[r] - mn;
#pragma unroll
  for (int r = 0; r < 16; ++r) p1[r] = p1[r] - mn;
#pragma unroll
  for (int r = 0; r < 16; ++r) p0[r] = __builtin_amdgcn_exp2f(p0[r]);
}
__device__ __forceinline__ void finishSM(f32x16& p0, f32x16& p1, float alpha, float& l_reg, bf16x8& pa0, bf16x8& pa1, bf16x8& pa2, bf16x8& pa3) {
#pragma unroll
  for (int r = 0; r < 16; ++r) p1[r] = __builtin_amdgcn_exp2f(p1[r]);
  float ps = 0;
#pragma unroll
  for (int r = 0; r < 16; ++r) ps += p0[r];
#pragma unroll
  for (int r = 0; r < 16; ++r) ps += p1[r];
  { auto rr = __builtin_amdgcn_permlane32_swap(__float_as_uint(ps), __float_as_uint(ps), false, false);
    ps = __uint_as_float(rr[0]) + __uint_as_float(rr[1]); }
  l_reg = l_reg * alpha + ps;
#define PK4(P, BASE, OUT) do { unsigned a0 = cvtpk(P[BASE + 0], P[BASE + 1]), a1 = cvtpk(P[BASE + 2], P[BASE + 3]);   \
    unsigned b0 = cvtpk(P[BASE + 4], P[BASE + 5]), b1 = cvtpk(P[BASE + 6], P[BASE + 7]);                              \
    auto r0 = __builtin_amdgcn_permlane32_swap(a0, b0, false, false); auto r1 = __builtin_amdgcn_permlane32_swap(a1, b1, false, false); \
    u32x4 w = {r0[0], r1[0], r0[1], r1[1]}; OUT = *reinterpret_cast<bf16x8*>(&w); } while (0)
  PK4(p0, 0, pa0); PK4(p0, 8, pa1); PK4(p1, 0, pa2); PK4(p1, 8, pa3);
#undef PK4
}
__device__ __forceinline__ void qkt(f32x16& p0, f32x16& p1, const bf16* Ks, const bf16x8* qr, int r32, int hi) {
  p0 = f32x16{}; p1 = f32x16{};
#pragma unroll
  for (int d0 = 0; d0 < 8; ++d0) { int cb = (d0 * 16 + hi * 8) * 2;
    bf16x8 b0 = *reinterpret_cast<const bf16x8*>((const char*)Ks + KSWZ(r32, cb));
    bf16x8 b1 = *reinterpret_cast<const bf16x8*>((const char*)Ks + KSWZ(32 + r32, cb));
    p0 = __builtin_amdgcn_mfma_f32_32x32x16_bf16(b0, qr[d0], p0, 0, 0, 0);
    p1 = __builtin_amdgcn_mfma_f32_32x32x16_bf16(b1, qr[d0], p1, 0, 0, 0); }
}
__device__ __forceinline__ int v_st(int k, int c) { const int kk = (k & ~0xC) | ((k & 4) << 1) | ((k & 8) >> 1); return ((kk >> 3) * 4 + (c >> 5)) * 512 + ((kk & 7) * 32 + (c & 31)) * 2; }
__device__ __forceinline__ int v_rd_base(int lane) { return ((lane & 3) << 3) | (((lane >> 2) & 3) << 6) | (((lane >> 4) & 1) << 5) | (((lane >> 5) & 1) << 8); }
constexpr int v_rd_off(int d0, int ks, int half) { return d0 * 512 + ks * 4096 + half * 2048; }
template <int OFF> __device__ __forceinline__ s16x4 tr_read(int vb) {
  s16x4 r; asm volatile("ds_read_b64_tr_b16 %0, %1 offset:%2" : "=&v"(r) : "v"(vb), "i"(OFF) : "memory"); return r;
}
template <int D0> __device__ __forceinline__ void pv_one(f32x16& od, int vb, bf16x8 pa0, bf16x8 pa1, bf16x8 pa2, bf16x8 pa3) {
  const s16x4 l0 = tr_read<v_rd_off(D0, 0, 0)>(vb), h0 = tr_read<v_rd_off(D0, 0, 1)>(vb), l1 = tr_read<v_rd_off(D0, 1, 0)>(vb), h1 = tr_read<v_rd_off(D0, 1, 1)>(vb);
  const s16x4 l2 = tr_read<v_rd_off(D0, 2, 0)>(vb), h2 = tr_read<v_rd_off(D0, 2, 1)>(vb), l3 = tr_read<v_rd_off(D0, 3, 0)>(vb), h3 = tr_read<v_rd_off(D0, 3, 1)>(vb);
  asm volatile("s_waitcnt lgkmcnt(0)" ::: "memory"); SBAR();
#define PK(L, H) (bf16x8){L[0], L[1], L[2], L[3], H[0], H[1], H[2], H[3]}
  od = __builtin_amdgcn_mfma_f32_32x32x16_bf16(pa0, PK(l0, h0), od, 0, 0, 0);
  od = __builtin_amdgcn_mfma_f32_32x32x16_bf16(pa1, PK(l1, h1), od, 0, 0, 0);
  od = __builtin_amdgcn_mfma_f32_32x32x16_bf16(pa2, PK(l2, h2), od, 0, 0, 0);
  od = __builtin_amdgcn_mfma_f32_32x32x16_bf16(pa3, PK(l3, h3), od, 0, 0, 0);
#undef PK
}
template <int D0> __device__ __forceinline__ void pv_one_lean(f32x16& od, int vb, bf16x8 pa0, bf16x8 pa1, bf16x8 pa2, bf16x8 pa3) {
#define PK(L, H) (bf16x8){L[0], L[1], L[2], L[3], H[0], H[1], H[2], H[3]}
  { const s16x4 l0 = tr_read<v_rd_off(D0, 0, 0)>(vb), h0 = tr_read<v_rd_off(D0, 0, 1)>(vb), l1 = tr_read<v_rd_off(D0, 1, 0)>(vb), h1 = tr_read<v_rd_off(D0, 1, 1)>(vb);
    asm volatile("s_waitcnt lgkmcnt(0)" ::: "memory"); SBAR();
    od = __builtin_amdgcn_mfma_f32_32x32x16_bf16(pa0, PK(l0, h0), od, 0, 0, 0);
    od = __builtin_amdgcn_mfma_f32_32x32x16_bf16(pa1, PK(l1, h1), od, 0, 0, 0); }
  { const s16x4 l2 = tr_read<v_rd_off(D0, 2, 0)>(vb), h2 = tr_read<v_rd_off(D0, 2, 1)>(vb), l3 = tr_read<v_rd_off(D0, 3, 0)>(vb), h3 = tr_read<v_rd_off(D0, 3, 1)>(vb);
    asm volatile("s_waitcnt lgkmcnt(0)" ::: "memory"); SBAR();
    od = __builtin_amdgcn_mfma_f32_32x32x16_bf16(pa2, PK(l2, h2), od, 0, 0, 0);
    od = __builtin_amdgcn_mfma_f32_32x32x16_bf16(pa3, PK(l3, h3), od, 0, 0, 0); }
#undef PK
}
__device__ __forceinline__ void pv_d0_lean(f32x16* o, int vb, bf16x8 pa0, bf16x8 pa1, bf16x8 pa2, bf16x8 pa3) {
  pv_one_lean<0>(o[0], vb, pa0, pa1, pa2, pa3); pv_one_lean<1>(o[1], vb, pa0, pa1, pa2, pa3); pv_one_lean<2>(o[2], vb, pa0, pa1, pa2, pa3); pv_one_lean<3>(o[3], vb, pa0, pa1, pa2, pa3);
}
__device__ __forceinline__ void pv_d0(f32x16* o, int vb, bf16x8 pa0, bf16x8 pa1, bf16x8 pa2, bf16x8 pa3) {
  pv_one<0>(o[0], vb, pa0, pa1, pa2, pa3); pv_one<1>(o[1], vb, pa0, pa1, pa2, pa3); pv_one<2>(o[2], vb, pa0, pa1, pa2, pa3); pv_one<3>(o[3], vb, pa0, pa1, pa2, pa3);
}

struct UA {
  const bf16* Q; long ldq;
  const bf16* K; const bf16* V; long ldk;
  int NT;
  int j0;
  int qk0;
  float slope2;
  int qrow0, krow0;
  const float* tbl;
  bf16* Y; long ldy; const bf16* Z; long ldz;
  float* O; long ldo;
  float* L; long ldl;
};

template <int MODE, int SDEPTH>
__device__ __forceinline__ void attn_unit(const UA& a, char* lds, const int wave_in) {
  int tid_ = fresh_tid(wave_in); asm volatile("" : "+v"(tid_));
  const int tid = tid_, wid = __builtin_amdgcn_readfirstlane(tid >> 6), lane = tid & 63, r32 = lane & 31, hi = lane >> 5;
  bf16* V_lds = (bf16*)lds; bf16* K_lds = (bf16*)(lds + 2 * SHM_V);
  float* ws = (float*)(lds + OFF_WS) + wid * 64; float* li_l = ws; float* al_l = ws + 32;
  float* tbl = (float*)(lds + OFF_TBL) + 64;
  if (MODE == M_NA) { __syncthreads(); for (int i = tid; i < 15 * 31; i += 512) tbl[i] = a.tbl[i] * LOG2E; }
  float m_reg = -1e30f, l_reg = 0; f32x16 o[4] = {}; bf16x8 qr[8];
  const bf16* Qw = a.Q + (long)(wid * QBLK + r32) * a.ldq + hi * 8;
#pragma unroll
  for (int d0 = 0; d0 < 8; ++d0) qr[d0] = *reinterpret_cast<const bf16x8*>(Qw + d0 * 16);
  const int sr = tid >> 4, sc = (tid & 15) * 8, vst0 = v_st(sr, sc), vst1 = v_st(32 + sr, sc);
  const int vb0 = (int)(uintptr_t)V_lds + v_rd_base(lane);
  const bf16* Kh = a.K; const bf16* Vh = a.V; const long LDK = a.ldk;
  struct { bf16x8 vs0, vs1, ks0, ks1; } sr_[SDEPTH];
#define SLOAD(i, k0) do { sr_[i].vs0 = *reinterpret_cast<const bf16x8*>(&Vh[(long)((k0) + sr) * LDK + sc]); sr_[i].vs1 = *reinterpret_cast<const bf16x8*>(&Vh[(long)((k0) + 32 + sr) * LDK + sc]); \
    sr_[i].ks0 = *reinterpret_cast<const bf16x8*>(&Kh[(long)((k0) + sr) * LDK + sc]); sr_[i].ks1 = *reinterpret_cast<const bf16x8*>(&Kh[(long)((k0) + 32 + sr) * LDK + sc]); } while (0)
#define SWRITE(b, i) do { *(bf16x8*)((char*)V_lds + (b) * SHM_V + vst0) = sr_[i].vs0;          \
    *(bf16x8*)((char*)V_lds + (b) * SHM_V + vst1) = sr_[i].vs1; int kc = sc * 2;               \
    *(bf16x8*)((char*)K_lds + (b) * SHM_K + KSWZ(sr, kc)) = sr_[i].ks0;                       \
    *(bf16x8*)((char*)K_lds + (b) * SHM_K + KSWZ(32 + sr, kc)) = sr_[i].ks1; } while (0)
#define SWAIT() do { if constexpr (SDEPTH == 2) asm volatile("s_waitcnt vmcnt(4)" ::: "memory"); else asm volatile("s_waitcnt vmcnt(0)" ::: "memory"); } while (0)
#define RESC(a_) do { if (__any((a_) < 1.f)) { if (hi == 0) al_l[r32] = (a_); asm volatile("s_waitcnt lgkmcnt(0)" ::: "memory"); \
    _Pragma("unroll") for (int d = 0; d < 4; ++d) _Pragma("unroll") for (int r = 0; r < 16; ++r) o[d][r] *= al_l[crow(r, hi)]; } } while (0)
  const float NEG_INF = -__builtin_inff();
  const int qkrel = a.qk0 + wid * 32 + r32 - 4 * hi;
  const float nslope = -a.slope2;
  const int qgr = a.qrow0 + (wid >> 1), cq = 32 * (wid & 1) + r32;
  const int c0 = min(max(cq - 8, 0), 48), r0 = min(max(qgr - 4, 0), 56);
#define MOD(P0, P1, J) do { \
    if (MODE == M_ALIBI || MODE == M_DIL) { const float rel = (float)(qkrel - (J) * 64); \
      _Pragma("unroll") for (int r = 0; r < 16; ++r) { const float cr = (float)((r & 3) + 8 * (r >> 2)); const float d0_ = fabsf(rel - cr), d1_ = fabsf(rel - cr - 32.f); \
        float v0_ = fmaf(nslope, d0_, P0[r]), v1_ = fmaf(nslope, d1_, P1[r]); \
        if (MODE == M_DIL) { v0_ = (d0_ <= 64.f) ? v0_ : NEG_INF; v1_ = (d1_ <= 64.f) ? v1_ : NEG_INF; } \
        P0[r] = v0_; P1[r] = v1_; } } \
    if (MODE == M_NA) { const int kr = a.krow0 + (J); const bool rv = (kr >= r0) && (kr < r0 + 8); \
      if (!rv) { _Pragma("unroll") for (int r = 0; r < 16; ++r) { P0[r] = NEG_INF; P1[r] = NEG_INF; } } \
      else { const float* tp = tbl + (kr - qgr + 7) * 31 + (4 * hi - cq + 15); const int kcb = 4 * hi - c0; \
        _Pragma("unroll") for (int r = 0; r < 16; ++r) { const int cr = (r & 3) + 8 * (r >> 2); \
          const bool ok0 = (unsigned)(kcb + cr) < 16u, ok1 = (unsigned)(kcb + cr + 32) < 16u; \
          const float b0_ = tp[cr], b1_ = tp[cr + 32]; \
          P0[r] = ok0 ? P0[r] + b0_ : NEG_INF; P1[r] = ok1 ? P1[r] + b1_ : NEG_INF; } } } \
  } while (0)
  f32x16 pA0, pA1, pB0, pB1; float mnA, mnB, alA, alB; bf16x8 pa0, pa1, pa2, pa3; const int NT = a.NT;
  constexpr int SE = 0, SO = SDEPTH - 1;
  SLOAD(SE, 0); asm volatile("s_waitcnt vmcnt(0)" ::: "memory"); SWRITE(0, SE); __syncthreads();
  qkt(pA0, pA1, K_lds, qr, r32, hi); MOD(pA0, pA1, 0); partialSM(pA0, pA1, m_reg, mnA, alA);
  SLOAD(SO, KVBLK); if constexpr (SDEPTH == 2) { if (2 < NT) SLOAD(SE, 2 * KVBLK); }
  SWAIT(); SWRITE(1, SO); __syncthreads();
  for (int j = 1; j + 1 < NT; j += 2) {
    SBAR(); qkt(pB0, pB1, (bf16*)((char*)K_lds + SHM_K), qr, r32, hi); MOD(pB0, pB1, j);
    finishSM(pA0, pA1, alA, l_reg, pa0, pa1, pa2, pa3); SBAR();
    SLOAD(SO, (j + SDEPTH) * KVBLK); SBAR();
    pv_d0(o, vb0, pa0, pa1, pa2, pa3); partialSM(pB0, pB1, m_reg, mnB, alB);
    __syncthreads(); SWAIT(); SWRITE(0, SE);
    RESC(alB); __syncthreads();
    SBAR(); qkt(pA0, pA1, K_lds, qr, r32, hi); MOD(pA0, pA1, j + 1);
    finishSM(pB0, pB1, alB, l_reg, pa0, pa1, pa2, pa3); SBAR();
    if (SDEPTH == 1 || j + 3 < NT) SLOAD(SE, (j + 1 + SDEPTH) * KVBLK); SBAR();
    pv_d0(o, vb0 + (int)SHM_V, pa0, pa1, pa2, pa3); partialSM(pA0, pA1, m_reg, mnA, alA);
    __syncthreads(); SWAIT(); SWRITE(1, SO);
    RESC(alA); __syncthreads();
  }
  SBAR(); qkt(pB0, pB1, (bf16*)((char*)K_lds + SHM_K), qr, r32, hi); MOD(pB0, pB1, NT - 1);
  finishSM(pA0, pA1, alA, l_reg, pa0, pa1, pa2, pa3); SBAR();
  pv_d0(o, vb0, pa0, pa1, pa2, pa3); partialSM(pB0, pB1, m_reg, mnB, alB);
  __syncthreads(); RESC(alB);
  finishSM(pB0, pB1, alB, l_reg, pa0, pa1, pa2, pa3); SBAR();
  pv_d0(o, vb0 + (int)SHM_V, pa0, pa1, pa2, pa3);
  if (hi == 0) li_l[r32] = l_reg; asm volatile("s_waitcnt lgkmcnt(0)" ::: "memory");
  float rli[16];
#pragma unroll
  for (int r = 0; r < 16; ++r) rli[r] = __builtin_amdgcn_rcpf(li_l[crow(r, hi)]);
  if (MODE == M_NA || MODE == M_DENSE) {
#pragma unroll
    for (int r = 0; r < 16; ++r) { const long orow = wid * QBLK + crow(r, hi);
#pragma unroll
      for (int d0 = 0; d0 < 4; ++d0) { const float z = bf2f(a.Z[orow * a.ldz + d0 * 32 + r32]); a.Y[orow * a.ldy + d0 * 32 + r32] = f2bf1(o[d0][r] * rli[r] * z); } }
  } else {
#pragma unroll
    for (int r = 0; r < 16; ++r) { const long orow = wid * QBLK + crow(r, hi);
#pragma unroll
      for (int d0 = 0; d0 < 4; ++d0) a.O[orow * a.ldo + d0 * 32 + r32] = o[d0][r] * rli[r]; }
    if (MODE == M_DIL) { if (hi == 0) a.L[(long)(wid * QBLK + r32) * a.ldl] = m_reg + __builtin_amdgcn_logf(l_reg); }
  }
#undef SLOAD
#undef SWRITE
#undef SWAIT
#undef RESC
#undef MOD
}

#define ATT_LAS __attribute__((address_space(3)))
#ifndef PINGPONG_SPLIT
#define PINGPONG_SPLIT 4
#endif
template <int MODE, int NVH>
__device__ __forceinline__ void attn_unit_dma(const UA& a, char* lds, int wsoff, const int wave_in) {
  int tid_ = fresh_tid(wave_in); asm volatile("" : "+v"(tid_));
  const int tid = tid_, wid = __builtin_amdgcn_readfirstlane(tid >> 6), lane = tid & 63, r32 = lane & 31, hi = lane >> 5;
  constexpr int KB = 16384, VB = NVH * 16384, OFF_V2 = 2 * KB;
  char* K_lds = lds;
  float* ws = (float*)(lds + wsoff) + wid * 64; float* li_l = ws; float* al_l = ws + 32;
  float* tbl = (float*)(lds + wsoff + 2048) + 64;
  if (MODE == M_NA) { for (int i = tid; i < 15 * 31; i += 512) tbl[i] = a.tbl[i] * LOG2E; }
  float m_reg = -1e30f, l_reg = 0; f32x16 o[4 * NVH]; bf16x8 qr[8];
#pragma unroll
  for (int d = 0; d < 4 * NVH; ++d) o[d] = f32x16{};
  const bf16* Qw = a.Q + (long)(wid * QBLK + r32) * a.ldq + hi * 8;
#pragma unroll
  for (int d0 = 0; d0 < 8; ++d0) qr[d0] = *reinterpret_cast<const bf16x8*>(Qw + d0 * 16);
  const int vb0 = (int)(uintptr_t)(lds + OFF_V2) + v_rd_base(lane);
  const unsigned ldkb = (unsigned)(a.ldk * 2);
  unsigned koff[2], voff[2 * NVH];
#pragma unroll
  for (int i = 0; i < 2; ++i) { const int row = (wid * 2 + i) * 4 + (lane >> 4), c = (lane & 15) ^ (row & 7); koff[i] = (unsigned)row * ldkb + (unsigned)c * 16u; }
#pragma unroll
  for (int i = 0; i < 2 * NVH; ++i) { const int vb = wid * 2 * NVH + i, half = vb >> 4, b = (vb & 15) * 1024 + lane * 16;
    const int sub = b >> 9, e = (b & 511) >> 1, kk = (sub >> 2) * 8 + (e >> 5), c = (sub & 3) * 32 + (e & 31);
    const int k = (kk & ~0xC) | ((kk & 4) << 1) | ((kk & 8) >> 1);
    voff[i] = (unsigned)k * ldkb + (unsigned)(half * 128 + c) * 2u; }
  const char* Kb = (const char*)a.K; const char* Vb = (const char*)a.V; const size_t tstep = (size_t)KVBLK * ldkb;
  ATT_LAS unsigned char* ldl = (ATT_LAS unsigned char*)lds;
#define TROT(j) (((j) + a.j0 >= NT) ? (j) + a.j0 - NT : (j) + a.j0)
#define DMA(j, ks, vs) do { const int jt_ = TROT(j); const char* kt_ = Kb + (size_t)jt_ * tstep; const char* vt_ = Vb + (size_t)jt_ * tstep; \
    _Pragma("unroll") for (int i_ = 0; i_ < 2; ++i_) __builtin_amdgcn_global_load_lds((const unsigned*)(kt_ + koff[i_]), (ATT_LAS unsigned*)(ldl + (ks) * KB + (wid * 2 + i_) * 1024), 16, 0, 0); \
    _Pragma("unroll") for (int i_ = 0; i_ < 2 * NVH; ++i_) __builtin_amdgcn_global_load_lds((const unsigned*)(vt_ + voff[i_]), (ATT_LAS unsigned*)(ldl + OFF_V2 + (vs) * VB + (wid * 2 * NVH + i_) * 1024), 16, 0, 0); } while (0)
#define RESC(a_) do { if (__any((a_) < 1.f)) { if (hi == 0) al_l[r32] = (a_); asm volatile("s_waitcnt lgkmcnt(0)" ::: "memory"); \
    _Pragma("unroll") for (int d = 0; d < 4 * NVH; ++d) _Pragma("unroll") for (int r = 0; r < 16; ++r) o[d][r] *= al_l[crow(r, hi)]; } } while (0)
  const float NEG_INF = -__builtin_inff();
  const int qkrel = a.qk0 + wid * 32 + r32 - 4 * hi;
  const float nslope = -a.slope2;
  const int qgr = a.qrow0 + (wid >> 1), cq = 32 * (wid & 1) + r32;
  const int c0 = min(max(cq - 8, 0), 48), r0 = min(max(qgr - 4, 0), 56);
#define ROWOK(J) ((MODE == M_NA) ? ((a.krow0 + (J)) >= r0 && (a.krow0 + (J)) < r0 + 8) : (MODE == M_DIL) ? ((J) * 64 <= a.qk0 + wid * 32 + 95 && (J) * 64 + 127 >= a.qk0 + wid * 32) : true)
#define MOD(P0, P1, J) do { \
    if (MODE == M_ALIBI || MODE == M_DIL) { const float rel = (float)(qkrel - (J) * 64); \
      _Pragma("unroll") for (int r = 0; r < 16; ++r) { const float cr = (float)((r & 3) + 8 * (r >> 2)); const float d0_ = fabsf(rel - cr), d1_ = fabsf(rel - cr - 32.f); \
        float v0_ = fmaf(nslope, d0_, P0[r]), v1_ = fmaf(nslope, d1_, P1[r]); \
        if (MODE == M_DIL) { v0_ = (d0_ <= 64.f) ? v0_ : NEG_INF; v1_ = (d1_ <= 64.f) ? v1_ : NEG_INF; } \
        P0[r] = v0_; P1[r] = v1_; } } \
    if (MODE == M_NA) { const int kr = a.krow0 + (J); const float* tp = tbl + (kr - qgr + 7) * 31 + (4 * hi - cq + 15); const int kcb = 4 * hi - c0; \
      _Pragma("unroll") for (int r = 0; r < 16; ++r) { const int cr = (r & 3) + 8 * (r >> 2); \
        const bool ok0 = (unsigned)(kcb + cr) < 16u, ok1 = (unsigned)(kcb + cr + 32) < 16u; \
        const float b0_ = tp[cr], b1_ = tp[cr + 32]; \
        P0[r] = ok0 ? P0[r] + b0_ : NEG_INF; P1[r] = ok1 ? P1[r] + b1_ : NEG_INF; } } \
  } while (0)
  f32x16 p0, p1; float mn, al; bf16x8 pa0, pa1, pa2, pa3; const int NT = a.NT;
#define TOP(j, ks, vs) do { asm volatile("s_waitcnt vmcnt(0)" ::: "memory");        \
    __builtin_amdgcn_s_barrier(); asm volatile("" ::: "memory");                    \
    if ((j) + 1 < NT) DMA((j) + 1, (ks) ^ 1, ((vs) == 2) ? 0 : (vs) + 1); } while (0)
#define QKSM(j, ks) do { SBAR(); qkt(p0, p1, (const bf16*)(K_lds + (ks) * KB), qr, r32, hi); MOD(p0, p1, TROT(j)); \
    partialSM(p0, p1, m_reg, mn, al); RESC(al); finishSM(p0, p1, al, l_reg, pa0, pa1, pa2, pa3); SBAR(); } while (0)
#define PVS(vs) do { _Pragma("unroll") for (int h = 0; h < NVH; ++h) { if (NVH == 2) pv_d0_lean(o + 4 * h, vb0 + (vs) * VB + h * 16384, pa0, pa1, pa2, pa3); else pv_d0(o + 4 * h, vb0 + (vs) * VB + h * 16384, pa0, pa1, pa2, pa3); } } while (0)
  DMA(0, 0, 0);
  if (wid < PINGPONG_SPLIT) {
    int vs = 0;
    for (int j = 0; j < NT; ++j) { const int ks = j & 1;
      TOP(j, ks, vs); if (ROWOK(TROT(j))) { QKSM(j, ks); PVS(vs); }
      vs = (vs == 2) ? 0 : vs + 1; }
  } else {
    int vs = 0, vprev = 0; bool pend = false;
    for (int j = 0; j < NT; ++j) { const int ks = j & 1;
      TOP(j, ks, vs); if (pend) PVS(vprev); pend = ROWOK(TROT(j)); if (pend) QKSM(j, ks);
      vprev = vs; vs = (vs == 2) ? 0 : vs + 1; }
    if (pend) PVS(vprev);
  }
  if (hi == 0) li_l[r32] = l_reg; asm volatile("s_waitcnt lgkmcnt(0)" ::: "memory");
  float rli[16];
#pragma unroll
  for (int r = 0; r < 16; ++r) rli[r] = __builtin_amdgcn_rcpf(li_l[crow(r, hi)]);
  if (MODE == M_DENSE || MODE == M_NA) {
#pragma unroll
    for (int r = 0; r < 16; ++r) { const long orow = wid * QBLK + crow(r, hi);
#pragma unroll
      for (int d0 = 0; d0 < 4 * NVH; ++d0) { const float z = bf2f(a.Z[orow * a.ldz + d0 * 32 + r32]); a.Y[orow * a.ldy + d0 * 32 + r32] = f2bf1(o[d0][r] * rli[r] * z); } }
  } else {
#pragma unroll
    for (int r = 0; r < 16; ++r) { const long orow = wid * QBLK + crow(r, hi);
#pragma unroll
      for (int d0 = 0; d0 < 4 * NVH; ++d0) a.O[orow * a.ldo + d0 * 32 + r32] = o[d0][r] * rli[r]; }
    if (MODE == M_DIL) { if (hi == 0) a.L[(long)(wid * QBLK + r32) * a.ldl] = m_reg + __builtin_amdgcn_logf(l_reg); }
  }
  __builtin_amdgcn_s_barrier(); asm volatile("" ::: "memory");
#undef DMA
#undef RESC
#undef MOD
#undef TOP
#undef QKSM
#undef PVS
#undef ROWOK
#undef TROT
}
#undef KSWZ
#undef SBAR
}
constexpr int NWAVES = 8;
#ifndef MK_ONE_LAUNCH
#define MK_ONE_LAUNCH 1
#endif
constexpr bool ONE_LAUNCH = MK_ONE_LAUNCH != 0;

constexpr int DM = 4096, NB = 2, SEQ = 4096, DEPTH = 2, HD = 128, GRID_W = 64;
constexpr int M = NB * SEQ;
constexpr int LDP = 32256;
constexpr float RMS_EPS = 1e-6f;
constexpr float QSCALE = 0.08838834764831845f * 1.4426950408889634f;
constexpr int CA_Q = 0, CA_K = 1024, CA_V = 2048, CA_Z = 3072;
constexpr int CB_Q = 4096, CB_K = 5120, CB_V = 5376, CB_Z = 5632;
constexpr int CC_Q = 6656, CC_K = 7680, CC_V = 8704, CC_Z = 9728;
constexpr int CD_Q = 10752, CD_K = 12288, CD_V = 13824, CD_Z = 15360;
constexpr int CG = 15872;

constexpr size_t MiB = 1u << 20;
constexpr size_t WS_CTL = 0, CTL_ZERO_BYTES = 1 * MiB;
constexpr int PK = DM + 64, PY = 1024 + 64;
constexpr size_t WS_WIN = 2 * MiB, WIN_LAYER = 256 * MiB;
constexpr size_t WBR_BLOCK = 9 * MiB;
constexpr size_t WS_WBR = WS_WIN + 2 * WIN_LAYER, WBR_LAYER = 4 * WBR_BLOCK;
constexpr size_t WS_WOUT = WS_WBR + 2 * WBR_LAYER, WOUT_LAYER = 33 * MiB;
constexpr size_t WS_XN = WS_WOUT + 2 * WOUT_LAYER;
constexpr size_t WS_PROJ = WS_XN + 66 * MiB;
constexpr size_t WS_OC = WS_PROJ + 504 * MiB;
constexpr size_t WS_OD = WS_OC + 64 * MiB;
constexpr size_t WS_LSE = WS_OD + 48 * MiB;
constexpr size_t Y_BLOCK = 17 * MiB;
constexpr size_t WS_YA = WS_LSE + 1 * MiB, WS_YB = WS_YA + Y_BLOCK, WS_YC = WS_YB + Y_BLOCK, WS_YD = WS_YC + Y_BLOCK;
constexpr size_t WS_MG = WS_YD + Y_BLOCK;
constexpr size_t WS_X1 = WS_MG + 66 * MiB;
constexpr int P8 = DM + 128;
constexpr size_t WS_XN8 = WS_X1 + 128 * MiB;
constexpr size_t WS_SA = WS_XN8 + 33 * MiB;
constexpr int N8 = 110 * 256;
constexpr size_t WS_WG8 = WS_SA + 1 * MiB, WG8_LAYER = 114 * MiB;
constexpr size_t WS_SB = WS_WG8 + 2 * WG8_LAYER;
constexpr size_t WS_MG8 = WS_SB + 1 * MiB;
constexpr size_t WS_SM = WS_MG8 + 33 * MiB;
constexpr size_t WS_WO8 = WS_SM + 1 * MiB, WO8_LAYER = 17 * MiB;
constexpr size_t WS_SO = WS_WO8 + 2 * WO8_LAYER;
constexpr size_t WS_END = WS_SO + 1 * MiB;
static_assert((size_t)DM * P8 <= WO8_LAYER, "d_ws map (int8 w_out)");
static_assert((size_t)M * P8 <= 33 * MiB && (size_t)N8 * P8 <= WG8_LAYER && (size_t)2 * N8 * 4 <= 1 * MiB, "d_ws map (int8)");
static_assert((size_t)LDP * PK * 2 <= WIN_LAYER && (size_t)DM * PY * 2 <= WBR_BLOCK && (size_t)DM * PK * 2 <= WOUT_LAYER && (size_t)M * PK * 2 <= 66 * MiB && (size_t)M * PY * 2 <= Y_BLOCK, "d_ws map");
constexpr int CW_BAR = 4096;

constexpr int RING_OFF = 0, RING_BYTES = 131072;
constexpr int LDSCTL_OFF = RING_BYTES, MISC_OFF = LDSCTL_OFF + 320;
constexpr int XTAB_OFF = RING_BYTES + 1024;
constexpr int LDS_BYTES = 147456;
static_assert(att::SHM_ATTN <= RING_BYTES, "attention scratch fits the ring region");

#define LAS __attribute__((address_space(3)))
typedef unsigned short bf16;
typedef unsigned v4u __attribute__((ext_vector_type(4)));
typedef unsigned v2u __attribute__((ext_vector_type(2)));
typedef float f32x4 __attribute__((ext_vector_type(4)));
#define LDS_WAIT() asm volatile("s_waitcnt lgkmcnt(0)" ::: "memory")
__device__ __forceinline__ unsigned f2bf(float f) { unsigned u = __builtin_bit_cast(unsigned, f); return (u + 0x7fffu + ((u >> 16) & 1u)) >> 16; }
__device__ __forceinline__ unsigned pk2(float lo, float hi) { return f2bf(lo) | (f2bf(hi) << 16); }
__device__ __forceinline__ float bflo(unsigned w) { return __builtin_bit_cast(float, w << 16); }
__device__ __forceinline__ float bfhi(unsigned w) { return __builtin_bit_cast(float, w & 0xffff0000u); }
#define XB_TMO      128
#define XB_XCNT(j)  (256  + 64 * (j))
#define XB_XSUB(j)  (1280 + 64 * (j))
#define XB_XGEN(j)  (2304 + 64 * (j))
#define XB_TOP      3328
#define XB_TOPGEN   3392
#define XCD_BAR_WORDS 3456
#define XB_SPIN_CAP (1u << 22)

__device__ __forceinline__ unsigned xb_ld(unsigned* p)              { return __hip_atomic_load(p, __ATOMIC_RELAXED, __HIP_MEMORY_SCOPE_AGENT); }
__device__ __forceinline__ unsigned xb_add(unsigned* p, unsigned v) { return __hip_atomic_fetch_add(p, v, __ATOMIC_RELAXED, __HIP_MEMORY_SCOPE_AGENT); }
__device__ __forceinline__ unsigned xb_xcc_id() { return (unsigned)__builtin_amdgcn_s_getreg((3 << 11) | 20) & 0xFu; }
#define XB_SPIN(cond, bar) do { unsigned _sp = 0; while (cond) { __builtin_amdgcn_s_sleep(1); \
    if ((++_sp & 255u) == 0u) { if (xb_ld(&(bar)[XB_TMO])) break; if (_sp > XB_SPIN_CAP) { atomicAdd(&(bar)[XB_TMO], 1u); break; } } } } while (0)

struct XcdBarrier {
    unsigned* bar; unsigned x;
    volatile LAS unsigned* st;
};

__device__ __forceinline__ XcdBarrier xcd_barrier_post(unsigned* bar, volatile LAS unsigned* st) {
    XcdBarrier b; b.bar = bar; b.x = xb_xcc_id(); b.st = st;
    if (threadIdx.x == 0) (void)xb_add(&bar[XB_XCNT(b.x)], 1u);
    return b;
}
__device__ __forceinline__ void xcd_barrier_complete(unsigned* bar, unsigned x, unsigned& nloc, unsigned& nx) {
    const unsigned G = gridDim.x * gridDim.y * gridDim.z;
    unsigned sum, cnt, mine, sp = 0u;
    for (;;) {
        sum = 0u; cnt = 0u; mine = 0u;
#pragma unroll 1
        for (unsigned j = 0; j < 16; ++j) { const unsigned c = xb_ld(&bar[XB_XCNT(j)]); sum += c; cnt += (c > 0u) ? 1u : 0u; mine = (j == x) ? c : mine; }
        if (sum == G) break;
        __builtin_amdgcn_s_sleep(1);
        if ((++sp & 255u) == 0u) { if (xb_ld(&bar[XB_TMO])) break; if (sp > XB_SPIN_CAP) { atomicAdd(&bar[XB_TMO], 1u); break; } }
    }
    nloc = mine > 0u ? mine : 1u; nx = cnt > 0u ? cnt : 1u;
}

__device__ __noinline__ void xcd_barrier(const XcdBarrier b, const bool leader  ) {
    asm volatile("s_waitcnt vmcnt(0)" ::: "memory");
    __syncthreads();
    if (leader) {
        unsigned* bar = b.bar;
        __builtin_amdgcn_s_waitcnt(0);
        unsigned nloc = b.st[0], nx = b.st[1];
        if (nloc == 0u) { xcd_barrier_complete(bar, b.x, nloc, nx); b.st[0] = nloc; b.st[1] = nx; }
        const unsigned old = xb_add(&bar[XB_XSUB(b.x)], 1u);
        const unsigned gen = old / nloc;
        if (old + 1u == (gen + 1u) * nloc) {
            __builtin_amdgcn_fence(__ATOMIC_RELEASE, "agent");
            asm volatile("s_waitcnt vmcnt(0)" ::: "memory");
            const unsigned og = xb_add(&bar[XB_TOP], 1u);
            const unsigned tg = og / nx;
            if (og + 1u == (tg + 1u) * nx) xb_add(&bar[XB_TOPGEN], 1u);
            else XB_SPIN(xb_ld(&bar[XB_TOPGEN]) == tg, bar);
            __builtin_amdgcn_fence(__ATOMIC_ACQUIRE, "agent");
            xb_add(&bar[XB_XGEN(b.x)], 1u);
            asm volatile("s_waitcnt vmcnt(0)" ::: "memory");
        } else {
            XB_SPIN(xb_ld(&bar[XB_XGEN(b.x)]) == gen, bar);
            __builtin_amdgcn_fence(__ATOMIC_ACQUIRE, "agent");
            asm volatile("s_waitcnt vmcnt(0)" ::: "memory");
        }
    }
    __syncthreads();
}
struct Frame {
    LAS unsigned char* lds;
    volatile LAS unsigned* MISC;
    unsigned* ctl;
    int tid, lane, wave;
    int vcu, G;
};
__device__ __forceinline__ float wave_sum(float v, const int lane) {
#pragma unroll
    for (int o = 1; o < 64; o <<= 1) v += __builtin_bit_cast(float, __builtin_amdgcn_ds_bpermute((lane ^ o) << 2, __builtin_bit_cast(int, v)));
    return v;
}
__device__ __forceinline__ float wave_max(float v, const int lane) {
#pragma unroll
    for (int o = 1; o < 64; o <<= 1) v = fmaxf(v, __builtin_bit_cast(float, __builtin_amdgcn_ds_bpermute((lane ^ o) << 2, __builtin_bit_cast(int, v))));
    return v;
}
__device__ __forceinline__ unsigned q8(float a, float b, float c, float d, float inv) {
    const int qa = (int)__builtin_rintf(a * inv), qb = (int)__builtin_rintf(b * inv), qc = (int)__builtin_rintf(c * inv), qd = (int)__builtin_rintf(d * inv);
    return (unsigned)(qa & 255) | ((unsigned)(qb & 255) << 8) | ((unsigned)(qc & 255) << 16) | ((unsigned)(qd & 255) << 24);
}
__device__ __forceinline__ void p0_transpose_item(const float* W, int K, int N, bf16* WT, int ldt, LAS float* scr, int item, int lane, int noff = 0, int ncols = 0) {
    const int nblk = (ncols ? ncols : N) / 32, kb = item / nblk, nb = item % nblk, k0 = 64 * kb, n0 = noff + 32 * nb;
    float v[32];
#pragma unroll
    for (int i = 0; i < 32; ++i) { const int kk = 2 * i + (lane >> 5); v[i] = __builtin_nontemporal_load(W + (size_t)(k0 + kk) * N + n0 + (lane & 31)); }
#pragma unroll
    for (int i = 0; i < 32; ++i) { const int kk = 2 * i + (lane >> 5); scr[kk * 33 + (lane & 31)] = v[i]; }
    LDS_WAIT(); asm volatile("" ::: "memory");
    const int c = lane & 7;
#pragma unroll
    for (int j = 0; j < 4; ++j) { const int n = (lane >> 3) + 8 * j; const LAS float* s = scr + (8 * c) * 33 + n;
        v4u o; o.x = pk2(s[0 * 33], s[1 * 33]); o.y = pk2(s[2 * 33], s[3 * 33]); o.z = pk2(s[4 * 33], s[5 * 33]); o.w = pk2(s[6 * 33], s[7 * 33]);
        *(v4u*)(WT + (size_t)(n0 + n) * ldt + k0 + 8 * c) = o; }
    LDS_WAIT(); asm volatile("" ::: "memory");
}
__device__ __forceinline__ void ld_xrow(const float* xrow, f32x4 (&v)[16], int lane) {
    const f32x4* xr = (const f32x4*)xrow + lane;
#pragma unroll
    for (int j = 0; j < 16; ++j) v[j] = xr[64 * j];
}
__device__ __forceinline__ void rms_row_regs(f32x4 (&v)[16], const float* g, bf16* orow, unsigned* qrow, float* sa_row, int lane) {
    const f32x4* gr = (const f32x4*)g + lane;
    float s = 0.f;
#pragma unroll
    for (int j = 0; j < 16; ++j) s += (v[j].x * v[j].x + v[j].y * v[j].y) + (v[j].z * v[j].z + v[j].w * v[j].w);
    const float rstd = 1.0f / sqrtf(wave_sum(s, lane) * (1.f / DM) + RMS_EPS);
    v2u* o8 = (v2u*)orow + lane; float mx = 0.f;
#pragma unroll
    for (int j = 0; j < 16; ++j) { const f32x4 gg = gr[64 * j]; v[j].x *= rstd * gg.x; v[j].y *= rstd * gg.y; v[j].z *= rstd * gg.z; v[j].w *= rstd * gg.w;
        mx = fmaxf(fmaxf(mx, fmaxf(fabsf(v[j].x), fabsf(v[j].y))), fmaxf(fabsf(v[j].z), fabsf(v[j].w)));
        v2u w; w.x = pk2(v[j].x, v[j].y); w.y = pk2(v[j].z, v[j].w); o8[64 * j] = w; }
    mx = fmaxf(wave_max(mx, lane), 1e-30f);
    const float inv = 127.0f / mx;
#pragma unroll
    for (int j = 0; j < 16; ++j) qrow[lane + 64 * j] = q8(v[j].x, v[j].y, v[j].z, v[j].w, inv);
    if (lane == 0) *sa_row = mx * (1.0f / 127.0f);
}
__device__ __forceinline__ void rms_row_to_bf16(const float* xrow, const float* g, bf16* orow, unsigned* qrow, float* sa_row, int lane) {
    f32x4 v[16]; ld_xrow(xrow, v, lane); rms_row_regs(v, g, orow, qrow, sa_row, lane);
}
__device__ __forceinline__ void ld_row16(const bf16* wrow, v4u (&w)[8], int lane) {
#pragma unroll
    for (int j = 0; j < 8; ++j) w[j] = *((const v4u*)wrow + lane + 64 * j);
}
__device__ __forceinline__ void q_row16(const v4u (&w)[8], unsigned* qrow, float* sc, int lane) {
    float mx = 0.f;
#pragma unroll
    for (int j = 0; j < 8; ++j) {
        mx = fmaxf(mx, fmaxf(fmaxf(fmaxf(fabsf(bflo(w[j].x)), fabsf(bfhi(w[j].x))), fmaxf(fabsf(bflo(w[j].y)), fabsf(bfhi(w[j].y)))), fmaxf(fmaxf(fabsf(bflo(w[j].z)), fabsf(bfhi(w[j].z))), fmaxf(fabsf(bflo(w[j].w)), fabsf(bfhi(w[j].w)))))); }
    mx = fmaxf(wave_max(mx, lane), 1e-30f);
    const float inv = 127.0f / mx;
#pragma unroll
    for (int j = 0; j < 8; ++j) { v2u o; o.x = q8(bflo(w[j].x), bfhi(w[j].x), bflo(w[j].y), bfhi(w[j].y), inv); o.y = q8(bflo(w[j].z), bfhi(w[j].z), bflo(w[j].w), bfhi(w[j].w), inv);
        *((v2u*)qrow + lane + 64 * j) = o; }
    if (lane == 0) *sc = mx * (1.0f / 127.0f);
}
struct Args;
template <class KPT> __device__ __forceinline__ void phase_prologue(Frame& F, KPT KP, unsigned char* ws) {
#define in_(i) ((const float*)(__attribute__((address_space(1))) const float*)(unsigned long long)KP->in[i])
    LAS float* scr = (LAS float*)(F.lds + RING_OFF + F.wave * 16384);
    const int gw = F.vcu * NWAVES + F.wave, NGW = F.G * NWAVES;
    constexpr int C16 = pg8::NT16 * 256, C16_OFF = 26 * 256;
    constexpr int I_IN = (DM / 64) * (C16 / 32), I_BR = (1024 / 64) * (DM / 32), I_BD = (512 / 64) * (DM / 32);
    constexpr int I_LAYER = I_IN + 3 * I_BR + I_BD;
    for (int it = gw; it < 2 * I_LAYER; it += NGW) {
        const int l = it / I_LAYER; int r = it % I_LAYER;
        bf16* wbr = (bf16*)(ws + WS_WBR + (size_t)l * WBR_LAYER);
        if (r < I_IN) { p0_transpose_item(in_(2) + (size_t)l * DM * LDP, DM, LDP, (bf16*)(ws + WS_WIN + (size_t)l * WIN_LAYER), PK, scr, r, F.lane, C16_OFF, C16); continue; } r -= I_IN;
        if (r < I_BR) { p0_transpose_item(in_(7) + (size_t)l * 1024 * DM, 1024, DM, wbr, PY, scr, r, F.lane); continue; } r -= I_BR;
        if (r < I_BR) { p0_transpose_item(in_(8) + (size_t)l * 1024 * DM, 1024, DM, wbr + 1 * (WBR_BLOCK / 2), PY, scr, r, F.lane); continue; } r -= I_BR;
        if (r < I_BR) { p0_transpose_item(in_(9) + (size_t)l * 1024 * DM, 1024, DM, wbr + 2 * (WBR_BLOCK / 2), PY, scr, r, F.lane); continue; } r -= I_BR;
        p0_transpose_item(in_(10) + (size_t)l * 512 * DM, 512, DM, wbr + 3 * (WBR_BLOCK / 2), PY, scr, r, F.lane);
    }
    {
        LAS float* cm = (LAS float*)(F.lds + RING_OFF + 12288);
        const int lane = F.lane, n = lane & 31, kpar = lane >> 5;
        constexpr int NBQ = N8 / 32;
        for (int it = F.vcu; it < 2 * NBQ + 2 * (DM / 32); it += F.G) {
            const float* W; int ldw; unsigned char* Q; float* SC;
            if (it < 2 * NBQ) { const int l = it / NBQ, n0c = (it % NBQ) * 32, n0 = pg8::map8(n0c >> 8) * 256 + (n0c & 255);
                W = in_(2) + (size_t)l * DM * LDP + n0 + n; ldw = LDP; Q = ws + WS_WG8 + (size_t)l * WG8_LAYER + (size_t)n0c * P8; SC = (float*)(ws + WS_SB) + (size_t)l * N8 + n0c; }
            else { const int r = it - 2 * NBQ, l = r / (DM / 32), n0 = (r % (DM / 32)) * 32;
                W = in_(11) + (size_t)l * DM * DM + n0 + n; ldw = DM; Q = ws + WS_WO8 + (size_t)l * WO8_LAYER + (size_t)n0 * P8; SC = (float*)(ws + WS_SO) + (size_t)l * DM + n0; }
            float mx = 0.f; unsigned pk[8][16];
#pragma unroll
            for (int kb = 0; kb < 8; ++kb) { const int k0 = (F.wave * 8 + kb) * 64;
                float v[32]; const float* wp = W + (size_t)(k0 + kpar) * ldw;
#pragma unroll
                for (int i = 0; i < 32; ++i) { v[i] = __builtin_nontemporal_load(wp); wp += 2 * ldw; asm volatile("" : "+v"(wp)); }
#pragma unroll
                for (int i = 0; i < 32; ++i) mx = fmaxf(mx, fabsf(v[i]));
#pragma unroll
                for (int i = 0; i < 16; ++i) { pk[kb][i] = pk2(v[2 * i], v[2 * i + 1]); asm volatile("" : "+v"(pk[kb][i])); }
                asm volatile("" ::: "memory"); __builtin_amdgcn_sched_barrier(0); }
            mx = fmaxf(mx, __builtin_bit_cast(float, __builtin_amdgcn_ds_bpermute((lane ^ 32) << 2, __builtin_bit_cast(int, mx))));
            if (lane < 32) cm[F.wave * 32 + lane] = mx;
            LDS_WAIT(); __syncthreads();
            float cmax = cm[n];
#pragma unroll
            for (int w = 1; w < 8; ++w) cmax = fmaxf(cmax, cm[w * 32 + n]);
            cmax = fmaxf(cmax, 1e-30f);
            const float inv = 127.0f / cmax;
            if (F.wave == 0 && lane < 32) SC[lane] = cmax * (1.0f / 127.0f);
#pragma unroll
            for (int kb = 0; kb < 8; ++kb) { const int k0 = (F.wave * 8 + kb) * 64;
#pragma unroll
                for (int i = 0; i < 16; ++i) { scr[(4 * i + kpar) * 33 + n] = bflo(pk[kb][i]) * inv; scr[(4 * i + 2 + kpar) * 33 + n] = bfhi(pk[kb][i]) * inv; }
                LDS_WAIT(); asm volatile("" ::: "memory");
                const int c = lane & 7;
#pragma unroll
                for (int j = 0; j < 4; ++j) { const int nn = (lane >> 3) + 8 * j; const LAS float* sp = scr + (8 * c) * 33 + nn;
                    v2u o; o.x = q8(sp[0 * 33], sp[1 * 33], sp[2 * 33], sp[3 * 33], 1.0f); o.y = q8(sp[4 * 33], sp[5 * 33], sp[6 * 33], sp[7 * 33], 1.0f);
                    *(v2u*)(Q + (size_t)nn * P8 + k0 + 8 * c) = o; }
                LDS_WAIT(); asm volatile("" ::: "memory"); __builtin_amdgcn_sched_barrier(0); }
            __syncthreads();
        }
    }
    for (int m = gw; m < M; m += NGW) rms_row_to_bf16(in_(0) + (size_t)m * DM, in_(1), (bf16*)(ws + WS_XN) + (size_t)m * PK, (unsigned*)(ws + WS_XN8 + (size_t)m * P8), (float*)(ws + WS_SA) + m, F.lane);
}
#undef in_
__device__ __forceinline__ void phase_finalize(Frame& F, unsigned char* ws, const float* lam_p  , const float* subln_g  , float lam_init) {
    const int gw = F.vcu * NWAVES + F.wave, NGW = F.G * NWAVES, lane = F.lane;
    const bf16* proj = (const bf16*)(ws + WS_PROJ);
    float d1 = lam_p[lane] * lam_p[128 + lane] + lam_p[64 + lane] * lam_p[192 + lane];
    float d2 = lam_p[256 + lane] * lam_p[384 + lane] + lam_p[320 + lane] * lam_p[448 + lane];
    d1 = wave_sum(d1, lane); d2 = wave_sum(d2, lane);
    const float lam = expf(d1) - expf(d2) + lam_init;
    const float post = 1.0f - lam_init;
    const float* OC = (const float*)(ws + WS_OC);
    const f32x4 sg = *(const f32x4*)(subln_g + 4 * lane);
    bf16* YC = (bf16*)(ws + WS_YC);
    for (int t = gw; t < M; t += NGW) {
        f32x4 o0[4], o1[4]; v2u zw[4];
#pragma unroll
        for (int h = 0; h < 4; ++h) { o0[h] = *(const f32x4*)(OC + (size_t)t * 2048 + (2 * h) * 256 + 4 * lane); o1[h] = *(const f32x4*)(OC + (size_t)t * 2048 + (2 * h + 1) * 256 + 4 * lane);
            zw[h] = *(const v2u*)(proj + (size_t)t * LDP + CC_Z + h * 256 + 4 * lane); }
#pragma unroll
        for (int h = 0; h < 4; ++h) {
            const f32x4 d = o0[h] - lam * o1[h];
            const float ss = wave_sum((d.x * d.x + d.y * d.y) + (d.z * d.z + d.w * d.w), lane);
            const float rstd = 1.0f / sqrtf(ss * (1.f / 256.f) + RMS_EPS) * post;
            v2u o; o.x = pk2(d.x * rstd * sg.x * bflo(zw[h].x), d.y * rstd * sg.y * bfhi(zw[h].x)); o.y = pk2(d.z * rstd * sg.z * bflo(zw[h].y), d.w * rstd * sg.w * bfhi(zw[h].y));
            *(v2u*)(YC + (size_t)t * PY + h * 256 + 4 * lane) = o;
        }
    }
    const float* OD = (const float*)(ws + WS_OD); const float* LSE = (const float*)(ws + WS_LSE);
    bf16* YD = (bf16*)(ws + WS_YD);
    const int hg = lane >> 4, c0 = hg * 128 + (lane & 15) * 8;
    for (int t0 = gw; t0 < M; t0 += 2 * NGW) {
        float ls[2][3]; f32x4 av[2][3][2]; v4u zw[2];
#pragma unroll
        for (int k = 0; k < 2; ++k) { const int t = min(t0 + k * NGW, M - 1);
#pragma unroll
            for (int g = 0; g < 3; ++g) { ls[k][g] = LSE[(size_t)g * M * 4 + (size_t)t * 4 + hg]; const float* pp = OD + (size_t)g * M * 512 + (size_t)t * 512 + c0; av[k][g][0] = *(const f32x4*)pp; av[k][g][1] = *(const f32x4*)(pp + 4); }
            zw[k] = *(const v4u*)(proj + (size_t)t * LDP + CD_Z + c0); }
#pragma unroll
        for (int k = 0; k < 2; ++k) { const int t = t0 + k * NGW;
            const float mx = fmaxf(ls[k][0], fmaxf(ls[k][1], ls[k][2]));
            float w0 = __builtin_amdgcn_exp2f(ls[k][0] - mx), w1 = __builtin_amdgcn_exp2f(ls[k][1] - mx), w2 = __builtin_amdgcn_exp2f(ls[k][2] - mx);
            const float inv = 1.0f / (w0 + w1 + w2); w0 *= inv; w1 *= inv; w2 *= inv;
            const f32x4 r0 = w0 * av[k][0][0] + w1 * av[k][1][0] + w2 * av[k][2][0], r1 = w0 * av[k][0][1] + w1 * av[k][1][1] + w2 * av[k][2][1];
            v4u o; o.x = pk2(r0.x * bflo(zw[k].x), r0.y * bfhi(zw[k].x)); o.y = pk2(r0.z * bflo(zw[k].y), r0.w * bfhi(zw[k].y));
            o.z = pk2(r1.x * bflo(zw[k].z), r1.y * bfhi(zw[k].z)); o.w = pk2(r1.z * bflo(zw[k].w), r1.w * bfhi(zw[k].w));
            if (t < M) *(v4u*)(YD + (size_t)t * PY + c0) = o; }
    }
}
#ifndef REP_AB
#define REP_AB 1
#endif
#ifndef REP_AC
#define REP_AC 1
#endif
#ifndef REP_AA
#define REP_AA 1
#endif
#ifndef REP_AD
#define REP_AD 1
#endif
#ifndef SD_DENSE
#define SD_DENSE 2
#endif
#ifndef SD_ALIBI
#define SD_ALIBI 2
#endif
#ifndef SD_NA
#define SD_NA 1
#endif
#ifndef SD_DIL
#define SD_DIL 1
#endif
__device__ __forceinline__ void phase_attention(Frame& F, unsigned char* ws, const float* rel_bias  , char* lds) {
    const att::bf16* P = (const att::bf16*)(ws + WS_PROJ);
    for (int rep = 0; rep < REP_AB; ++rep)
    for (int u = F.vcu; u < 256; u += F.G) {
        const int grp = u >> 6, b = grp >> 1, kvh = grp & 1, hq = kvh * 4 + ((u >> 4) & 3), qb = u & 15;
        const size_t tb = (size_t)b * SEQ, tq = tb + 256 * qb;
        att::UA a{};
        a.Q = P + tq * LDP + CB_Q + hq * 128; a.ldq = LDP;
        a.K = P + tb * LDP + CB_K + kvh * 128; a.V = P + tb * LDP + CB_V + kvh * 128; a.ldk = LDP; a.NT = SEQ / 64;
        a.Y = (att::bf16*)(ws + WS_YB) + tq * PY + hq * 128; a.ldy = PY; a.Z = P + tq * LDP + CB_Z + hq * 128; a.ldz = LDP;
        att::attn_unit_dma<att::M_DENSE, 1>(a, lds, 2 * 16384 + 3 * 16384, F.wave);
    }
    for (int rep = 0; rep < REP_AC; ++rep)
    for (int u = F.vcu; u < 256; u += F.G) {
        const int combo = u >> 4, b = combo >> 3, h = (combo >> 1) & 3, mp = combo & 1, qb = u & 15;
        const size_t tb = (size_t)b * SEQ, tq = tb + 256 * qb;
        att::UA a{};
        a.Q = P + tq * LDP + CC_Q + (h * 2 + mp) * 128; a.ldq = LDP;
        a.K = P + tb * LDP + CC_K + (h * 2 + mp) * 128; a.V = P + tb * LDP + CC_V + h * 256; a.ldk = LDP; a.NT = SEQ / 64;
        a.qk0 = 256 * qb; a.slope2 = __builtin_amdgcn_exp2f(-2.0f * (float)(h + 1)) * att::LOG2E; a.j0 = 4 * qb;
        a.O = (float*)(ws + WS_OC) + tq * 2048 + (h * 2 + mp) * 256; a.ldo = 2048;
        att::attn_unit_dma<att::M_ALIBI, 2>(a, lds, XTAB_OFF, F.wave);
    }
    for (int rep = 0; rep < REP_AA; ++rep)
    for (int u = F.vcu; u < 256; u += F.G) {
        const int b = u >> 7, h = (u >> 4) & 7, R = u & 15;
        const size_t tb = (size_t)b * SEQ, tq = tb + 256 * R;
        int kr_lo = min(max(4 * R - 4, 0), 56); const int kr_last = min(max(4 * R - 1, 0), 56) + 7; int NT = kr_last - kr_lo + 1;
        att::UA a{};
        a.Q = P + tq * LDP + CA_Q + h * 128; a.ldq = LDP;
        a.K = P + (tb + (size_t)kr_lo * 64) * LDP + CA_K + h * 128; a.V = P + (tb + (size_t)kr_lo * 64) * LDP + CA_V + h * 128; a.ldk = LDP; a.NT = NT;
        a.qrow0 = 4 * R; a.krow0 = kr_lo; a.tbl = rel_bias + h * (15 * 31);
        a.Y = (att::bf16*)(ws + WS_YA) + tq * PY + h * 128; a.ldy = PY; a.Z = P + tq * LDP + CA_Z + h * 128; a.ldz = LDP;
        att::attn_unit_dma<att::M_NA, 1>(a, lds, 2 * 16384 + 3 * 16384, F.wave);
    }
    for (int rep = 0; rep < REP_AD; ++rep)
    for (int u = F.vcu; u < 384; u += F.G) {
        const int bh = u >> 4, b = bh / 12, gh = bh % 12, g = gh >> 2, hg = gh & 3, u16 = u & 15;
        const int dil = (g == 0) ? 1 : ((g == 1) ? 4 : 16);
        const int qb = (g == 0) ? u16 : ((g == 1) ? (u16 & 3) : 0), rho = (g == 0) ? 0 : ((g == 1) ? (u16 >> 2) : u16);
        const int nttot = 64 / dil;
        const int t_lo = max(0, 4 * qb - 1), t_hi = min(nttot, 4 * qb + 5);
        const size_t tb = (size_t)b * SEQ, tq = tb + rho + (size_t)dil * 256 * qb, tk = tb + rho + (size_t)dil * 64 * t_lo;
        att::UA a{};
        a.Q = P + tq * LDP + CD_Q + gh * 128; a.ldq = (long)LDP * dil;
        a.K = P + tk * LDP + CD_K + gh * 128; a.V = P + tk * LDP + CD_V + gh * 128; a.ldk = (long)LDP * dil; a.NT = t_hi - t_lo;
        a.qk0 = 256 * qb - 64 * t_lo; a.slope2 = __builtin_amdgcn_exp2f(-8.0f * (float)(gh + 1) / 12.0f) * (float)dil * att::LOG2E;
        a.O = (float*)(ws + WS_OD) + (size_t)g * M * 512 + tq * 512 + hg * 128; a.ldo = 512L * dil;
        a.L = (float*)(ws + WS_LSE) + (size_t)g * M * 4 + tq * 4 + hg; a.ldl = 4L * dil;
        att::attn_unit_dma<att::M_DIL, 1>(a, lds, 2 * 16384 + 3 * 16384, F.wave);
    }
}

#ifndef REP_PRO
#define REP_PRO 1
#endif
#ifndef REP_INP
#define REP_INP 1
#endif
#ifndef REP_ATT
#define REP_ATT 1
#endif
#ifndef REP_FIN
#define REP_FIN 1
#endif
#ifndef REP_BRA
#define REP_BRA 1
#endif
#ifndef REP_OUT
#define REP_OUT 1
#endif
#ifndef REP_NRM
#define REP_NRM 1
#endif
constexpr int NPH = 14;
struct Args { const float* in[12]; float* out; unsigned char* ws; int ph_lo, ph_hi; };
__global__ void __launch_bounds__(NWAVES * 64, 2) mega_fwd(Args args) {
    extern __shared__ __attribute__((aligned(16))) unsigned char lds[];
    Frame F;
    F.lds = (LAS unsigned char*)lds;
    F.MISC = (volatile LAS unsigned*)(F.lds + MISC_OFF);
    F.tid = threadIdx.x; F.lane = F.tid & 63; F.wave = __builtin_amdgcn_readfirstlane(F.tid >> 6);
    const int wave0 = F.wave;
    F.G = gridDim.x; { const int bx = blockIdx.x; F.vcu = (F.G % 8 == 0) ? (bx % 8) * (F.G / 8) + bx / 8 : bx; }
    unsigned char* ws = args.ws;
    F.ctl = (unsigned*)(ws + WS_CTL);
    for (int u = F.tid; u < (LDS_BYTES - LDSCTL_OFF) / 4; u += NWAVES * 64) ((LAS unsigned*)(F.lds + LDSCTL_OFF))[u] = 0u;
    __syncthreads();
    XcdBarrier bar; bar.bar = F.ctl + CW_BAR; bar.x = 0; bar.st = nullptr;
    if (ONE_LAUNCH) bar = xcd_barrier_post(F.ctl + CW_BAR, F.MISC + 8);
    const int lo = args.ph_lo, hi = args.ph_hi;
    const __attribute__((address_space(4))) Args* KP = (const __attribute__((address_space(4))) Args*)__builtin_amdgcn_kernarg_segment_ptr();
#define INP(i) ((const float*)(__attribute__((address_space(1))) const float*)(unsigned long long)KP->in[i])
#define PHASE_ENTER() do { unsigned long long kpi_ = (unsigned long long)__builtin_amdgcn_kernarg_segment_ptr(); asm volatile("" : "+s"(kpi_)); KP = (const __attribute__((address_space(4))) Args*)kpi_; \
        unsigned long long wsi_ = (unsigned long long)KP->ws; asm volatile("" : "+s"(wsi_)); ws = (unsigned char*)(__attribute__((address_space(1))) unsigned char*)wsi_; int t_ = fresh_tid(wave0); asm volatile("" : "+v"(t_)); F.tid = t_; F.lane = t_ & 63; F.wave = wave0; } while (0)
#define IN(k) (lo <= (k) && (k) < hi)
#define SEAM(k) do { if (IN(k) && IN((k) + 1)) xcd_barrier(bar, fresh_tid(wave0) == 0); } while (0)

    if (IN(0)) { for (int rep = 0; rep < REP_PRO; ++rep) { PHASE_ENTER(); phase_prologue(F, KP, ws); }
        SEAM(0); }

#pragma unroll 1
    for (int l = 0; l < DEPTH; ++l) {
        const int pb = 1 + 7 * l;
        if (IN(pb)) for (int rep = 0; rep < REP_INP; ++rep) {
            PHASE_ENTER(); bf16* proj = (bf16*)(ws + WS_PROJ);
            {
                pg8::Gemm g8{(const pg8::bf16_t*)(ws + WS_XN8), (const pg8::bf16_t*)(ws + WS_WG8 + (size_t)l * WG8_LAYER), M, N8, DM / 2, P8 / 2};
                pg8::StaticOrder S8; S8.init(M, N8, F.G, (int)blockIdx.x);
                pg8::EpiProjT<true> E8{proj, LDP, INP(3) + (size_t)l * 4 * 2 * HD, (LAS float*)(F.lds + XTAB_OFF), QSCALE, (const float*)(ws + WS_SA), (const float*)(ws + WS_SB) + (size_t)l * N8};
                pg8::gemm_phase<pg8::EpiProjT<true>, pg8::StaticOrder, true, true, pg8::Gemm, true>(F.lds + RING_OFF, g8, S8, E8, F.wave);
            }
            pg8::GemmMap16 g{(const pg8::bf16_t*)(ws + WS_XN), (const pg8::bf16_t*)(ws + WS_WIN + (size_t)l * WIN_LAYER), DM, PK};
            pg8::StaticOrder S; S.init(M, pg8::NT16 * 256, F.G, (int)blockIdx.x);
            pg8::EpiProjT<false> E{proj, LDP, INP(3) + (size_t)l * 4 * 2 * HD, (LAS float*)(F.lds + XTAB_OFF), QSCALE, nullptr, nullptr};
            pg8::gemm_phase<pg8::EpiProjT<false>, pg8::StaticOrder, true, true, pg8::GemmMap16>(F.lds + RING_OFF, g, S, E, F.wave);
            if (rep == REP_INP - 1) SEAM(pb);
        }
        if (IN(pb + 2)) { for (int rep = 0; rep < REP_ATT; ++rep) { PHASE_ENTER(); phase_attention(F, ws, INP(4) + (size_t)l * 8 * 15 * 31, (char*)lds + RING_OFF); } SEAM(pb + 2); }
        if (IN(pb + 3)) for (int rep = 0; rep < REP_FIN; ++rep) {
            PHASE_ENTER();
            const float lam_init = 0.8f - 0.6f * expf(-0.3f * (float)l);
            phase_finalize(F, ws, INP(5) + (size_t)l * 4 * HD, INP(6) + (size_t)l * 2 * HD, lam_init); if (rep == REP_FIN - 1) SEAM(pb + 3);
        }
        if (IN(pb + 4)) for (int rep = 0; rep < REP_BRA; ++rep) {
            PHASE_ENTER(); bf16* proj = (bf16*)(ws + WS_PROJ);
            const int rot = (int)(blockIdx.x & 1);
            pg8::ChainGemm g{(const bf16*)(ws + WS_YA), (const bf16*)(ws + WS_WBR + (size_t)l * WBR_LAYER), Y_BLOCK / 2, WBR_BLOCK / 2, PY, 1024, rot};
            pg8::ChainOrder S; S.T.init(M, DM, F.G, (int)blockIdx.x);
            pg8::EpiChain E{proj + CG, LDP, (bf16*)(ws + WS_MG), PK, rot};
            pg8::gemm_phase<pg8::EpiChain, pg8::ChainOrder, true, true, pg8::ChainGemm>(F.lds + RING_OFF, g, S, E, F.wave);
            if (rep == REP_BRA - 1) SEAM(pb + 4);
        }
        if (IN(pb + 5)) {
            { PHASE_ENTER(); const int gw = F.vcu * NWAVES + F.wave, NGW = F.G * NWAVES;
              for (int m = gw; m < M; m += 2 * NGW) { const int m2 = min(m + NGW, M - 1); v4u wa[8], wb[8];
                  ld_row16((const bf16*)(ws + WS_MG) + (size_t)m * PK, wa, F.lane); ld_row16((const bf16*)(ws + WS_MG) + (size_t)m2 * PK, wb, F.lane);
                  q_row16(wa, (unsigned*)(ws + WS_MG8 + (size_t)m * P8), (float*)(ws + WS_SM) + m, F.lane);
                  if (m + NGW < M) q_row16(wb, (unsigned*)(ws + WS_MG8 + (size_t)m2 * P8), (float*)(ws + WS_SM) + m2, F.lane); } }
            xcd_barrier(bar, fresh_tid(wave0) == 0);
            for (int rep = 0; rep < REP_OUT; ++rep) {
            PHASE_ENTER();
            const float* xin = (l == 0) ? INP(0) : (const float*)(ws + WS_X1);
            float* xout = (l == DEPTH - 1) ? (float*)(__attribute__((address_space(1))) float*)(unsigned long long)KP->out : (float*)(ws + WS_X1);
            pg8::Gemm g{(const pg8::bf16_t*)(ws + WS_MG8), (const pg8::bf16_t*)(ws + WS_WO8 + (size_t)l * WO8_LAYER), M, DM, DM / 2, P8 / 2};
            pg8::StaticOrder S; S.init(M, DM, F.G, (int)blockIdx.x);
            pg8::EpiRes8 E{xin, xout, DM, (const float*)(ws + WS_SM), (const float*)(ws + WS_SO) + (size_t)l * DM};
            pg8::gemm_phase<pg8::EpiRes8, pg8::StaticOrder, true, true, pg8::Gemm, true>(F.lds + RING_OFF, g, S, E, F.wave);
            }
            SEAM(pb + 5);
        }
        if (l + 1 < DEPTH && IN(pb + 6)) for (int rep = 0; rep < REP_NRM; ++rep) {
            PHASE_ENTER();
            const int gw = F.vcu * NWAVES + F.wave, NGW = F.G * NWAVES;
            for (int m = gw; m < M; m += 2 * NGW) { const int m2 = min(m + NGW, M - 1); f32x4 va[16], vb[16];
                ld_xrow((const float*)(ws + WS_X1) + (size_t)m * DM, va, F.lane); ld_xrow((const float*)(ws + WS_X1) + (size_t)m2 * DM, vb, F.lane);
                rms_row_regs(va, INP(1) + (size_t)(l + 1) * DM, (bf16*)(ws + WS_XN) + (size_t)m * PK, (unsigned*)(ws + WS_XN8 + (size_t)m * P8), (float*)(ws + WS_SA) + m, F.lane);
                if (m + NGW < M) rms_row_regs(vb, INP(1) + (size_t)(l + 1) * DM, (bf16*)(ws + WS_XN) + (size_t)m2 * PK, (unsigned*)(ws + WS_XN8 + (size_t)m2 * P8), (float*)(ws + WS_SA) + m2, F.lane); }
            if (rep == REP_NRM - 1) SEAM(pb + 6);
        }
    }
#undef IN
#undef SEAM
#undef PHASE_ENTER
#undef INP
}

extern "C" void kernel_launch(void* const* d_in, const int* in_sizes, int n_in, void* d_out, int out_size, void* d_ws, size_t ws_size, hipStream_t stream) {
    static int grid = 0;
    if (grid == 0) {
        if (n_in != 12 || in_sizes[0] != M * DM || out_size != M * DM || ws_size < WS_END) { fprintf(stderr, "kernel_launch: shape/workspace mismatch (n_in %d, in0 %d, out %d, ws %zu, need %zu)\n", n_in, n_in > 0 ? in_sizes[0] : -1, out_size, ws_size, (size_t)WS_END); grid = -1; return; }
        int dev = 0, cus = 0, per_cu = 0;
        if (hipGetDevice(&dev) != hipSuccess || hipDeviceGetAttribute(&cus, hipDeviceAttributeMultiprocessorCount, dev) != hipSuccess) { grid = -1; return; }
        if (hipFuncSetAttribute((const void*)mega_fwd, hipFuncAttributeMaxDynamicSharedMemorySize, LDS_BYTES) != hipSuccess) { fprintf(stderr, "kernel_launch: hipFuncSetAttribute failed\n"); grid = -1; return; }
        if (hipOccupancyMaxActiveBlocksPerMultiprocessor(&per_cu, (const void*)mega_fwd, NWAVES * 64, LDS_BYTES) != hipSuccess || per_cu < 1)
            fprintf(stderr, "kernel_launch: note: occupancy query reports %d workgroups per CU\n", per_cu);
        (void)hipGetLastError();
        grid = cus;
    }
    if (grid < 0) return;
    if (hipMemsetAsync((char*)d_ws + WS_CTL, 0, CTL_ZERO_BYTES, stream) != hipSuccess) { fprintf(stderr, "kernel_launch: hipMemsetAsync failed\n"); return; }
    Args a{};
    for (int i = 0; i < 12; ++i) a.in[i] = (const float*)d_in[i];
    a.out = (float*)d_out; a.ws = (unsigned char*)d_ws;
    if (ONE_LAUNCH) {
        a.ph_lo = 0; a.ph_hi = NPH;
        hipLaunchKernelGGL(mega_fwd, dim3(grid), dim3(NWAVES * 64), LDS_BYTES, stream, a);
    } else {
        for (int p = 0; p < NPH; ++p) { a.ph_lo = p; a.ph_hi = p + 1; hipLaunchKernelGGL(mega_fwd, dim3(grid), dim3(NWAVES * 64), LDS_BYTES, stream, a); }
    }
    const hipError_t le = hipPeekAtLastError();
    if (le != hipSuccess) fprintf(stderr, "kernel_launch: launch failed: %s\n", hipGetErrorName(le));
}
```

```cpp
#include <hip/hip_runtime.h>
#include <cstdio>
#include <cstdint>
__device__ __forceinline__ int fresh_tid(int wave) { unsigned m = ~0u; asm volatile("" : "+s"(m)); return wave * 64 + (int)__builtin_amdgcn_mbcnt_hi(m, __builtin_amdgcn_mbcnt_lo(m, 0u)); }
namespace pg8 {
#define PG8_LAS __attribute__((address_space(3)))
typedef unsigned short bf16_t;
typedef short bf16x8 __attribute__((ext_vector_type(8)));
typedef float f32x4 __attribute__((ext_vector_type(4)));
typedef unsigned u32x4 __attribute__((ext_vector_type(4)));
constexpr int BM = 256, BK = 64, HALF = 128, HTB = HALF * BK * 2  , STAGE_BYTES = 8 * HTB, NXCD = 8, WGM = 8;

__host__ __device__ __forceinline__ int lds_byte(int r, int c) { const int st = (r >> 4) * 2 + (c >> 5), rr = r & 15, cc = c & 31, ob = rr * 64 + cc * 2; return st * 1024 + (ob ^ (((ob >> 9) & 1) << 5)); }
__host__ __device__ __forceinline__ void stage_rc(int b, int& R, int& C) { const int st = b / 1024, sb = b % 1024, swz = sb ^ (((sb >> 9) & 1) << 5); R = (st >> 1) * 16 + swz / 64; C = (st & 1) * 32 + (swz % 64) / 2; }
__host__ __device__ __forceinline__ int perm32(int rho) { const int n = rho >> 4, i = rho & 15; return 8 * (i >> 2) + 4 * n + (i & 3); }

struct Unit { int pm, pn, seg; };
struct Gemm { const bf16_t* A; const bf16_t* Bt; int M, N, K, P;
    __device__ __forceinline__ int pitch() const { return P; }
    __device__ __forceinline__ int ntiles(const Unit&) const { return K / BK; }
    __device__ __forceinline__ const char* a_base(const Unit& u, size_t tstep) const { return (const char*)A + (size_t)u.pm * tstep; }
    __device__ __forceinline__ const char* b_base(const Unit& u, size_t tstep) const { return (const char*)Bt + (size_t)u.pn * tstep; }
};
__host__ __device__ __forceinline__ int map16(int j) { return j + 26; }
__host__ __device__ __forceinline__ int map8(int j) { return j < 26 ? j : j + 16; }
constexpr int NT16 = 16, NT8 = 110;
struct GemmMap16 { const bf16_t* A; const bf16_t* Bt; int K, P;
    __device__ __forceinline__ int pitch() const { return P; }
    __device__ __forceinline__ int ntiles(const Unit&) const { return K / BK; }
    __device__ __forceinline__ const char* a_base(const Unit& u, size_t tstep) const { return (const char*)A + (size_t)u.pm * tstep; }
    __device__ __forceinline__ const char* b_base(const Unit& u, size_t tstep) const { return (const char*)Bt + (size_t)map16(u.pn) * tstep; }
};
struct ChainGemm { const bf16_t* A0; const bf16_t* B0; size_t a_stride, b_stride; int P, K, rot;
    __device__ __forceinline__ int branch(const Unit& u) const { return (u.seg + 3 * rot) & 3; }
    __device__ __forceinline__ int pitch() const { return P; }
    __device__ __forceinline__ int ntiles(const Unit& u) const { return (branch(u) == 3) ? (K / BK) / 2 : K / BK; }
    __device__ __forceinline__ const char* a_base(const Unit& u, size_t tstep) const { return (const char*)(A0 + (size_t)branch(u) * a_stride) + (size_t)u.pm * tstep; }
    __device__ __forceinline__ const char* b_base(const Unit& u, size_t tstep) const { return (const char*)(B0 + (size_t)branch(u) * b_stride) + (size_t)u.pn * tstep; }
};

struct StaticOrder {
    int nM, nN, nwg, G, c;
    __host__ __device__ void init(int M, int N, int G_, int c_) { nM = M / BM; nN = N / BM; nwg = nM * nN; G = G_; c = c_; }
    __host__ __device__ bool next(int i, Unit& u) const {
        const long L = (long)i * G + c; if (L >= nwg) return false;
        int wgid = (int)L; { const int q = nwg / NXCD, r = nwg % NXCD, xcd = wgid % NXCD, off = wgid / NXCD; wgid = (xcd < r ? xcd * (q + 1) : r * (q + 1) + (xcd - r) * q) + off; }
        const int nig = WGM * nN, gid = wgid / nig, fm = gid * WGM, gsz = (nM - fm) < WGM ? (nM - fm) : WGM;
        u.pm = fm + ((wgid % nig) % gsz); u.pn = (wgid % nig) / gsz; u.seg = 0; return true;
    }
    __device__ __forceinline__ void a_ready(const Unit&) const {}
    __device__ __forceinline__ void done(const Unit&) const {}
};
struct ChainOrder { StaticOrder T;
    __device__ __forceinline__ bool next(int i, Unit& u) const { if (!T.next(i >> 2, u)) return false; u.seg = i & 3; return true; }
    __device__ __forceinline__ void a_ready(const Unit&) const {}
    __device__ __forceinline__ void done(const Unit&) const {}
};

__device__ __forceinline__ unsigned cvt_pk_bf16(float lo, float hi) { unsigned r; asm volatile("v_cvt_pk_bf16_f32 %0, %1, %2" : "=v"(r) : "v"(lo), "v"(hi)); return r; }
typedef float f32x2 __attribute__((ext_vector_type(2)));
typedef int i32x4 __attribute__((ext_vector_type(4)));
template <bool I8> struct AccT { typedef f32x4 type; };
template <> struct AccT<true> { typedef i32x4 type; };
template <bool I8> __device__ __forceinline__ typename AccT<I8>::type mma1(bf16x8 b, bf16x8 a, typename AccT<I8>::type c) {
    if constexpr (I8) return __builtin_amdgcn_mfma_i32_16x16x64_i8(__builtin_bit_cast(i32x4, b), __builtin_bit_cast(i32x4, a), c, 0, 0, 0);
    else return __builtin_amdgcn_mfma_f32_16x16x32_bf16(b, a, c, 0, 0, 0);
}
__device__ __forceinline__ float sigmoid_fast(float v) { return __builtin_amdgcn_rcpf(1.0f + __builtin_amdgcn_exp2f(-1.4426950408889634f * v)); }
__device__ __forceinline__ float bf_lo(unsigned w) { return __builtin_bit_cast(float, w << 16); }
__device__ __forceinline__ float bf_hi(unsigned w) { return __builtin_bit_cast(float, w & 0xffff0000u); }
template <bool I8> struct EpiProjT {
    static constexpr bool PERM = true, AFTER_DRAIN = false;
    bf16_t* O; int ldc; const float* qk_gain  ; PG8_LAS float* xtab  ; float qscale; const float* sa; const float* sb;
    __device__ __forceinline__ bool resets(const Unit&) const { return true; }
    __device__ __forceinline__ void operator()(const typename AccT<I8>::type (&acc)[2][2][4][2], const Unit& u, int wr, int wc, int fr, int fq) const {
        const int pn = I8 ? map8(u.pn) : map16(u.pn);
        int kind, br = 0, isk = 0;
        if (pn >= 62) kind = 2;
        else if ((pn >= 12 && pn < 16) || (pn >= 22 && pn < 26) || (pn >= 38 && pn < 42) || pn >= 60) kind = 1;
        else if (pn < 8) { kind = 3; br = 0; isk = pn >= 4; }
        else if (pn >= 16 && pn < 21) { kind = 3; br = 1; isk = pn >= 20; }
        else if (pn >= 26 && pn < 34) { kind = 3; br = 2; isk = pn >= 30; }
        else if (pn >= 42 && pn < 54) { kind = 3; br = 3; isk = pn >= 48; }
        else kind = 0;
        const int row0 = u.pm * BM + wr * 64 + fr, cc0 = wc * 32 + 8 * fq, col0 = pn * BM + cc0;
        f32x4 sbv[2][2];
        if (I8) {
#pragma unroll
            for (int bj = 0; bj < 2; ++bj)
#pragma unroll
                for (int n = 0; n < 2; ++n) sbv[bj][n] = *(const f32x4*)(sb + u.pn * BM + cc0 + bj * HALF + 4 * n);
        }
        float sarr[2][4];
#pragma unroll
        for (int ai = 0; ai < 2; ++ai)
#pragma unroll
            for (int m = 0; m < 4; ++m) sarr[ai][m] = I8 ? sa[row0 + ai * HALF + m * 16] : 1.0f;
        if (I8) asm volatile("" ::: "memory");
#define EPV(ai, bj, m, n, sar) (I8 ? (f32x4){(float)acc[ai][bj][m][n][0], (float)acc[ai][bj][m][n][1], (float)acc[ai][bj][m][n][2], (float)acc[ai][bj][m][n][3]} * (sar) * sbv[bj][n] \
                                   : (f32x4){(float)acc[ai][bj][m][n][0], (float)acc[ai][bj][m][n][1], (float)acc[ai][bj][m][n][2], (float)acc[ai][bj][m][n][3]})
        if (kind != 3) {
#pragma unroll
            for (int ai = 0; ai < 2; ++ai)
#pragma unroll
                for (int m = 0; m < 4; ++m) { const int row = row0 + ai * HALF + m * 16; bf16_t* rowp = O + (size_t)row * ldc + col0; const float sar = sarr[ai][m];
#pragma unroll
                    for (int bj = 0; bj < 2; ++bj) { f32x4 v0 = EPV(ai, bj, m, 0, sar), v1 = EPV(ai, bj, m, 1, sar);
                        if (kind == 1) {
#pragma unroll
                            for (int e = 0; e < 4; ++e) { v0[e] *= sigmoid_fast(v0[e]); v1[e] *= sigmoid_fast(v1[e]); }
                        } else if (kind == 2) {
#pragma unroll
                            for (int e = 0; e < 4; ++e) { v0[e] = fminf(__builtin_amdgcn_exp2f(-1.4426950408889634f * v0[e]), 1e18f); v1[e] = fminf(__builtin_amdgcn_exp2f(-1.4426950408889634f * v1[e]), 1e18f); }
                        }
                        u32x4 w; w.x = cvt_pk_bf16(v0[0], v0[1]); w.y = cvt_pk_bf16(v0[2], v0[3]); w.z = cvt_pk_bf16(v1[0], v1[1]); w.w = cvt_pk_bf16(v1[2], v1[3]);
                        *(u32x4*)(rowp + bj * HALF) = w; } }
            return;
        }
#pragma unroll
        for (int ai = 0; ai < 2; ++ai)
#pragma unroll
            for (int m = 0; m < 4; ++m) { const float sar = sarr[ai][m];
#pragma unroll
                for (int bj = 0; bj < 2; ++bj) { const f32x4 a = EPV(ai, bj, m, 0, sar), b = EPV(ai, bj, m, 1, sar);
                    float s = (a[0] * a[0] + a[1] * a[1]) + (a[2] * a[2] + a[3] * a[3]) + (b[0] * b[0] + b[1] * b[1]) + (b[2] * b[2] + b[3] * b[3]);
                    s += __builtin_bit_cast(float, __builtin_amdgcn_ds_bpermute(((fq * 16 + fr) ^ 16) << 2, __builtin_bit_cast(int, s)));
                    s += __builtin_bit_cast(float, __builtin_amdgcn_ds_bpermute(((fq * 16 + fr) ^ 32) << 2, __builtin_bit_cast(int, s)));
                    if (fq == 0) xtab[((ai * HALF + wr * 64 + m * 16 + fr) * 2 + bj) * 4 + wc] = s; } }
        asm volatile("s_waitcnt lgkmcnt(0)" ::: "memory"); __builtin_amdgcn_s_barrier(); asm volatile("" ::: "memory");
        const float* gp = qk_gain + (br * 2 + isk) * 128 + cc0;
        const f32x4 ga = *(const f32x4*)gp, gb = *(const f32x4*)(gp + 4);
        const float sc = isk ? 1.0f : qscale;
        float invf[4];
#pragma unroll
        for (int i = 0; i < 4; ++i) invf[i] = __builtin_amdgcn_exp2f(-(float)(((cc0 >> 1) + i) & 31) * (13.287712379549449f / 32.f));
#pragma unroll
        for (int ai = 0; ai < 2; ++ai)
#pragma unroll
            for (int m = 0; m < 4; ++m) { const int rl = ai * HALF + wr * 64 + m * 16 + fr; const int row = u.pm * BM + rl;
                bf16_t* rowp = O + (size_t)row * ldc + col0; const float sar = sarr[ai][m];
                const int spos = row & 4095; const float fpos = (wc < 2) ? (float)(spos >> 6) : (float)(spos & 63);
#pragma unroll
                for (int bj = 0; bj < 2; ++bj) { const f32x4 t = *(const PG8_LAS f32x4*)(xtab + (rl * 2 + bj) * 4);
                    const float rstd = sc / sqrtf(((t[0] + t[1]) + (t[2] + t[3])) * (1.0f / 128.0f) + 1e-6f);
                    f32x4 v0 = EPV(ai, bj, m, 0, sar) * rstd * ga, v1 = EPV(ai, bj, m, 1, sar) * rstd * gb;
                    if (br == 1) {
                        float x[8] = {v0[0], v0[1], v0[2], v0[3], v1[0], v1[1], v1[2], v1[3]};
#pragma unroll
                        for (int i = 0; i < 4; ++i) { const float rev = __builtin_amdgcn_fractf(fpos * invf[i] * 0.15915494309189535f);
                            const float sn = __builtin_amdgcn_sinf(rev), cs = __builtin_amdgcn_cosf(rev);
                            const float x1 = x[2 * i], x2 = x[2 * i + 1]; x[2 * i] = x1 * cs - x2 * sn; x[2 * i + 1] = x1 * sn + x2 * cs; }
                        v0 = (f32x4){x[0], x[1], x[2], x[3]}; v1 = (f32x4){x[4], x[5], x[6], x[7]};
                    }
                    u32x4 w; w.x = cvt_pk_bf16(v0[0], v0[1]); w.y = cvt_pk_bf16(v0[2], v0[3]); w.z = cvt_pk_bf16(v1[0], v1[1]); w.w = cvt_pk_bf16(v1[2], v1[3]);
                    *(u32x4*)(rowp + bj * HALF) = w; } }
#undef EPV
    }
};
struct EpiChain {
    static constexpr bool PERM = true, AFTER_DRAIN = false;
    const bf16_t* G; int ldg; bf16_t* Mg; int ldm; int rot;
    __device__ __forceinline__ bool resets(const Unit& u) const { return u.seg == 3; }
    __device__ __forceinline__ void operator()(f32x4 (&acc)[2][2][4][2], const Unit& u, int wr, int wc, int fr, int fq) const {
        const int row0 = u.pm * BM + wr * 64 + fr, col0 = u.pn * BM + wc * 32 + 8 * fq, seg = u.seg;
        const int bcur = (seg + 3 * rot) & 3, bnxt = (seg + 1 + 3 * rot) & 3;
        const bf16_t* Gs = G + (size_t)bcur * 4096;
        const bool lastseg = seg == 3;
        const int nxo = lastseg ? 0 : (bnxt - bcur) * 4096;
#pragma unroll
        for (int ai = 0; ai < 2; ++ai) {
            u32x4 gw[4][2], nw[4][2];
#pragma unroll
            for (int m = 0; m < 4; ++m) { const size_t row = (size_t)(row0 + ai * HALF + m * 16);
#pragma unroll
                for (int bj = 0; bj < 2; ++bj) { gw[m][bj] = *(const u32x4*)(Gs + row * ldg + col0 + bj * HALF); nw[m][bj] = *(const u32x4*)(Gs + nxo + row * ldg + col0 + bj * HALF); } }
            asm volatile("" ::: "memory");
#pragma unroll
            for (int m = 0; m < 4; ++m) { const size_t row = (size_t)(row0 + ai * HALF + m * 16);
#pragma unroll
                for (int bj = 0; bj < 2; ++bj) { const u32x4 g = gw[m][bj], q = nw[m][bj];
                    float f[8] = {bf_lo(g.x), bf_hi(g.x), bf_lo(g.y), bf_hi(g.y), bf_lo(g.z), bf_hi(g.z), bf_lo(g.w), bf_hi(g.w)};
                    const float d[8] = {bf_lo(q.x), bf_hi(q.x), bf_lo(q.y), bf_hi(q.y), bf_lo(q.z), bf_hi(q.z), bf_lo(q.w), bf_hi(q.w)};
#pragma unroll
                    for (int e = 0; e < 8; ++e) { const float r = __builtin_amdgcn_rcpf(1.0f + f[e]); f[e] = lastseg ? r : (1.0f + d[e]) * r; }
                    f32x4 v0 = acc[ai][bj][m][0], v1 = acc[ai][bj][m][1];
                    v0[0] *= f[0]; v0[1] *= f[1]; v0[2] *= f[2]; v0[3] *= f[3]; v1[0] *= f[4]; v1[1] *= f[5]; v1[2] *= f[6]; v1[3] *= f[7];
                    acc[ai][bj][m][0] = v0; acc[ai][bj][m][1] = v1;
                    if (lastseg) { u32x4 w; w.x = cvt_pk_bf16(v0[0], v0[1]); w.y = cvt_pk_bf16(v0[2], v0[3]); w.z = cvt_pk_bf16(v1[0], v1[1]); w.w = cvt_pk_bf16(v1[2], v1[3]);
                        *(u32x4*)(Mg + row * ldm + col0 + bj * HALF) = w; } } }
            asm volatile("" ::: "memory");
        }
    }
};
struct EpiRes {
    static constexpr bool PERM = false, AFTER_DRAIN = false;
    const float* base; float* out; int ldc;
    __device__ __forceinline__ bool resets(const Unit&) const { return true; }
    __device__ __forceinline__ void operator()(const f32x4 (&acc)[2][2][4][2], const Unit& u, int wr, int wc, int fr, int fq) const {
        const int col0 = u.pn * BM + wc * 32 + 4 * fq;
#pragma unroll
        for (int ai = 0; ai < 2; ++ai) {
            f32x4 pre[4][2][2];
#pragma unroll
            for (int m = 0; m < 4; ++m) { const size_t off = (size_t)(u.pm * BM + ai * HALF + wr * 64 + m * 16 + fr) * ldc + col0;
#pragma unroll
                for (int bj = 0; bj < 2; ++bj)
#pragma unroll
                    for (int n = 0; n < 2; ++n) pre[m][bj][n] = *(const f32x4*)(base + off + bj * HALF + n * 16); }
            asm volatile("" ::: "memory");
#pragma unroll
            for (int m = 0; m < 4; ++m) { const size_t off = (size_t)(u.pm * BM + ai * HALF + wr * 64 + m * 16 + fr) * ldc + col0;
#pragma unroll
                for (int bj = 0; bj < 2; ++bj)
#pragma unroll
                    for (int n = 0; n < 2; ++n) *(f32x4*)(out + off + bj * HALF + n * 16) = pre[m][bj][n] + acc[ai][bj][m][n]; }
            asm volatile("" ::: "memory");
        }
    }
};
struct EpiRes8 {
    static constexpr bool PERM = false, AFTER_DRAIN = false;
    const float* base; float* out; int ldc; const float* sm; const float* so;
    __device__ __forceinline__ bool resets(const Unit&) const { return true; }
    __device__ __forceinline__ void operator()(const i32x4 (&acc)[2][2][4][2], const Unit& u, int wr, int wc, int fr, int fq) const {
        const int col0 = u.pn * BM + wc * 32 + 4 * fq;
        f32x4 sov[2][2];
#pragma unroll
        for (int bj = 0; bj < 2; ++bj)
#pragma unroll
            for (int n = 0; n < 2; ++n) sov[bj][n] = *(const f32x4*)(so + col0 + bj * HALF + n * 16);
#pragma unroll
        for (int ai = 0; ai < 2; ++ai) {
            f32x4 pre[4][2][2]; float smr[4];
#pragma unroll
            for (int m = 0; m < 4; ++m) { const int row = u.pm * BM + ai * HALF + wr * 64 + m * 16 + fr; const size_t off = (size_t)row * ldc + col0; smr[m] = sm[row];
#pragma unroll
                for (int bj = 0; bj < 2; ++bj)
#pragma unroll
                    for (int n = 0; n < 2; ++n) pre[m][bj][n] = *(const f32x4*)(base + off + bj * HALF + n * 16); }
            asm volatile("" ::: "memory");
#pragma unroll
            for (int m = 0; m < 4; ++m) { const size_t off = (size_t)(u.pm * BM + ai * HALF + wr * 64 + m * 16 + fr) * ldc + col0;
#pragma unroll
                for (int bj = 0; bj < 2; ++bj)
#pragma unroll
                    for (int n = 0; n < 2; ++n) { const i32x4 a = acc[ai][bj][m][n]; f32x4 v; v[0] = (float)a[0]; v[1] = (float)a[1]; v[2] = (float)a[2]; v[3] = (float)a[3];
                        *(f32x4*)(out + off + bj * HALF + n * 16) = pre[m][bj][n] + v * smr[m] * sov[bj][n]; } }
            asm volatile("" ::: "memory");
        }
    }
};

template <class Epi, class Sched, bool ALIGN_EPI = false, bool SP2 = false, class GemmT = Gemm, bool I8 = false>
__device__ __forceinline__ void gemm_phase(PG8_LAS unsigned char* lds, const GemmT g, const Sched& S, const Epi& E, const int wave_in) {
    int tid_ = fresh_tid(wave_in); asm volatile("" : "+v"(tid_));
    const int tid = tid_, wid = __builtin_amdgcn_readfirstlane(tid >> 6), lane = tid & 63, wr = wid >> 2, wc = wid & 3, fr = lane & 15, fq = lane >> 4;
    const int K = g.pitch();
    unsigned voffA[2], voffB[2];
#pragma unroll
    for (int i = 0; i < 2; ++i) { int R, C; stage_rc(tid * 16 + i * 8192, R, C); const int Rb = Epi::PERM ? ((R & ~31) + perm32(R & 31)) : R;
        voffA[i] = (unsigned)(R * K + C) * 2u; voffB[i] = (unsigned)(Rb * K + C) * 2u; }
    const size_t kstep = (size_t)(BK * 2);
    const size_t hstep = (size_t)HALF * K * 2;
    const size_t tstep = 2 * hstep;
    const unsigned ldsw = (unsigned)wid * 1024u;
    const int aoff = lds_byte(wr * 64 + fr, fq * 8), boff = lds_byte(wc * 32 + fr, fq * 8);
#define PG8_SA(b, h) (((b) * 2 + (h)) * HTB)
#define PG8_SB(b, h) ((4 + (b) * 2 + (h)) * HTB)
#define PG8_STAGE(bufoff, gbase, voff) do { _Pragma("unroll") for (int _i = 0; _i < 2; ++_i) \
        __builtin_amdgcn_global_load_lds((const unsigned*)((const char*)(gbase) + (voff)[_i]), (PG8_LAS unsigned*)(lds + (bufoff) + ldsw + _i * 8192), 16, 0, 0); } while (0)
#define PG8_LDA(dst, b, h) do { _Pragma("unroll") for (int m = 0; m < 4; ++m) _Pragma("unroll") for (int k = 0; k < 2; ++k) dst[m][k] = *(const PG8_LAS bf16x8*)(lds + PG8_SA(b, h) + aoff + m * 2048 + k * 1024); } while (0)
#define PG8_LDB(dst, b, h) do { _Pragma("unroll") for (int n = 0; n < 2; ++n) _Pragma("unroll") for (int k = 0; k < 2; ++k) dst[n][k] = *(const PG8_LAS bf16x8*)(lds + PG8_SB(b, h) + boff + n * 2048 + k * 1024); } while (0)
#define PG8_MMA(ai, bj, At, Bt) do { __builtin_amdgcn_s_setprio(1); _Pragma("unroll") for (int m = 0; m < 4; ++m) _Pragma("unroll") for (int n = 0; n < 2; ++n) _Pragma("unroll") for (int k = 0; k < 2; ++k) \
        acc[ai][bj][m][n] = mma1<I8>(Bt[n][k], At[m][k], acc[ai][bj][m][n]); __builtin_amdgcn_s_setprio(0); } while (0)
#define PG8_WAIT_V(n) asm volatile("s_waitcnt vmcnt(" #n ")" ::: "memory")
#define PG8_WAIT_L(n) asm volatile("s_waitcnt lgkmcnt(" #n ")" ::: "memory")
#define PG8_BAR __builtin_amdgcn_s_barrier()
#define PG8_SCHED __builtin_amdgcn_sched_barrier(0)
    Unit cur, nxt; int ui = 0;
    if (!S.next(0, cur)) return;
    int nt = g.ntiles(cur);
    typedef typename AccT<I8>::type acc_t;
    acc_t acc[2][2][4][2];
#pragma unroll
    for (int a = 0; a < 2; ++a)
#pragma unroll
        for (int b = 0; b < 2; ++b)
#pragma unroll
            for (int m = 0; m < 4; ++m)
#pragma unroll
                for (int n = 0; n < 2; ++n) acc[a][b][m][n] = acc_t{};
    bf16x8 At[4][2], B0[2][2], B1[2][2];
    const char* cA = g.a_base(cur, tstep); const char* cB = g.b_base(cur, tstep);
    S.a_ready(cur);
    if constexpr (SP2) {
        PG8_STAGE(PG8_SB(0, 0), cB, voffB); PG8_STAGE(PG8_SB(0, 1), cB + hstep, voffB); PG8_STAGE(PG8_SA(0, 0), cA, voffA); PG8_STAGE(PG8_SA(0, 1), cA + hstep, voffA);
        if (wr == 1) PG8_BAR;
        PG8_WAIT_V(2); PG8_BAR;
        PG8_STAGE(PG8_SB(1, 0), cB + kstep, voffB); PG8_STAGE(PG8_SA(1, 0), cA + kstep, voffA); PG8_STAGE(PG8_SB(1, 1), cB + hstep + kstep, voffB);
        PG8_WAIT_V(6); PG8_BAR;
    } else {
        PG8_STAGE(PG8_SB(0, 0), cB, voffB); PG8_STAGE(PG8_SA(0, 0), cA, voffA); PG8_STAGE(PG8_SB(0, 1), cB + hstep, voffB); PG8_STAGE(PG8_SA(0, 1), cA + hstep, voffA);
        if (wr == 1) PG8_BAR;
        PG8_WAIT_V(4); PG8_BAR;
        PG8_STAGE(PG8_SB(1, 0), cB + kstep, voffB); PG8_STAGE(PG8_SA(1, 0), cA + kstep, voffA); PG8_STAGE(PG8_SB(1, 1), cB + hstep + kstep, voffB);
        PG8_WAIT_V(6); PG8_BAR;
    }
    for (;;) {
        const bool has_next = S.next(ui + 1, nxt);
        const char* nA = has_next ? g.a_base(nxt, tstep) : cA; const char* nB = has_next ? g.b_base(nxt, tstep) : cB;
        for (int t = 0; t < nt; t += 2) {
            const bool last = (t == nt - 2);
            const char* a1 = cA + (size_t)(t + 1) * kstep;
            const char* a2 = last ? nA : cA + (size_t)(t + 2) * kstep; const char* b2 = last ? nB : cB + (size_t)(t + 2) * kstep;
            const char* a3 = a2 + kstep; const char* b3 = b2 + kstep;
            if (last && has_next) S.a_ready(nxt);
            if constexpr (SP2) {
            PG8_LDB(B0, 0, 0); PG8_LDB(B1, 0, 1); PG8_SCHED; PG8_LDA(At, 0, 0); PG8_STAGE(PG8_SA(1, 1), a1 + hstep, voffA);
            PG8_WAIT_V(8); PG8_WAIT_L(0); PG8_BAR; PG8_MMA(0, 0, At, B0); PG8_MMA(0, 1, At, B1); PG8_BAR; PG8_SCHED;
            PG8_LDA(At, 0, 1); PG8_STAGE(PG8_SB(0, 0), b2, voffB); PG8_STAGE(PG8_SB(0, 1), b2 + hstep, voffB); PG8_STAGE(PG8_SA(0, 0), a2, voffA);
            PG8_WAIT_V(8); PG8_WAIT_L(0); PG8_BAR; PG8_MMA(1, 0, At, B0); PG8_MMA(1, 1, At, B1); PG8_BAR; PG8_SCHED;
            PG8_LDB(B0, 1, 0); PG8_LDB(B1, 1, 1); PG8_SCHED; PG8_LDA(At, 1, 0); PG8_STAGE(PG8_SA(0, 1), a2 + hstep, voffA);
            PG8_WAIT_V(8); PG8_WAIT_L(0); PG8_BAR; PG8_MMA(0, 0, At, B0); PG8_MMA(0, 1, At, B1); PG8_BAR; PG8_SCHED;
            PG8_LDA(At, 1, 1); PG8_STAGE(PG8_SB(1, 0), b3, voffB); PG8_STAGE(PG8_SB(1, 1), b3 + hstep, voffB); PG8_STAGE(PG8_SA(1, 0), a3, voffA);
            PG8_WAIT_V(8); PG8_WAIT_L(0); PG8_BAR; PG8_MMA(1, 0, At, B0); PG8_MMA(1, 1, At, B1); PG8_BAR; PG8_SCHED;
            } else {
            PG8_LDB(B0, 0, 0); PG8_SCHED; PG8_LDA(At, 0, 0); PG8_STAGE(PG8_SA(1, 1), a1 + hstep, voffA);
            PG8_WAIT_L(8); PG8_BAR; PG8_WAIT_L(0); PG8_MMA(0, 0, At, B0); PG8_BAR; PG8_SCHED;
            PG8_LDB(B1, 0, 1); PG8_STAGE(PG8_SB(0, 0), b2, voffB);
            PG8_BAR; PG8_WAIT_L(0); PG8_MMA(0, 1, At, B1); PG8_BAR;
            PG8_LDA(At, 0, 1); PG8_STAGE(PG8_SA(0, 0), a2, voffA);
            PG8_BAR; PG8_WAIT_L(0); PG8_MMA(1, 0, At, B0); PG8_BAR; PG8_SCHED;
            PG8_STAGE(PG8_SB(0, 1), b2 + hstep, voffB);
            PG8_WAIT_V(6); PG8_BAR; PG8_MMA(1, 1, At, B1); PG8_BAR;
            PG8_LDB(B0, 1, 0); PG8_SCHED; PG8_LDA(At, 1, 0); PG8_STAGE(PG8_SA(0, 1), a2 + hstep, voffA);
            PG8_WAIT_L(8); PG8_BAR; PG8_WAIT_L(0); PG8_MMA(0, 0, At, B0); PG8_BAR; PG8_SCHED;
            PG8_LDB(B1, 1, 1); PG8_STAGE(PG8_SB(1, 0), b3, voffB);
            PG8_BAR; PG8_WAIT_L(0); PG8_MMA(0, 1, At, B1); PG8_BAR;
            PG8_LDA(At, 1, 1); PG8_STAGE(PG8_SA(1, 0), a3, voffA);
            PG8_BAR; PG8_WAIT_L(0); PG8_MMA(1, 0, At, B0); PG8_BAR; PG8_SCHED;
            PG8_STAGE(PG8_SB(1, 1), b3 + hstep, voffB);
            PG8_WAIT_V(6); PG8_BAR; PG8_MMA(1, 1, At, B1); PG8_BAR;
            }
        }
        if constexpr (ALIGN_EPI) { if (wr == 0) PG8_BAR; }
        if constexpr (!Epi::AFTER_DRAIN) { E(acc, cur, wr, wc, fr, fq); S.done(cur); }
        if (!has_next) break;
        if (E.resets(cur)) {
#pragma unroll
        for (int a = 0; a < 2; ++a)
#pragma unroll
            for (int b = 0; b < 2; ++b)
#pragma unroll
                for (int m = 0; m < 4; ++m)
#pragma unroll
                    for (int n = 0; n < 2; ++n) acc[a][b][m][n] = acc_t{};
        }
        cur = nxt; cA = nA; cB = nB; ++ui; nt = g.ntiles(cur);
        if constexpr (ALIGN_EPI) { if (wr == 1) PG8_BAR; }
    }
    PG8_WAIT_V(0);
    if constexpr (!ALIGN_EPI) { if (wr == 0) PG8_BAR; }
    PG8_BAR;
    if constexpr (Epi::AFTER_DRAIN) { E.fused(acc, cur, wr, wc, fr, fq, lds, wid, lane); S.done(cur); }
#undef PG8_SA
#undef PG8_SB
#undef PG8_STAGE
#undef PG8_LDA
#undef PG8_LDB
#undef PG8_MMA
#undef PG8_WAIT_V
#undef PG8_WAIT_L
#undef PG8_BAR
#undef PG8_SCHED
}
}
namespace att {
typedef unsigned short bf16;
using bf16x8 = __attribute__((ext_vector_type(8))) short;
using s16x4  = __attribute__((ext_vector_type(4))) short;
using f32x16 = __attribute__((ext_vector_type(16))) float;
using u32x4  = __attribute__((ext_vector_type(4))) unsigned;
constexpr int D = 128, NW = 8, QBLK = 32, KVBLK = 64;
constexpr int SHM_V = KVBLK * D * 2, SHM_K = KVBLK * D * 2;
constexpr int OFF_WS = 2 * SHM_V + 2 * SHM_K, OFF_TBL = OFF_WS + NW * 64 * 4, SHM_ATTN = OFF_TBL + 4096;
constexpr float THR2 = 8.f;
constexpr float LOG2E = 1.4426950408889634f;
enum { M_NA = 0, M_DENSE = 1, M_ALIBI = 2, M_DIL = 3 };
#define KSWZ(row, colB) ((row) * 256 + ((colB) ^ (((row) & 7) << 4)))
#define SBAR() __builtin_amdgcn_sched_barrier(0)
__device__ __forceinline__ int crow(int r, int hi) { return (r & 3) + 8 * (r >> 2) + 4 * hi; }
__device__ __forceinline__ unsigned cvtpk(float lo, float hi) { unsigned r; asm volatile("v_cvt_pk_bf16_f32 %0, %1, %2" : "=v"(r) : "v"(lo), "v"(hi)); return r; }
__device__ __forceinline__ unsigned short f2bf1(float f) { unsigned u = __builtin_bit_cast(unsigned, f); return (unsigned short)((u + 0x7fffu + ((u >> 16) & 1u)) >> 16); }
__device__ __forceinline__ float bf2f(unsigned short h) { return __builtin_bit_cast(float, (unsigned)h << 16); }

__device__ __forceinline__ void partialSM(f32x16& p0, f32x16& p1, float& m_reg, float& mn, float& alpha) {
  float pmax = p0[0];
#pragma unroll
  for (int r = 1; r < 16; ++r) pmax = fmaxf(pmax, p0[r]);
#pragma unroll
  for (int r = 0; r < 16; ++r) pmax = fmaxf(pmax, p1[r]);
  { auto rr = __builtin_amdgcn_permlane32_swap(__float_as_uint(pmax), __float_as_uint(pmax), false, false);
    pmax = fmaxf(__uint_as_float(rr[0]), __uint_as_float(rr[1])); }
  if (__builtin_expect(__all(pmax - m_reg <= THR2), 1)) { mn = m_reg; alpha = 1.f; }
  else { mn = fmaxf(m_reg, pmax); alpha = __builtin_amdgcn_exp2f(m_reg - mn); m_reg = mn; }
#pragma unroll
  for (int r = 0; r < 16; ++r) p0[r] = p0[r] - mn;
#pragma unroll
  for (int r = 0; r < 16; ++r) p1[r] = p1[r] - mn;
#pragma unroll
  for (int r = 0; r < 16; ++r) p0[r] = __builtin_amdgcn_exp2f(p0[r]);
}
__device__ __forceinline__ void finishSM(f32x16& p0, f32x16& p1, float alpha, float& l_reg, bf16x8& pa0, bf16x8& pa1, bf16x8& pa2, bf16x8& pa3) {
#pragma unroll
  for (int r = 0; r < 16; ++r) p1[r] = __builtin_amdgcn_exp2f(p1[r]);
  float ps = 0;
#pragma unroll
  for (int r = 0; r < 16; ++r) ps += p0[r];
#pragma unroll
  for (int r = 0; r < 16; ++r) ps += p1[r];
  { auto rr = __builtin_amdgcn_permlane32_swap(__float_as_uint(ps), __float_as_uint(ps), false, false);
    ps = __uint_as_float(rr[0]) + __uint_as_float(rr[1]); }
  l_reg = l_reg * alpha + ps;
#define PK4(P, BASE, OUT) do { unsigned a0 = cvtpk(P[BASE + 0], P[BASE + 1]), a1 = cvtpk(P[BASE + 2], P[BASE + 3]);   \
    unsigned b0 = cvtpk(P[BASE + 4], P[BASE + 5]), b1 = cvtpk(P[BASE + 6], P[BASE + 7]);                              \
    auto r0 = __builtin_amdgcn_permlane32_swap(a0, b0, false, false); auto r1 = __builtin_amdgcn_permlane32_swap(a1, b1, false, false); \
    u32x4 w = {r0[0], r1[0], r0[1], r1[1]}; OUT = *reinterpret_cast<bf16x8*>(&w); } while (0)
  PK4(p0, 0, pa0); PK4(p0, 8, pa1); PK4(p1, 0, pa2); PK4(p1, 8, pa3);
#undef PK4
}
__device__ __forceinline__ void qkt(f32x16& p0, f32x16& p1, const bf16* Ks, const bf16x8* qr, int r32, int hi) {
  p0 = f32x16{}; p1 = f32x16{};
#pragma unroll
  for (int d0 = 0; d0 < 8; ++d0) { int cb = (d0 * 16 + hi * 8) * 2;
    bf16x8 b0 = *reinterpret_cast<const bf16x8*>((const char*)Ks + KSWZ(r32, cb));
    bf16x8 b1 = *reinterpret_cast<const bf16x8*>((const char*)Ks + KSWZ(32 + r32, cb));
    p0 = __builtin_amdgcn_mfma_f32_32x32x16_bf16(b0, qr[d0], p0, 0, 0, 0);
    p1 = __builtin_amdgcn_mfma_f32_32x32x16_bf16(b1, qr[d0], p1, 0, 0, 0); }
}
__device__ __forceinline__ int v_st(int k, int c) { const int kk = (k & ~0xC) | ((k & 4) << 1) | ((k & 8) >> 1); return ((kk >> 3) * 4 + (c >> 5)) * 512 + ((kk & 7) * 32 + (c & 31)) * 2; }
__device__ __forceinline__ int v_rd_base(int lane) { return ((lane & 3) << 3) | (((lane >> 2) & 3) << 6) | (((lane >> 4) & 1) << 5) | (((lane >> 5) & 1) << 8); }
constexpr int v_rd_off(int d0, int ks, int half) { return d0 * 512 + ks * 4096 + half * 2048; }
template <int OFF> __device__ __forceinline__ s16x4 tr_read(int vb) {
  s16x4 r; asm volatile("ds_read_b64_tr_b16 %0, %1 offset:%2" : "=&v"(r) : "v"(vb), "i"(OFF) : "memory"); return r;
}
template <int D0> __device__ __forceinline__ void pv_one(f32x16& od, int vb, bf16x8 pa0, bf16x8 pa1, bf16x8 pa2, bf16x8 pa3) {
  const s16x4 l0 = tr_read<v_rd_off(D0, 0, 0)>(vb), h0 = tr_read<v_rd_off(D0, 0, 1)>(vb), l1 = tr_read<v_rd_off(D0, 1, 0)>(vb), h1 = tr_read<v_rd_off(D0, 1, 1)>(vb);
  const s16x4 l2 = tr_read<v_rd_off(D0, 2, 0)>(vb), h2 = tr_read<v_rd_off(D0, 2, 1)>(vb), l3 = tr_read<v_rd_off(D0, 3, 0)>(vb), h3 = tr_read<v_rd_off(D0, 3, 1)>(vb);
  asm volatile("s_waitcnt lgkmcnt(0)" ::: "memory"); SBAR();
#define PK(L, H) (bf16x8){L[0], L[1], L[2], L[3], H[0], H[1], H[2], H[3]}
  od = __builtin_amdgcn_mfma_f32_32x32x16_bf16(pa0, PK(l0, h0), od, 0, 0, 0);
  od = __builtin_amdgcn_mfma_f32_32x32x16_bf16(pa1, PK(l1, h1), od, 0, 0, 0);
  od = __builtin_amdgcn_mfma_f32_32x32x16_bf16(pa2, PK(l2, h2), od, 0, 0, 0);
  od = __builtin_amdgcn_mfma_f32_32x32x16_bf16(pa3, PK(l3, h3), od, 0, 0, 0);
#undef PK
}
template <int D0> __device__ __forceinline__ void pv_one_lean(f32x16& od, int vb, bf16x8 pa0, bf16x8 pa1, bf16x8 pa2, bf16x8 pa3) {
#define PK(L, H) (bf16x8){L[0], L[1], L[2], L[3], H[0], H[1], H[2], H[3]}
  { const s16x4 l0 = tr_read<v_rd_off(D0, 0, 0)>(vb), h0 = tr_read<v_rd_off(D0, 0, 1)>(vb), l1 = tr_read<v_rd_off(D0, 1, 0)>(vb), h1 = tr_read<v_rd_off(D0, 1, 1)>(vb);
    asm volatile("s_waitcnt lgkmcnt(0)" ::: "memory"); SBAR();
    od = __builtin_amdgcn_mfma_f32_32x32x16_bf16(pa0, PK(l0, h0), od, 0, 0, 0);
    od = __builtin_amdgcn_mfma_f32_32x32x16_bf16(pa1, PK(l1, h1), od, 0, 0, 0); }
  { const s16x4 l2 = tr_read<v_rd_off(D0, 2, 0)>(vb), h2 = tr_read<v_rd_off(D0, 2, 1)>(vb), l3 = tr_read<v_rd_off(D0, 3, 0)>(vb), h3 = tr_read<v_rd_off(D0, 3, 1)>(vb);
    asm volatile("s_waitcnt lgkmcnt(0)" ::: "memory"); SBAR();
    od = __builtin_amdgcn_mfma_f32_32x32x16_bf16(pa2, PK(l2, h2), od, 0, 0, 0);
    od = __builtin_amdgcn_mfma_f32_32x32x16_bf16(pa3, PK(l3, h3), od, 0, 0, 0); }
#undef PK
}
__device__ __forceinline__ void pv_d0_lean(f32x16* o, int vb, bf16x8 pa0, bf16x8 pa1, bf16x8 pa2, bf16x8 pa3) {
  pv_one_lean<0>(o[0], vb, pa0, pa1, pa2, pa3); pv_one_lean<1>(o[1], vb, pa0, pa1, pa2, pa3); pv_one_lean<2>(o[2], vb, pa0, pa1, pa2, pa3); pv_one_lean<3>(o[3], vb, pa0, pa1, pa2, pa3);
}
__device__ __forceinline__ void pv_d0(f32x16* o, int vb, bf16x8 pa0, bf16x8 pa1, bf16x8 pa2, bf16x8 pa3) {
  pv_one<0>(o[0], vb, pa0, pa1, pa2, pa3); pv_one<1>(o[1], vb, pa0, pa1, pa2, pa3); pv_one<2>(o[2], vb, pa0, pa1, pa2, pa3); pv_one<3>(o[3], vb, pa0, pa1, pa2, pa3);
}

struct UA {
  const bf16* Q; long ldq;
  const bf16* K; const bf16* V; long ldk;
  int NT;
  int j0;
  int qk0;
  float slope2;
  int qrow0, krow0;
  const float* tbl;
  bf16* Y; long ldy; const bf16* Z; long ldz;
  float* O; long ldo;
  float* L; long ldl;
};

template <int MODE, int SDEPTH>
__device__ __forceinline__ void attn_unit(const UA& a, char* lds, const int wave_in) {
  int tid_ = fresh_tid(wave_in); asm volatile("" : "+v"(tid_));
  const int tid = tid_, wid = __builtin_amdgcn_readfirstlane(tid >> 6), lane = tid & 63, r32 = lane & 31, hi = lane >> 5;
  bf16* V_lds = (bf16*)lds; bf16* K_lds = (bf16*)(lds + 2 * SHM_V);
  float* ws = (float*)(lds + OFF_WS) + wid * 64; float* li_l = ws; float* al_l = ws + 32;
  float* tbl = (float*)(lds + OFF_TBL) + 64;
  if (MODE == M_NA) { __syncthreads(); for (int i = tid; i < 15 * 31; i += 512) tbl[i] = a.tbl[i] * LOG2E; }
  float m_reg = -1e30f, l_reg = 0; f32x16 o[4] = {}; bf16x8 qr[8];
  const bf16* Qw = a.Q + (long)(wid * QBLK + r32) * a.ldq + hi * 8;
#pragma unroll
  for (int d0 = 0; d0 < 8; ++d0) qr[d0] = *reinterpret_cast<const bf16x8*>(Qw + d0 * 16);
  const int sr = tid >> 4, sc = (tid & 15) * 8, vst0 = v_st(sr, sc), vst1 = v_st(32 + sr, sc);
  const int vb0 = (int)(uintptr_t)V_lds + v_rd_base(lane);
  const bf16* Kh = a.K; const bf16* Vh = a.V; const long LDK = a.ldk;
  struct { bf16x8 vs0, vs1, ks0, ks1; } sr_[SDEPTH];
#define SLOAD(i, k0) do { sr_[i].vs0 = *reinterpret_cast<const bf16x8*>(&Vh[(long)((k0) + sr) * LDK + sc]); sr_[i].vs1 = *reinterpret_cast<const bf16x8*>(&Vh[(long)((k0) + 32 + sr) * LDK + sc]); \
    sr_[i].ks0 = *reinterpret_cast<const bf16x8*>(&Kh[(long)((k0) + sr) * LDK + sc]); sr_[i].ks1 = *reinterpret_cast<const bf16x8*>(&Kh[(long)((k0) + 32 + sr) * LDK + sc]); } while (0)
#define SWRITE(b, i) do { *(bf16x8*)((char*)V_lds + (b) * SHM_V + vst0) = sr_[i].vs0;          \
    *(bf16x8*)((char*)V_lds + (b) * SHM_V + vst1) = sr_[i].vs1; int kc = sc * 2;               \
    *(bf16x8*)((char*)K_lds + (b) * SHM_K + KSWZ(sr, kc)) = sr_[i].ks0;                       \
    *(bf16x8*)((char*)K_lds + (b) * SHM_K + KSWZ(32 + sr, kc)) = sr_[i].ks1; } while (0)
#define SWAIT() do { if constexpr (SDEPTH == 2) asm volatile("s_waitcnt vmcnt(4)" ::: "memory"); else asm volatile("s_waitcnt vmcnt(0)" ::: "memory"); } while (0)
#define RESC(a_) do { if (__any((a_) < 1.f)) { if (hi == 0) al_l[r32] = (a_); asm volatile("s_waitcnt lgkmcnt(0)" ::: "memory"); \
    _Pragma("unroll") for (int d = 0; d < 4; ++d) _Pragma("unroll") for (int r = 0; r < 16; ++r) o[d][r] *= al_l[crow(r, hi)]; } } while (0)
  const float NEG_INF = -__builtin_inff();
  const int qkrel = a.qk0 + wid * 32 + r32 - 4 * hi;
  const float nslope = -a.slope2;
  const int qgr = a.qrow0 + (wid >> 1), cq = 32 * (wid & 1) + r32;
  const int c0 = min(max(cq - 8, 0), 48), r0 = min(max(qgr - 4, 0), 56);
#define MOD(P0, P1, J) do { \
    if (MODE == M_ALIBI || MODE == M_DIL) { const float rel = (float)(qkrel - (J) * 64); \
      _Pragma("unroll") for (int r = 0; r < 16; ++r) { const float cr = (float)((r & 3) + 8 * (r >> 2)); const float d0_ = fabsf(rel - cr), d1_ = fabsf(rel - cr - 32.f); \
        float v0_ = fmaf(nslope, d0_, P0[r]), v1_ = fmaf(nslope, d1_, P1[r]); \
        if (MODE == M_DIL) { v0_ = (d0_ <= 64.f) ? v0_ : NEG_INF; v1_ = (d1_ <= 64.f) ? v1_ : NEG_INF; } \
        P0[r] = v0_; P1[r] = v1_; } } \
    if (MODE == M_NA) { const int kr = a.krow0 + (J); const bool rv = (kr >= r0) && (kr < r0 + 8); \
      if (!rv) { _Pragma("unroll") for (int r = 0; r < 16; ++r) { P0[r] = NEG_INF; P1[r] = NEG_INF; } } \
      else { const float* tp = tbl + (kr - qgr + 7) * 31 + (4 * hi - cq + 15); const int kcb = 4 * hi - c0; \
        _Pragma("unroll") for (int r = 0; r < 16; ++r) { const int cr = (r & 3) + 8 * (r >> 2); \
          const bool ok0 = (unsigned)(kcb + cr) < 16u, ok1 = (unsigned)(kcb + cr + 32) < 16u; \
          const float b0_ = tp[cr], b1_ = tp[cr + 32]; \
          P0[r] = ok0 ? P0[r] + b0_ : NEG_INF; P1[r] = ok1 ? P1[r] + b1_ : NEG_INF; } } } \
  } while (0)
  f32x16 pA0, pA1, pB0, pB1; float mnA, mnB, alA, alB; bf16x8 pa0, pa1, pa2, pa3; const int NT = a.NT;
  constexpr int SE = 0, SO = SDEPTH - 1;
  SLOAD(SE, 0); asm volatile("s_waitcnt vmcnt(0)" ::: "memory"); SWRITE(0, SE); __syncthreads();
  qkt(pA0, pA1, K_lds, qr, r32, hi); MOD(pA0, pA1, 0); partialSM(pA0, pA1, m_reg, mnA, alA);
  SLOAD(SO, KVBLK); if constexpr (SDEPTH == 2) { if (2 < NT) SLOAD(SE, 2 * KVBLK); }
  SWAIT(); SWRITE(1, SO); __syncthreads();
  for (int j = 1; j + 1 < NT; j += 2) {
    SBAR(); qkt(pB0, pB1, (bf16*)((char*)K_lds + SHM_K), qr, r32, hi); MOD(pB0, pB1, j);
    finishSM(pA0, pA1, alA, l_reg, pa0, pa1, pa2, pa3); SBAR();
    SLOAD(SO, (j + SDEPTH) * KVBLK); SBAR();
    pv_d0(o, vb0, pa0, pa1, pa2, pa3); partialSM(pB0, pB1, m_reg, mnB, alB);
    __syncthreads(); SWAIT(); SWRITE(0, SE);
    RESC(alB); __syncthreads();
    SBAR(); qkt(pA0, pA1, K_lds, qr, r32, hi); MOD(pA0, pA1, j + 1);
    finishSM(pB0, pB1, alB, l_reg, pa0, pa1, pa2, pa3); SBAR();
    if (SDEPTH == 1 || j + 3 < NT) SLOAD(SE, (j + 1 + SDEPTH) * KVBLK); SBAR();
    pv_d0(o, vb0 + (int)SHM_V, pa0, pa1, pa2, pa3); partialSM(pA0, pA1, m_reg, mnA, alA);
    __syncthreads(); SWAIT(); SWRITE(1, SO);
    RESC(alA); __syncthreads();
  }
  SBAR(); qkt(pB0, pB1, (bf16*)((char*)K_lds + SHM_K), qr, r32, hi); MOD(pB0, pB1, NT - 1);
  finishSM(pA0, pA1, alA, l_reg, pa0, pa1, pa2, pa3); SBAR();
  pv_d0(o, vb0, pa0, pa1, pa2, pa3); partialSM(pB0, pB1, m_reg, mnB, alB);
  __syncthreads(); RESC(alB);
  finishSM(pB0, pB1, alB, l_reg, pa0, pa1, pa2, pa3); SBAR();
  pv_d0(o, vb0 + (int)SHM_V, pa0, pa1, pa2, pa3);
  if (hi == 0) li_l[r32] = l_reg; asm volatile("s_waitcnt lgkmcnt(0)" ::: "memory");
  float rli[16];
#pragma unroll
  for (int r = 0; r < 16; ++r) rli[r] = __builtin_amdgcn_rcpf(li_l[crow(r, hi)]);
  if (MODE == M_NA || MODE == M_DENSE) {
    bf16 zz[16][4];
#pragma unroll
    for (int r = 0; r < 16; ++r) { const long orow = wid * QBLK + crow(r, hi);
#pragma unroll
      for (int d0 = 0; d0 < 4; ++d0) zz[r][d0] = a.Z[orow * a.ldz + d0 * 32 + r32]; }
#pragma unroll
    for (int r = 0; r < 16; ++r) { const long orow = wid * QBLK + crow(r, hi);
#pragma unroll
      for (int d0 = 0; d0 < 4; ++d0) a.Y[orow * a.ldy + d0 * 32 + r32] = f2bf1(o[d0][r] * rli[r] * bf2f(zz[r][d0])); }
  } else {
#pragma unroll
    for (int r = 0; r < 16; ++r) { const long orow = wid * QBLK + crow(r, hi);
#pragma unroll
      for (int d0 = 0; d0 < 4; ++d0) a.O[orow * a.ldo + d0 * 32 + r32] = o[d0][r] * rli[r]; }
    if (MODE == M_DIL) { if (hi == 0) a.L[(long)(wid * QBLK + r32) * a.ldl] = m_reg + __builtin_amdgcn_logf(l_reg); }
  }
#undef SLOAD
#undef SWRITE
#undef SWAIT
#undef RESC
#undef MOD
}

#define ATT_LAS __attribute__((address_space(3)))
#ifndef PINGPONG_SPLIT
#define PINGPONG_SPLIT 4
#endif
template <int MODE, int NVH>
__device__ __forceinline__ void attn_unit_dma(const UA& a, char* lds, int wsoff, const int wave_in) {
  int tid_ = fresh_tid(wave_in); asm volatile("" : "+v"(tid_));
  const int tid = tid_, wid = __builtin_amdgcn_readfirstlane(tid >> 6), lane = tid & 63, r32 = lane & 31, hi = lane >> 5;
  constexpr int KB = 16384, VB = NVH * 16384, OFF_V2 = 2 * KB;
  char* K_lds = lds;
  float* ws = (float*)(lds + wsoff) + wid * 64; float* li_l = ws; float* al_l = ws + 32;
  float* tbl = (float*)(lds + wsoff + 2048) + 64;
  if (MODE == M_NA) { for (int i = tid; i < 15 * 31; i += 512) tbl[i] = a.tbl[i] * LOG2E; }
  float m_reg = -1e30f, l_reg = 0; f32x16 o[4 * NVH]; bf16x8 qr[8];
#pragma unroll
  for (int d = 0; d < 4 * NVH; ++d) o[d] = f32x16{};
  const bf16* Qw = a.Q + (long)(wid * QBLK + r32) * a.ldq + hi * 8;
#pragma unroll
  for (int d0 = 0; d0 < 8; ++d0) qr[d0] = *reinterpret_cast<const bf16x8*>(Qw + d0 * 16);
  const int vb0 = (int)(uintptr_t)(lds + OFF_V2) + v_rd_base(lane);
  const unsigned ldkb = (unsigned)(a.ldk * 2);
  unsigned koff[2], voff[2 * NVH];
#pragma unroll
  for (int i = 0; i < 2; ++i) { const int row = (wid * 2 + i) * 4 + (lane >> 4), c = (lane & 15) ^ (row & 7); koff[i] = (unsigned)row * ldkb + (unsigned)c * 16u; }
#pragma unroll
  for (int i = 0; i < 2 * NVH; ++i) { const int vb = wid * 2 * NVH + i, half = vb >> 4, b = (vb & 15) * 1024 + lane * 16;
    const int sub = b >> 9, e = (b & 511) >> 1, kk = (sub >> 2) * 8 + (e >> 5), c = (sub & 3) * 32 + (e & 31);
    const int k = (kk & ~0xC) | ((kk & 4) << 1) | ((kk & 8) >> 1);
    voff[i] = (unsigned)k * ldkb + (unsigned)(half * 128 + c) * 2u; }
  const char* Kb = (const char*)a.K; const char* Vb = (const char*)a.V; const size_t tstep = (size_t)KVBLK * ldkb;
  ATT_LAS unsigned char* ldl = (ATT_LAS unsigned char*)lds;
#define TROT(j) (((j) + a.j0 >= NT) ? (j) + a.j0 - NT : (j) + a.j0)
#define DMA(j, ks, vs) do { const int jt_ = TROT(j); const char* kt_ = Kb + (size_t)jt_ * tstep; const char* vt_ = Vb + (size_t)jt_ * tstep; \
    _Pragma("unroll") for (int i_ = 0; i_ < 2; ++i_) __builtin_amdgcn_global_load_lds((const unsigned*)(kt_ + koff[i_]), (ATT_LAS unsigned*)(ldl + (ks) * KB + (wid * 2 + i_) * 1024), 16, 0, 0); \
    _Pragma("unroll") for (int i_ = 0; i_ < 2 * NVH; ++i_) __builtin_amdgcn_global_load_lds((const unsigned*)(vt_ + voff[i_]), (ATT_LAS unsigned*)(ldl + OFF_V2 + (vs) * VB + (wid * 2 * NVH + i_) * 1024), 16, 0, 0); } while (0)
#define RESC(a_) do { if (__any((a_) < 1.f)) { if (hi == 0) al_l[r32] = (a_); asm volatile("s_waitcnt lgkmcnt(0)" ::: "memory"); \
    _Pragma("unroll") for (int d = 0; d < 4 * NVH; ++d) _Pragma("unroll") for (int r = 0; r < 16; ++r) o[d][r] *= al_l[crow(r, hi)]; } } while (0)
  const float NEG_INF = -__builtin_inff();
  const int qkrel = a.qk0 + wid * 32 + r32 - 4 * hi;
  const float nslope = -a.slope2;
  const int qgr = a.qrow0 + (wid >> 1), cq = 32 * (wid & 1) + r32;
  const int c0 = min(max(cq - 8, 0), 48), r0 = min(max(qgr - 4, 0), 56);
#define ROWOK(J) ((MODE == M_NA) ? ((a.krow0 + (J)) >= r0 && (a.krow0 + (J)) < r0 + 8) : (MODE == M_DIL) ? ((J) * 64 <= a.qk0 + wid * 32 + 95 && (J) * 64 + 127 >= a.qk0 + wid * 32) : true)
#define MOD(P0, P1, J) do { \
    if (MODE == M_ALIBI || MODE == M_DIL) { const float rel = (float)(qkrel - (J) * 64); \
      _Pragma("unroll") for (int r = 0; r < 16; ++r) { const float cr = (float)((r & 3) + 8 * (r >> 2)); const float d0_ = fabsf(rel - cr), d1_ = fabsf(rel - cr - 32.f); \
        float v0_ = fmaf(nslope, d0_, P0[r]), v1_ = fmaf(nslope, d1_, P1[r]); \
        if (MODE == M_DIL) { v0_ = (d0_ <= 64.f) ? v0_ : NEG_INF; v1_ = (d1_ <= 64.f) ? v1_ : NEG_INF; } \
        P0[r] = v0_; P1[r] = v1_; } } \
    if (MODE == M_NA) { const int kr = a.krow0 + (J); const float* tp = tbl + (kr - qgr + 7) * 31 + (4 * hi - cq + 15); const int kcb = 4 * hi - c0; \
      _Pragma("unroll") for (int r = 0; r < 16; ++r) { const int cr = (r & 3) + 8 * (r >> 2); \
        const bool ok0 = (unsigned)(kcb + cr) < 16u, ok1 = (unsigned)(kcb + cr + 32) < 16u; \
        const float b0_ = tp[cr], b1_ = tp[cr + 32]; \
        P0[r] = ok0 ? P0[r] + b0_ : NEG_INF; P1[r] = ok1 ? P1[r] + b1_ : NEG_INF; } } \
  } while (0)
  f32x16 p0, p1; float mn, al; bf16x8 pa0, pa1, pa2, pa3; const int NT = a.NT;
#define TOP(j, ks, vs) do { asm volatile("s_waitcnt vmcnt(0)" ::: "memory");        \
    __builtin_amdgcn_s_barrier(); asm volatile("" ::: "memory");                    \
    if ((j) + 1 < NT) DMA((j) + 1, (ks) ^ 1, ((vs) == 2) ? 0 : (vs) + 1); } while (0)
#define QKSM(j, ks) do { SBAR(); qkt(p0, p1, (const bf16*)(K_lds + (ks) * KB), qr, r32, hi); MOD(p0, p1, TROT(j)); \
    partialSM(p0, p1, m_reg, mn, al); RESC(al); finishSM(p0, p1, al, l_reg, pa0, pa1, pa2, pa3); SBAR(); } while (0)
#define PVS(vs) do { _Pragma("unroll") for (int h = 0; h < NVH; ++h) { if (NVH == 2) pv_d0_lean(o + 4 * h, vb0 + (vs) * VB + h * 16384, pa0, pa1, pa2, pa3); else pv_d0(o + 4 * h, vb0 + (vs) * VB + h * 16384, pa0, pa1, pa2, pa3); } } while (0)
  DMA(0, 0, 0);
  if (wid < PINGPONG_SPLIT) {
    int vs = 0;
    for (int j = 0; j < NT; ++j) { const int ks = j & 1;
      TOP(j, ks, vs); if (ROWOK(TROT(j))) { QKSM(j, ks); PVS(vs); }
      vs = (vs == 2) ? 0 : vs + 1; }
  } else {
    int vs = 0, vprev = 0; bool pend = false;
    for (int j = 0; j < NT; ++j) { const int ks = j & 1;
      TOP(j, ks, vs); if (pend) PVS(vprev); pend = ROWOK(TROT(j)); if (pend) QKSM(j, ks);
      vprev = vs; vs = (vs == 2) ? 0 : vs + 1; }
    if (pend) PVS(vprev);
  }
  if (hi == 0) li_l[r32] = l_reg; asm volatile("s_waitcnt lgkmcnt(0)" ::: "memory");
  float rli[16];
#pragma unroll
  for (int r = 0; r < 16; ++r) rli[r] = __builtin_amdgcn_rcpf(li_l[crow(r, hi)]);
  if (MODE == M_DENSE || MODE == M_NA) {
    bf16 zz[16][4 * NVH];
#pragma unroll
    for (int r = 0; r < 16; ++r) { const long orow = wid * QBLK + crow(r, hi);
#pragma unroll
      for (int d0 = 0; d0 < 4 * NVH; ++d0) zz[r][d0] = a.Z[orow * a.ldz + d0 * 32 + r32]; }
#pragma unroll
    for (int r = 0; r < 16; ++r) { const long orow = wid * QBLK + crow(r, hi);
#pragma unroll
      for (int d0 = 0; d0 < 4 * NVH; ++d0) a.Y[orow * a.ldy + d0 * 32 + r32] = f2bf1(o[d0][r] * rli[r] * bf2f(zz[r][d0])); }
  } else {
#pragma unroll
    for (int r = 0; r < 16; ++r) { const long orow = wid * QBLK + crow(r, hi);
#pragma unroll
      for (int d0 = 0; d0 < 4 * NVH; ++d0) a.O[orow * a.ldo + d0 * 32 + r32] = o[d0][r] * rli[r]; }
    if (MODE == M_DIL) { if (hi == 0) a.L[(long)(wid * QBLK + r32) * a.ldl] = m_reg + __builtin_amdgcn_logf(l_reg); }
  }
  __builtin_amdgcn_s_barrier(); asm volatile("" ::: "memory");
#undef DMA
#undef RESC
#undef MOD
#undef TOP
#undef QKSM
#undef PVS
#undef ROWOK
#undef TROT
}
#undef KSWZ
#undef SBAR
}
constexpr int NWAVES = 8;
#ifndef MK_ONE_LAUNCH
#define MK_ONE_LAUNCH 1
#endif
constexpr bool ONE_LAUNCH = MK_ONE_LAUNCH != 0;

constexpr int DM = 4096, NB = 2, SEQ = 4096, DEPTH = 2, HD = 128, GRID_W = 64;
constexpr int M = NB * SEQ;
constexpr int LDP = 32256;
constexpr float RMS_EPS = 1e-6f;
constexpr float QSCALE = 0.08838834764831845f * 1.4426950408889634f;
constexpr int CA_Q = 0, CA_K = 1024, CA_V = 2048, CA_Z = 3072;
constexpr int CB_Q = 4096, CB_K = 5120, CB_V = 5376, CB_Z = 5632;
constexpr int CC_Q = 6656, CC_K = 7680, CC_V = 8704, CC_Z = 9728;
constexpr int CD_Q = 10752, CD_K = 12288, CD_V = 13824, CD_Z = 15360;
constexpr int CG = 15872;

constexpr size_t MiB = 1u << 20;
constexpr size_t WS_CTL = 0, CTL_ZERO_BYTES = 1 * MiB;
constexpr int PK = DM + 64, PY = 1024 + 64;
constexpr size_t WS_WIN = 2 * MiB, WIN_LAYER = 256 * MiB;
constexpr size_t WBR_BLOCK = 9 * MiB;
constexpr size_t WS_WBR = WS_WIN + 2 * WIN_LAYER, WBR_LAYER = 4 * WBR_BLOCK;
constexpr size_t WS_WOUT = WS_WBR + 2 * WBR_LAYER, WOUT_LAYER = 33 * MiB;
constexpr size_t WS_XN = WS_WOUT + 2 * WOUT_LAYER;
constexpr size_t WS_PROJ = WS_XN + 66 * MiB;
constexpr size_t WS_OC = WS_PROJ + 504 * MiB;
constexpr size_t WS_OD = WS_OC + 64 * MiB;
constexpr size_t WS_LSE = WS_OD + 48 * MiB;
constexpr size_t Y_BLOCK = 17 * MiB;
constexpr size_t WS_YA = WS_LSE + 1 * MiB, WS_YB = WS_YA + Y_BLOCK, WS_YC = WS_YB + Y_BLOCK, WS_YD = WS_YC + Y_BLOCK;
constexpr size_t WS_MG = WS_YD + Y_BLOCK;
constexpr size_t WS_X1 = WS_MG + 66 * MiB;
constexpr int P8 = DM + 128;
constexpr size_t WS_XN8 = WS_X1 + 128 * MiB;
constexpr size_t WS_SA = WS_XN8 + 33 * MiB;
constexpr int N8 = 110 * 256;
constexpr size_t WS_WG8 = WS_SA + 1 * MiB, WG8_LAYER = 114 * MiB;
constexpr size_t WS_SB = WS_WG8 + 2 * WG8_LAYER;
constexpr size_t WS_MG8 = WS_SB + 1 * MiB;
constexpr size_t WS_SM = WS_MG8 + 33 * MiB;
constexpr size_t WS_WO8 = WS_SM + 1 * MiB, WO8_LAYER = 17 * MiB;
constexpr size_t WS_SO = WS_WO8 + 2 * WO8_LAYER;
constexpr size_t WS_END = WS_SO + 1 * MiB;
static_assert((size_t)DM * P8 <= WO8_LAYER, "d_ws map (int8 w_out)");
static_assert((size_t)M * P8 <= 33 * MiB && (size_t)N8 * P8 <= WG8_LAYER && (size_t)2 * N8 * 4 <= 1 * MiB, "d_ws map (int8)");
static_assert((size_t)LDP * PK * 2 <= WIN_LAYER && (size_t)DM * PY * 2 <= WBR_BLOCK && (size_t)DM * PK * 2 <= WOUT_LAYER && (size_t)M * PK * 2 <= 66 * MiB && (size_t)M * PY * 2 <= Y_BLOCK, "d_ws map");
constexpr int CW_BAR = 4096;

constexpr int RING_OFF = 0, RING_BYTES = 131072;
constexpr int LDSCTL_OFF = RING_BYTES, MISC_OFF = LDSCTL_OFF + 320;
constexpr int XTAB_OFF = RING_BYTES + 1024;
constexpr int LDS_BYTES = 147456;
static_assert(att::SHM_ATTN <= RING_BYTES, "attention scratch fits the ring region");

#define LAS __attribute__((address_space(3)))
typedef unsigned short bf16;
typedef unsigned v4u __attribute__((ext_vector_type(4)));
typedef unsigned v2u __attribute__((ext_vector_type(2)));
typedef float f32x4 __attribute__((ext_vector_type(4)));
#define LDS_WAIT() asm volatile("s_waitcnt lgkmcnt(0)" ::: "memory")
__device__ __forceinline__ unsigned f2bf(float f) { unsigned u = __builtin_bit_cast(unsigned, f); return (u + 0x7fffu + ((u >> 16) & 1u)) >> 16; }
__device__ __forceinline__ unsigned pk2(float lo, float hi) { return f2bf(lo) | (f2bf(hi) << 16); }
__device__ __forceinline__ float bflo(unsigned w) { return __builtin_bit_cast(float, w << 16); }
__device__ __forceinline__ float bfhi(unsigned w) { return __builtin_bit_cast(float, w & 0xffff0000u); }
#define XB_TMO      128
#define XB_XCNT(j)  (256  + 64 * (j))
#define XB_XSUB(j)  (1280 + 64 * (j))
#define XB_XGEN(j)  (2304 + 64 * (j))
#define XB_TOP      3328
#define XB_TOPGEN   3392
#define XCD_BAR_WORDS 3456
#define XB_SPIN_CAP (1u << 22)

__device__ __forceinline__ unsigned xb_ld(unsigned* p)              { return __hip_atomic_load(p, __ATOMIC_RELAXED, __HIP_MEMORY_SCOPE_AGENT); }
__device__ __forceinline__ unsigned xb_add(unsigned* p, unsigned v) { return __hip_atomic_fetch_add(p, v, __ATOMIC_RELAXED, __HIP_MEMORY_SCOPE_AGENT); }
__device__ __forceinline__ unsigned xb_xcc_id() { return (unsigned)__builtin_amdgcn_s_getreg((3 << 11) | 20) & 0xFu; }
#define XB_SPIN(cond, bar) do { unsigned _sp = 0; while (cond) { __builtin_amdgcn_s_sleep(1); \
    if ((++_sp & 255u) == 0u) { if (xb_ld(&(bar)[XB_TMO])) break; if (_sp > XB_SPIN_CAP) { atomicAdd(&(bar)[XB_TMO], 1u); break; } } } } while (0)

struct XcdBarrier {
    unsigned* bar; unsigned x;
    volatile LAS unsigned* st;
};

__device__ __forceinline__ XcdBarrier xcd_barrier_post(unsigned* bar, volatile LAS unsigned* st) {
    XcdBarrier b; b.bar = bar; b.x = xb_xcc_id(); b.st = st;
    if (threadIdx.x == 0) (void)xb_add(&bar[XB_XCNT(b.x)], 1u);
    return b;
}
__device__ __forceinline__ void xcd_barrier_complete(unsigned* bar, unsigned x, unsigned& nloc, unsigned& nx) {
    const unsigned G = gridDim.x * gridDim.y * gridDim.z;
    unsigned sum, cnt, mine, sp = 0u;
    for (;;) {
        sum = 0u; cnt = 0u; mine = 0u;
#pragma unroll 1
        for (unsigned j = 0; j < 16; ++j) { const unsigned c = xb_ld(&bar[XB_XCNT(j)]); sum += c; cnt += (c > 0u) ? 1u : 0u; mine = (j == x) ? c : mine; }
        if (sum == G) break;
        __builtin_amdgcn_s_sleep(1);
        if ((++sp & 255u) == 0u) { if (xb_ld(&bar[XB_TMO])) break; if (sp > XB_SPIN_CAP) { atomicAdd(&bar[XB_TMO], 1u); break; } }
    }
    nloc = mine > 0u ? mine : 1u; nx = cnt > 0u ? cnt : 1u;
}

__device__ __noinline__ void xcd_barrier(const XcdBarrier b, const bool leader  ) {
    asm volatile("s_waitcnt vmcnt(0)" ::: "memory");
    __syncthreads();
    if (leader) {
        unsigned* bar = b.bar;
        __builtin_amdgcn_s_waitcnt(0);
        unsigned nloc = b.st[0], nx = b.st[1];
        if (nloc == 0u) { xcd_barrier_complete(bar, b.x, nloc, nx); b.st[0] = nloc; b.st[1] = nx; }
        const unsigned old = xb_add(&bar[XB_XSUB(b.x)], 1u);
        const unsigned gen = old / nloc;
        if (old + 1u == (gen + 1u) * nloc) {
            __builtin_amdgcn_fence(__ATOMIC_RELEASE, "agent");
            asm volatile("s_waitcnt vmcnt(0)" ::: "memory");
            const unsigned og = xb_add(&bar[XB_TOP], 1u);
            const unsigned tg = og / nx;
            if (og + 1u == (tg + 1u) * nx) xb_add(&bar[XB_TOPGEN], 1u);
            else XB_SPIN(xb_ld(&bar[XB_TOPGEN]) == tg, bar);
            __builtin_amdgcn_fence(__ATOMIC_ACQUIRE, "agent");
            xb_add(&bar[XB_XGEN(b.x)], 1u);
            asm volatile("s_waitcnt vmcnt(0)" ::: "memory");
        } else {
            XB_SPIN(xb_ld(&bar[XB_XGEN(b.x)]) == gen, bar);
            __builtin_amdgcn_fence(__ATOMIC_ACQUIRE, "agent");
            asm volatile("s_waitcnt vmcnt(0)" ::: "memory");
        }
    }
    __syncthreads();
}
struct Frame {
    LAS unsigned char* lds;
    volatile LAS unsigned* MISC;
    unsigned* ctl;
    int tid, lane, wave;
    int vcu, G;
};
__device__ __forceinline__ float wave_sum(float v, const int lane) {
#pragma unroll
    for (int o = 1; o < 64; o <<= 1) v += __builtin_bit_cast(float, __builtin_amdgcn_ds_bpermute((lane ^ o) << 2, __builtin_bit_cast(int, v)));
    return v;
}
__device__ __forceinline__ float wave_max(float v, const int lane) {
#pragma unroll
    for (int o = 1; o < 64; o <<= 1) v = fmaxf(v, __builtin_bit_cast(float, __builtin_amdgcn_ds_bpermute((lane ^ o) << 2, __builtin_bit_cast(int, v))));
    return v;
}
__device__ __forceinline__ unsigned q8(float a, float b, float c, float d, float inv) {
    const int qa = (int)__builtin_rintf(a * inv), qb = (int)__builtin_rintf(b * inv), qc = (int)__builtin_rintf(c * inv), qd = (int)__builtin_rintf(d * inv);
    return (unsigned)(qa & 255) | ((unsigned)(qb & 255) << 8) | ((unsigned)(qc & 255) << 16) | ((unsigned)(qd & 255) << 24);
}
__device__ __forceinline__ void p0_transpose_item(const float* W, int K, int N, bf16* WT, int ldt, LAS float* scr, int item, int lane, int noff = 0, int ncols = 0) {
    const int nblk = (ncols ? ncols : N) / 32, kb = item / nblk, nb = item % nblk, k0 = 64 * kb, n0 = noff + 32 * nb;
    float v[32];
#pragma unroll
    for (int i = 0; i < 32; ++i) { const int kk = 2 * i + (lane >> 5); v[i] = __builtin_nontemporal_load(W + (size_t)(k0 + kk) * N + n0 + (lane & 31)); }
#pragma unroll
    for (int i = 0; i < 32; ++i) { const int kk = 2 * i + (lane >> 5); scr[kk * 33 + (lane & 31)] = v[i]; }
    LDS_WAIT(); asm volatile("" ::: "memory");
    const int c = lane & 7;
#pragma unroll
    for (int j = 0; j < 4; ++j) { const int n = (lane >> 3) + 8 * j; const LAS float* s = scr + (8 * c) * 33 + n;
        v4u o; o.x = pk2(s[0 * 33], s[1 * 33]); o.y = pk2(s[2 * 33], s[3 * 33]); o.z = pk2(s[4 * 33], s[5 * 33]); o.w = pk2(s[6 * 33], s[7 * 33]);
        *(v4u*)(WT + (size_t)(n0 + n) * ldt + k0 + 8 * c) = o; }
    LDS_WAIT(); asm volatile("" ::: "memory");
}
__device__ __forceinline__ void ld_xrow(const float* xrow, f32x4 (&v)[16], int lane) {
    const f32x4* xr = (const f32x4*)xrow + lane;
#pragma unroll
    for (int j = 0; j < 16; ++j) v[j] = xr[64 * j];
}
__device__ __forceinline__ void rms_row_regs(f32x4 (&v)[16], const float* g, bf16* orow, unsigned* qrow, float* sa_row, int lane) {
    const f32x4* gr = (const f32x4*)g + lane;
    float s = 0.f;
#pragma unroll
    for (int j = 0; j < 16; ++j) s += (v[j].x * v[j].x + v[j].y * v[j].y) + (v[j].z * v[j].z + v[j].w * v[j].w);
    const float rstd = 1.0f / sqrtf(wave_sum(s, lane) * (1.f / DM) + RMS_EPS);
    v2u* o8 = (v2u*)orow + lane; float mx = 0.f;
#pragma unroll
    for (int j = 0; j < 16; ++j) { const f32x4 gg = gr[64 * j]; v[j].x *= rstd * gg.x; v[j].y *= rstd * gg.y; v[j].z *= rstd * gg.z; v[j].w *= rstd * gg.w;
        mx = fmaxf(fmaxf(mx, fmaxf(fabsf(v[j].x), fabsf(v[j].y))), fmaxf(fabsf(v[j].z), fabsf(v[j].w)));
        v2u w; w.x = pk2(v[j].x, v[j].y); w.y = pk2(v[j].z, v[j].w); o8[64 * j] = w; }
    mx = fmaxf(wave_max(mx, lane), 1e-30f);
    const float inv = 127.0f / mx;
#pragma unroll
    for (int j = 0; j < 16; ++j) qrow[lane + 64 * j] = q8(v[j].x, v[j].y, v[j].z, v[j].w, inv);
    if (lane == 0) *sa_row = mx * (1.0f / 127.0f);
}
__device__ __forceinline__ void rms_row_to_bf16(const float* xrow, const float* g, bf16* orow, unsigned* qrow, float* sa_row, int lane) {
    f32x4 v[16]; ld_xrow(xrow, v, lane); rms_row_regs(v, g, orow, qrow, sa_row, lane);
}
__device__ __forceinline__ void ld_row16(const bf16* wrow, v4u (&w)[8], int lane) {
#pragma unroll
    for (int j = 0; j < 8; ++j) w[j] = *((const v4u*)wrow + lane + 64 * j);
}
__device__ __forceinline__ void q_row16(const v4u (&w)[8], unsigned* qrow, float* sc, int lane) {
    float mx = 0.f;
#pragma unroll
    for (int j = 0; j < 8; ++j) {
        mx = fmaxf(mx, fmaxf(fmaxf(fmaxf(fabsf(bflo(w[j].x)), fabsf(bfhi(w[j].x))), fmaxf(fabsf(bflo(w[j].y)), fabsf(bfhi(w[j].y)))), fmaxf(fmaxf(fabsf(bflo(w[j].z)), fabsf(bfhi(w[j].z))), fmaxf(fabsf(bflo(w[j].w)), fabsf(bfhi(w[j].w)))))); }
    mx = fmaxf(wave_max(mx, lane), 1e-30f);
    const float inv = 127.0f / mx;
#pragma unroll
    for (int j = 0; j < 8; ++j) { v2u o; o.x = q8(bflo(w[j].x), bfhi(w[j].x), bflo(w[j].y), bfhi(w[j].y), inv); o.y = q8(bflo(w[j].z), bfhi(w[j].z), bflo(w[j].w), bfhi(w[j].w), inv);
        *((v2u*)qrow + lane + 64 * j) = o; }
    if (lane == 0) *sc = mx * (1.0f / 127.0f);
}
struct Args;
template <class KPT> __device__ __forceinline__ void phase_prologue(Frame& F, KPT KP, unsigned char* ws) {
#define in_(i) ((const float*)(__attribute__((address_space(1))) const float*)(unsigned long long)KP->in[i])
    LAS float* scr = (LAS float*)(F.lds + RING_OFF + F.wave * 16384);
    const int gw = F.vcu * NWAVES + F.wave, NGW = F.G * NWAVES;
    constexpr int C16 = pg8::NT16 * 256, C16_OFF = 26 * 256;
    constexpr int I_IN = (DM / 64) * (C16 / 32), I_BR = (1024 / 64) * (DM / 32), I_BD = (512 / 64) * (DM / 32);
    constexpr int I_LAYER = I_IN + 3 * I_BR + I_BD;
    for (int it = gw; it < 2 * I_LAYER; it += NGW) {
        const int l = it / I_LAYER; int r = it % I_LAYER;
        bf16* wbr = (bf16*)(ws + WS_WBR + (size_t)l * WBR_LAYER);
        if (r < I_IN) { p0_transpose_item(in_(2) + (size_t)l * DM * LDP, DM, LDP, (bf16*)(ws + WS_WIN + (size_t)l * WIN_LAYER), PK, scr, r, F.lane, C16_OFF, C16); continue; } r -= I_IN;
        if (r < I_BR) { p0_transpose_item(in_(7) + (size_t)l * 1024 * DM, 1024, DM, wbr, PY, scr, r, F.lane); continue; } r -= I_BR;
        if (r < I_BR) { p0_transpose_item(in_(8) + (size_t)l * 1024 * DM, 1024, DM, wbr + 1 * (WBR_BLOCK / 2), PY, scr, r, F.lane); continue; } r -= I_BR;
        if (r < I_BR) { p0_transpose_item(in_(9) + (size_t)l * 1024 * DM, 1024, DM, wbr + 2 * (WBR_BLOCK / 2), PY, scr, r, F.lane); continue; } r -= I_BR;
        p0_transpose_item(in_(10) + (size_t)l * 512 * DM, 512, DM, wbr + 3 * (WBR_BLOCK / 2), PY, scr, r, F.lane);
    }
    {
        LAS float* cm = (LAS float*)(F.lds + RING_OFF + 12288);
        const int lane = F.lane, n = lane & 31, kpar = lane >> 5;
        constexpr int NBQ = N8 / 32;
        for (int it = F.vcu; it < 2 * NBQ + 2 * (DM / 32); it += F.G) {
            const float* W; int ldw; unsigned char* Q; float* SC;
            if (it < 2 * NBQ) { const int l = it / NBQ, n0c = (it % NBQ) * 32, n0 = pg8::map8(n0c >> 8) * 256 + (n0c & 255);
                W = in_(2) + (size_t)l * DM * LDP + n0 + n; ldw = LDP; Q = ws + WS_WG8 + (size_t)l * WG8_LAYER + (size_t)n0c * P8; SC = (float*)(ws + WS_SB) + (size_t)l * N8 + n0c; }
            else { const int r = it - 2 * NBQ, l = r / (DM / 32), n0 = (r % (DM / 32)) * 32;
                W = in_(11) + (size_t)l * DM * DM + n0 + n; ldw = DM; Q = ws + WS_WO8 + (size_t)l * WO8_LAYER + (size_t)n0 * P8; SC = (float*)(ws + WS_SO) + (size_t)l * DM + n0; }
            float mx = 0.f; unsigned pk[8][16];
#pragma unroll
            for (int kb = 0; kb < 8; ++kb) { const int k0 = (F.wave * 8 + kb) * 64;
                float v[32]; const float* wp = W + (size_t)(k0 + kpar) * ldw;
#pragma unroll
                for (int i = 0; i < 32; ++i) { v[i] = __builtin_nontemporal_load(wp); wp += 2 * ldw; asm volatile("" : "+v"(wp)); }
#pragma unroll
                for (int i = 0; i < 32; ++i) mx = fmaxf(mx, fabsf(v[i]));
#pragma unroll
                for (int i = 0; i < 16; ++i) { pk[kb][i] = pk2(v[2 * i], v[2 * i + 1]); asm volatile("" : "+v"(pk[kb][i])); }
                asm volatile("" ::: "memory"); __builtin_amdgcn_sched_barrier(0); }
            mx = fmaxf(mx, __builtin_bit_cast(float, __builtin_amdgcn_ds_bpermute((lane ^ 32) << 2, __builtin_bit_cast(int, mx))));
            if (lane < 32) cm[F.wave * 32 + lane] = mx;
            LDS_WAIT(); __syncthreads();
            float cmax = cm[n];
#pragma unroll
            for (int w = 1; w < 8; ++w) cmax = fmaxf(cmax, cm[w * 32 + n]);
            cmax = fmaxf(cmax, 1e-30f);
            const float inv = 127.0f / cmax;
            if (F.wave == 0 && lane < 32) SC[lane] = cmax * (1.0f / 127.0f);
#pragma unroll
            for (int kb = 0; kb < 8; ++kb) { const int k0 = (F.wave * 8 + kb) * 64;
#pragma unroll
                for (int i = 0; i < 16; ++i) { scr[(4 * i + kpar) * 33 + n] = bflo(pk[kb][i]) * inv; scr[(4 * i + 2 + kpar) * 33 + n] = bfhi(pk[kb][i]) * inv; }
                LDS_WAIT(); asm volatile("" ::: "memory");
                const int c = lane & 7;
#pragma unroll
                for (int j = 0; j < 4; ++j) { const int nn = (lane >> 3) + 8 * j; const LAS float* sp = scr + (8 * c) * 33 + nn;
                    v2u o; o.x = q8(sp[0 * 33], sp[1 * 33], sp[2 * 33], sp[3 * 33], 1.0f); o.y = q8(sp[4 * 33], sp[5 * 33], sp[6 * 33], sp[7 * 33], 1.0f);
                    *(v2u*)(Q + (size_t)nn * P8 + k0 + 8 * c) = o; }
                LDS_WAIT(); asm volatile("" ::: "memory"); __builtin_amdgcn_sched_barrier(0); }
            __syncthreads();
        }
    }
    for (int m = gw; m < M; m += NGW) rms_row_to_bf16(in_(0) + (size_t)m * DM, in_(1), (bf16*)(ws + WS_XN) + (size_t)m * PK, (unsigned*)(ws + WS_XN8 + (size_t)m * P8), (float*)(ws + WS_SA) + m, F.lane);
}
#undef in_
__device__ __forceinline__ void phase_finalize(Frame& F, unsigned char* ws, const float* lam_p  , const float* subln_g  , float lam_init) {
    const int gw = F.vcu * NWAVES + F.wave, NGW = F.G * NWAVES, lane = F.lane;
    const bf16* proj = (const bf16*)(ws + WS_PROJ);
    float d1 = lam_p[lane] * lam_p[128 + lane] + lam_p[64 + lane] * lam_p[192 + lane];
    float d2 = lam_p[256 + lane] * lam_p[384 + lane] + lam_p[320 + lane] * lam_p[448 + lane];
    d1 = wave_sum(d1, lane); d2 = wave_sum(d2, lane);
    const float lam = expf(d1) - expf(d2) + lam_init;
    const float post = 1.0f - lam_init;
    const float* OC = (const float*)(ws + WS_OC);
    const f32x4 sg = *(const f32x4*)(subln_g + 4 * lane);
    bf16* YC = (bf16*)(ws + WS_YC);
    for (int t = gw; t < M; t += NGW) {
        f32x4 o0[4], o1[4]; v2u zw[4];
#pragma unroll
        for (int h = 0; h < 4; ++h) { o0[h] = *(const f32x4*)(OC + (size_t)t * 2048 + (2 * h) * 256 + 4 * lane); o1[h] = *(const f32x4*)(OC + (size_t)t * 2048 + (2 * h + 1) * 256 + 4 * lane);
            zw[h] = *(const v2u*)(proj + (size_t)t * LDP + CC_Z + h * 256 + 4 * lane); }
#pragma unroll
        for (int h = 0; h < 4; ++h) {
            const f32x4 d = o0[h] - lam * o1[h];
            const float ss = wave_sum((d.x * d.x + d.y * d.y) + (d.z * d.z + d.w * d.w), lane);
            const float rstd = 1.0f / sqrtf(ss * (1.f / 256.f) + RMS_EPS) * post;
            v2u o; o.x = pk2(d.x * rstd * sg.x * bflo(zw[h].x), d.y * rstd * sg.y * bfhi(zw[h].x)); o.y = pk2(d.z * rstd * sg.z * bflo(zw[h].y), d.w * rstd * sg.w * bfhi(zw[h].y));
            *(v2u*)(YC + (size_t)t * PY + h * 256 + 4 * lane) = o;
        }
    }
    const float* OD = (const float*)(ws + WS_OD); const float* LSE = (const float*)(ws + WS_LSE);
    bf16* YD = (bf16*)(ws + WS_YD);
    const int hg = lane >> 4, c0 = hg * 128 + (lane & 15) * 8;
    for (int t0 = gw; t0 < M; t0 += 2 * NGW) {
        float ls[2][3]; f32x4 av[2][3][2]; v4u zw[2];
#pragma unroll
        for (int k = 0; k < 2; ++k) { const int t = min(t0 + k * NGW, M - 1);
#pragma unroll
            for (int g = 0; g < 3; ++g) { ls[k][g] = LSE[(size_t)g * M * 4 + (size_t)t * 4 + hg]; const float* pp = OD + (size_t)g * M * 512 + (size_t)t * 512 + c0; av[k][g][0] = *(const f32x4*)pp; av[k][g][1] = *(const f32x4*)(pp + 4); }
            zw[k] = *(const v4u*)(proj + (size_t)t * LDP + CD_Z + c0); }
#pragma unroll
        for (int k = 0; k < 2; ++k) { const int t = t0 + k * NGW;
            const float mx = fmaxf(ls[k][0], fmaxf(ls[k][1], ls[k][2]));
            float w0 = __builtin_amdgcn_exp2f(ls[k][0] - mx), w1 = __builtin_amdgcn_exp2f(ls[k][1] - mx), w2 = __builtin_amdgcn_exp2f(ls[k][2] - mx);
            const float inv = 1.0f / (w0 + w1 + w2); w0 *= inv; w1 *= inv; w2 *= inv;
            const f32x4 r0 = w0 * av[k][0][0] + w1 * av[k][1][0] + w2 * av[k][2][0], r1 = w0 * av[k][0][1] + w1 * av[k][1][1] + w2 * av[k][2][1];
            v4u o; o.x = pk2(r0.x * bflo(zw[k].x), r0.y * bfhi(zw[k].x)); o.y = pk2(r0.z * bflo(zw[k].y), r0.w * bfhi(zw[k].y));
            o.z = pk2(r1.x * bflo(zw[k].z), r1.y * bfhi(zw[k].z)); o.w = pk2(r1.z * bflo(zw[k].w), r1.w * bfhi(zw[k].w));
            if (t < M) *(v4u*)(YD + (size_t)t * PY + c0) = o; }
    }
}
#ifndef REP_AB
#define REP_AB 1
#endif
#ifndef REP_AC
#define REP_AC 1
#endif
#ifndef REP_AA
#define REP_AA 1
#endif
#ifndef REP_AD
#define REP_AD 1
#endif
#ifndef SD_DENSE
#define SD_DENSE 2
#endif
#ifndef SD_ALIBI
#define SD_ALIBI 2
#endif
#ifndef SD_NA
#define SD_NA 1
#endif
#ifndef SD_DIL
#define SD_DIL 1
#endif
__device__ __forceinline__ void phase_attention(Frame& F, unsigned char* ws, const float* rel_bias  , char* lds) {
    const att::bf16* P = (const att::bf16*)(ws + WS_PROJ);
    for (int rep = 0; rep < REP_AB; ++rep)
    for (int u = F.vcu; u < 256; u += F.G) {
        const int grp = u >> 6, b = grp >> 1, kvh = grp & 1, hq = kvh * 4 + ((u >> 4) & 3), qb = u & 15;
        const size_t tb = (size_t)b * SEQ, tq = tb + 256 * qb;
        att::UA a{};
        a.Q = P + tq * LDP + CB_Q + hq * 128; a.ldq = LDP;
        a.K = P + tb * LDP + CB_K + kvh * 128; a.V = P + tb * LDP + CB_V + kvh * 128; a.ldk = LDP; a.NT = SEQ / 64;
        a.Y = (att::bf16*)(ws + WS_YB) + tq * PY + hq * 128; a.ldy = PY; a.Z = P + tq * LDP + CB_Z + hq * 128; a.ldz = LDP;
        att::attn_unit_dma<att::M_DENSE, 1>(a, lds, 2 * 16384 + 3 * 16384, F.wave);
    }
    for (int rep = 0; rep < REP_AC; ++rep)
    for (int u = F.vcu; u < 256; u += F.G) {
        const int combo = u >> 4, b = combo >> 3, h = (combo >> 1) & 3, mp = combo & 1, qb = u & 15;
        const size_t tb = (size_t)b * SEQ, tq = tb + 256 * qb;
        att::UA a{};
        a.Q = P + tq * LDP + CC_Q + (h * 2 + mp) * 128; a.ldq = LDP;
        a.K = P + tb * LDP + CC_K + (h * 2 + mp) * 128; a.V = P + tb * LDP + CC_V + h * 256; a.ldk = LDP; a.NT = SEQ / 64;
        a.qk0 = 256 * qb; a.slope2 = __builtin_amdgcn_exp2f(-2.0f * (float)(h + 1)) * att::LOG2E; a.j0 = 4 * qb;
        a.O = (float*)(ws + WS_OC) + tq * 2048 + (h * 2 + mp) * 256; a.ldo = 2048;
        att::attn_unit_dma<att::M_ALIBI, 2>(a, lds, XTAB_OFF, F.wave);
    }
    for (int rep = 0; rep < REP_AA; ++rep)
    for (int u = F.vcu; u < 256; u += F.G) {
        const int b = u >> 7, h = (u >> 4) & 7, R = u & 15;
        const size_t tb = (size_t)b * SEQ, tq = tb + 256 * R;
        int kr_lo = min(max(4 * R - 4, 0), 56); const int kr_last = min(max(4 * R - 1, 0), 56) + 7; int NT = kr_last - kr_lo + 1;
        att::UA a{};
        a.Q = P + tq * LDP + CA_Q + h * 128; a.ldq = LDP;
        a.K = P + (tb + (size_t)kr_lo * 64) * LDP + CA_K + h * 128; a.V = P + (tb + (size_t)kr_lo * 64) * LDP + CA_V + h * 128; a.ldk = LDP; a.NT = NT;
        a.qrow0 = 4 * R; a.krow0 = kr_lo; a.tbl = rel_bias + h * (15 * 31);
        a.Y = (att::bf16*)(ws + WS_YA) + tq * PY + h * 128; a.ldy = PY; a.Z = P + tq * LDP + CA_Z + h * 128; a.ldz = LDP;
        att::attn_unit_dma<att::M_NA, 1>(a, lds, 2 * 16384 + 3 * 16384, F.wave);
    }
    for (int rep = 0; rep < REP_AD; ++rep)
    for (int u = F.vcu; u < 384; u += F.G) {
        const int bh = u >> 4, b = bh / 12, gh = bh % 12, g = gh >> 2, hg = gh & 3, u16 = u & 15;
        const int dil = (g == 0) ? 1 : ((g == 1) ? 4 : 16);
        const int qb = (g == 0) ? u16 : ((g == 1) ? (u16 & 3) : 0), rho = (g == 0) ? 0 : ((g == 1) ? (u16 >> 2) : u16);
        const int nttot = 64 / dil;
        const int t_lo = max(0, 4 * qb - 1), t_hi = min(nttot, 4 * qb + 5);
        const size_t tb = (size_t)b * SEQ, tq = tb + rho + (size_t)dil * 256 * qb, tk = tb + rho + (size_t)dil * 64 * t_lo;
        att::UA a{};
        a.Q = P + tq * LDP + CD_Q + gh * 128; a.ldq = (long)LDP * dil;
        a.K = P + tk * LDP + CD_K + gh * 128; a.V = P + tk * LDP + CD_V + gh * 128; a.ldk = (long)LDP * dil; a.NT = t_hi - t_lo;
        a.qk0 = 256 * qb - 64 * t_lo; a.slope2 = __builtin_amdgcn_exp2f(-8.0f * (float)(gh + 1) / 12.0f) * (float)dil * att::LOG2E;
        a.O = (float*)(ws + WS_OD) + (size_t)g * M * 512 + tq * 512 + hg * 128; a.ldo = 512L * dil;
        a.L = (float*)(ws + WS_LSE) + (size_t)g * M * 4 + tq * 4 + hg; a.ldl = 4L * dil;
        att::attn_unit_dma<att::M_DIL, 1>(a, lds, 2 * 16384 + 3 * 16384, F.wave);
    }
}

#ifndef REP_PRO
#define REP_PRO 1
#endif
#ifndef REP_INP
#define REP_INP 1
#endif
#ifndef REP_ATT
#define REP_ATT 1
#endif
#ifndef REP_FIN
#define REP_FIN 1
#endif
#ifndef REP_BRA
#define REP_BRA 1
#endif
#ifndef REP_OUT
#define REP_OUT 1
#endif
#ifndef REP_NRM
#define REP_NRM 1
#endif
constexpr int NPH = 14;
struct Args { const float* in[12]; float* out; unsigned char* ws; int ph_lo, ph_hi; };
__global__ void __launch_bounds__(NWAVES * 64, 2) mega_fwd(Args args) {
    extern __shared__ __attribute__((aligned(16))) unsigned char lds[];
    Frame F;
    F.lds = (LAS unsigned char*)lds;
    F.MISC = (volatile LAS unsigned*)(F.lds + MISC_OFF);
    F.tid = threadIdx.x; F.lane = F.tid & 63; F.wave = __builtin_amdgcn_readfirstlane(F.tid >> 6);
    const int wave0 = F.wave;
    F.G = gridDim.x; { const int bx = blockIdx.x; F.vcu = (F.G % 8 == 0) ? (bx % 8) * (F.G / 8) + bx / 8 : bx; }
    unsigned char* ws = args.ws;
    F.ctl = (unsigned*)(ws + WS_CTL);
    for (int u = F.tid; u < (LDS_BYTES - LDSCTL_OFF) / 4; u += NWAVES * 64) ((LAS unsigned*)(F.lds + LDSCTL_OFF))[u] = 0u;
    __syncthreads();
    XcdBarrier bar; bar.bar = F.ctl + CW_BAR; bar.x = 0; bar.st = nullptr;
    if (ONE_LAUNCH) bar = xcd_barrier_post(F.ctl + CW_BAR, F.MISC + 8);
    const int lo = args.ph_lo, hi = args.ph_hi;
    const __attribute__((address_space(4))) Args* KP = (const __attribute__((address_space(4))) Args*)__builtin_amdgcn_kernarg_segment_ptr();
#define INP(i) ((const float*)(__attribute__((address_space(1))) const float*)(unsigned long long)KP->in[i])
#define PHASE_ENTER() do { unsigned long long kpi_ = (unsigned long long)__builtin_amdgcn_kernarg_segment_ptr(); asm volatile("" : "+s"(kpi_)); KP = (const __attribute__((address_space(4))) Args*)kpi_; \
        unsigned long long wsi_ = (unsigned long long)KP->ws; asm volatile("" : "+s"(wsi_)); ws = (unsigned char*)(__attribute__((address_space(1))) unsigned char*)wsi_; int t_ = fresh_tid(wave0); asm volatile("" : "+v"(t_)); F.tid = t_; F.lane = t_ & 63; F.wave = wave0; } while (0)
#define IN(k) (lo <= (k) && (k) < hi)
#define SEAM(k) do { if (IN(k) && IN((k) + 1)) xcd_barrier(bar, fresh_tid(wave0) == 0); } while (0)

    if (IN(0)) { for (int rep = 0; rep < REP_PRO; ++rep) { PHASE_ENTER(); phase_prologue(F, KP, ws); }
        SEAM(0); }

#pragma unroll 1
    for (int l = 0; l < DEPTH; ++l) {
        const int pb = 1 + 7 * l;
        if (IN(pb)) for (int rep = 0; rep < REP_INP; ++rep) {
            PHASE_ENTER(); bf16* proj = (bf16*)(ws + WS_PROJ);
            {
                pg8::Gemm g8{(const pg8::bf16_t*)(ws + WS_XN8), (const pg8::bf16_t*)(ws + WS_WG8 + (size_t)l * WG8_LAYER), M, N8, DM / 2, P8 / 2};
                pg8::StaticOrder S8; S8.init(M, N8, F.G, (int)blockIdx.x);
                pg8::EpiProjT<true> E8{proj, LDP, INP(3) + (size_t)l * 4 * 2 * HD, (LAS float*)(F.lds + XTAB_OFF), QSCALE, (const float*)(ws + WS_SA), (const float*)(ws + WS_SB) + (size_t)l * N8};
                pg8::gemm_phase<pg8::EpiProjT<true>, pg8::StaticOrder, true, true, pg8::Gemm, true>(F.lds + RING_OFF, g8, S8, E8, F.wave);
            }
            pg8::GemmMap16 g{(const pg8::bf16_t*)(ws + WS_XN), (const pg8::bf16_t*)(ws + WS_WIN + (size_t)l * WIN_LAYER), DM, PK};
            pg8::StaticOrder S; S.init(M, pg8::NT16 * 256, F.G, (int)blockIdx.x);
            pg8::EpiProjT<false> E{proj, LDP, INP(3) + (size_t)l * 4 * 2 * HD, (LAS float*)(F.lds + XTAB_OFF), QSCALE, nullptr, nullptr};
            pg8::gemm_phase<pg8::EpiProjT<false>, pg8::StaticOrder, true, true, pg8::GemmMap16>(F.lds + RING_OFF, g, S, E, F.wave);
            if (rep == REP_INP - 1) SEAM(pb);
        }
        if (IN(pb + 2)) { for (int rep = 0; rep < REP_ATT; ++rep) { PHASE_ENTER(); phase_attention(F, ws, INP(4) + (size_t)l * 8 * 15 * 31, (char*)lds + RING_OFF); } SEAM(pb + 2); }
        if (IN(pb + 3)) for (int rep = 0; rep < REP_FIN; ++rep) {
            PHASE_ENTER();
            const float lam_init = 0.8f - 0.6f * expf(-0.3f * (float)l);
            phase_finalize(F, ws, INP(5) + (size_t)l * 4 * HD, INP(6) + (size_t)l * 2 * HD, lam_init); if (rep == REP_FIN - 1) SEAM(pb + 3);
        }
        if (IN(pb + 4)) for (int rep = 0; rep < REP_BRA; ++rep) {
            PHASE_ENTER(); bf16* proj = (bf16*)(ws + WS_PROJ);
            const int rot = (int)(blockIdx.x & 1);
            pg8::ChainGemm g{(const bf16*)(ws + WS_YA), (const bf16*)(ws + WS_WBR + (size_t)l * WBR_LAYER), Y_BLOCK / 2, WBR_BLOCK / 2, PY, 1024, rot};
            pg8::ChainOrder S; S.T.init(M, DM, F.G, (int)blockIdx.x);
            pg8::EpiChain E{proj + CG, LDP, (bf16*)(ws + WS_MG), PK, rot};
            pg8::gemm_phase<pg8::EpiChain, pg8::ChainOrder, true, true, pg8::ChainGemm>(F.lds + RING_OFF, g, S, E, F.wave);
            if (rep == REP_BRA - 1) SEAM(pb + 4);
        }
        if (IN(pb + 5)) {
            { PHASE_ENTER(); const int gw = F.vcu * NWAVES + F.wave, NGW = F.G * NWAVES;
              for (int m = gw; m < M; m += 2 * NGW) { const int m2 = min(m + NGW, M - 1); v4u wa[8], wb[8];
                  ld_row16((const bf16*)(ws + WS_MG) + (size_t)m * PK, wa, F.lane); ld_row16((const bf16*)(ws + WS_MG) + (size_t)m2 * PK, wb, F.lane);
                  q_row16(wa, (unsigned*)(ws + WS_MG8 + (size_t)m * P8), (float*)(ws + WS_SM) + m, F.lane);
                  if (m + NGW < M) q_row16(wb, (unsigned*)(ws + WS_MG8 + (size_t)m2 * P8), (float*)(ws + WS_SM) + m2, F.lane); } }
            xcd_barrier(bar, fresh_tid(wave0) == 0);
            for (int rep = 0; rep < REP_OUT; ++rep) {
            PHASE_ENTER();
            const float* xin = (l == 0) ? INP(0) : (const float*)(ws + WS_X1);
            float* xout = (l == DEPTH - 1) ? (float*)(__attribute__((address_space(1))) float*)(unsigned long long)KP->out : (float*)(ws + WS_X1);
            pg8::Gemm g{(const pg8::bf16_t*)(ws + WS_MG8), (const pg8::bf16_t*)(ws + WS_WO8 + (size_t)l * WO8_LAYER), M, DM, DM / 2, P8 / 2};
            pg8::StaticOrder S; S.init(M, DM, F.G, (int)blockIdx.x);
            pg8::EpiRes8 E{xin, xout, DM, (const float*)(ws + WS_SM), (const float*)(ws + WS_SO) + (size_t)l * DM};
            pg8::gemm_phase<pg8::EpiRes8, pg8::StaticOrder, true, true, pg8::Gemm, true>(F.lds + RING_OFF, g, S, E, F.wave);
            }
            SEAM(pb + 5);
        }
        if (l + 1 < DEPTH && IN(pb + 6)) for (int rep = 0; rep < REP_NRM; ++rep) {
            PHASE_ENTER();
            const int gw = F.vcu * NWAVES + F.wave, NGW = F.G * NWAVES;
            for (int m = gw; m < M; m += 2 * NGW) { const int m2 = min(m + NGW, M - 1); f32x4 va[16], vb[16];
                ld_xrow((const float*)(ws + WS_X1) + (size_t)m * DM, va, F.lane); ld_xrow((const float*)(ws + WS_X1) + (size_t)m2 * DM, vb, F.lane);
                rms_row_regs(va, INP(1) + (size_t)(l + 1) * DM, (bf16*)(ws + WS_XN) + (size_t)m * PK, (unsigned*)(ws + WS_XN8 + (size_t)m * P8), (float*)(ws + WS_SA) + m, F.lane);
                if (m + NGW < M) rms_row_regs(vb, INP(1) + (size_t)(l + 1) * DM, (bf16*)(ws + WS_XN) + (size_t)m2 * PK, (unsigned*)(ws + WS_XN8 + (size_t)m2 * P8), (float*)(ws + WS_SA) + m2, F.lane); }
            if (rep == REP_NRM - 1) SEAM(pb + 6);
        }
    }
#undef IN
#undef SEAM
#undef PHASE_ENTER
#undef INP
}

extern "C" void kernel_launch(void* const* d_in, const int* in_sizes, int n_in, void* d_out, int out_size, void* d_ws, size_t ws_size, hipStream_t stream) {
    static int grid = 0;
    if (grid == 0) {
        if (n_in != 12 || in_sizes[0] != M * DM || out_size != M * DM || ws_size < WS_END) { fprintf(stderr, "kernel_launch: shape/workspace mismatch (n_in %d, in0 %d, out %d, ws %zu, need %zu)\n", n_in, n_in > 0 ? in_sizes[0] : -1, out_size, ws_size, (size_t)WS_END); grid = -1; return; }
        int dev = 0, cus = 0, per_cu = 0;
        if (hipGetDevice(&dev) != hipSuccess || hipDeviceGetAttribute(&cus, hipDeviceAttributeMultiprocessorCount, dev) != hipSuccess) { grid = -1; return; }
        if (hipFuncSetAttribute((const void*)mega_fwd, hipFuncAttributeMaxDynamicSharedMemorySize, LDS_BYTES) != hipSuccess) { fprintf(stderr, "kernel_launch: hipFuncSetAttribute failed\n"); grid = -1; return; }
        if (hipOccupancyMaxActiveBlocksPerMultiprocessor(&per_cu, (const void*)mega_fwd, NWAVES * 64, LDS_BYTES) != hipSuccess || per_cu < 1)
            fprintf(stderr, "kernel_launch: note: occupancy query reports %d workgroups per CU\n", per_cu);
        (void)hipGetLastError();
        grid = cus;
    }
    if (grid < 0) return;
    if (hipMemsetAsync((char*)d_ws + WS_CTL, 0, CTL_ZERO_BYTES, stream) != hipSuccess) { fprintf(stderr, "kernel_launch: hipMemsetAsync failed\n"); return; }
    Args a{};
    for (int i = 0; i < 12; ++i) a.in[i] = (const float*)d_in[i];
    a.out = (float*)d_out; a.ws = (unsigned char*)d_ws;
    if (ONE_LAUNCH) {
        a.ph_lo = 0; a.ph_hi = NPH;
        hipLaunchKernelGGL(mega_fwd, dim3(grid), dim3(NWAVES * 64), LDS_BYTES, stream, a);
    } else {
        for (int p = 0; p < NPH; ++p) { a.ph_lo = p; a.ph_hi = p + 1; hipLaunchKernelGGL(mega_fwd, dim3(grid), dim3(NWAVES * 64), LDS_BYTES, stream, a); }
    }
    const hipError_t le = hipPeekAtLastError();
    if (le != hipSuccess) fprintf(stderr, "kernel_launch: launch failed: %s\n", hipGetErrorName(le));
}
```

```cpp
#include <hip/hip_runtime.h>
#include <cstdio>
#include <cstdint>
__device__ __forceinline__ int fresh_tid(int wave) { unsigned m = ~0u; asm volatile("" : "+s"(m)); return wave * 64 + (int)__builtin_amdgcn_mbcnt_hi(m, __builtin_amdgcn_mbcnt_lo(m, 0u)); }
namespace pg8 {
#define PG8_LAS __attribute__((address_space(3)))
typedef unsigned short bf16_t;
typedef short bf16x8 __attribute__((ext_vector_type(8)));
typedef float f32x4 __attribute__((ext_vector_type(4)));
typedef unsigned u32x4 __attribute__((ext_vector_type(4)));
constexpr int BM = 256, BK = 64, HALF = 128, HTB = HALF * BK * 2  , STAGE_BYTES = 8 * HTB, NXCD = 8, WGM = 8;

__host__ __device__ __forceinline__ int lds_byte(int r, int c) { const int st = (r >> 4) * 2 + (c >> 5), rr = r & 15, cc = c & 31, ob = rr * 64 + cc * 2; return st * 1024 + (ob ^ (((ob >> 9) & 1) << 5)); }
__host__ __device__ __forceinline__ void stage_rc(int b, int& R, int& C) { const int st = b / 1024, sb = b % 1024, swz = sb ^ (((sb >> 9) & 1) << 5); R = (st >> 1) * 16 + swz / 64; C = (st & 1) * 32 + (swz % 64) / 2; }
__host__ __device__ __forceinline__ int perm32(int rho) { const int n = rho >> 4, i = rho & 15; return 8 * (i >> 2) + 4 * n + (i & 3); }

struct Unit { int pm, pn, seg; };
struct Gemm { const bf16_t* A; const bf16_t* Bt; int M, N, K, P;
    __device__ __forceinline__ int pitch() const { return P; }
    __device__ __forceinline__ int ntiles(const Unit&) const { return K / BK; }
    __device__ __forceinline__ const char* a_base(const Unit& u, size_t tstep) const { return (const char*)A + (size_t)u.pm * tstep; }
    __device__ __forceinline__ const char* b_base(const Unit& u, size_t tstep) const { return (const char*)Bt + (size_t)u.pn * tstep; }
};
__host__ __device__ __forceinline__ int map16(int j) { return j + 26; }
__host__ __device__ __forceinline__ int map8(int j) { return j < 26 ? j : j + 16; }
constexpr int NT16 = 16, NT8 = 110;
struct GemmMap16 { const bf16_t* A; const bf16_t* Bt; int K, P;
    __device__ __forceinline__ int pitch() const { return P; }
    __device__ __forceinline__ int ntiles(const Unit&) const { return K / BK; }
    __device__ __forceinline__ const char* a_base(const Unit& u, size_t tstep) const { return (const char*)A + (size_t)u.pm * tstep; }
    __device__ __forceinline__ const char* b_base(const Unit& u, size_t tstep) const { return (const char*)Bt + (size_t)map16(u.pn) * tstep; }
};
struct ChainGemm { const bf16_t* A0; const bf16_t* B0; size_t a_stride, b_stride; int P, K, rot;
    __device__ __forceinline__ int branch(const Unit& u) const { return (u.seg + 3 * rot) & 3; }
    __device__ __forceinline__ int pitch() const { return P; }
    __device__ __forceinline__ int ntiles(const Unit& u) const { return (branch(u) == 3) ? (K / BK) / 2 : K / BK; }
    __device__ __forceinline__ const char* a_base(const Unit& u, size_t tstep) const { return (const char*)(A0 + (size_t)branch(u) * a_stride) + (size_t)u.pm * tstep; }
    __device__ __forceinline__ const char* b_base(const Unit& u, size_t tstep) const { return (const char*)(B0 + (size_t)branch(u) * b_stride) + (size_t)u.pn * tstep; }
};

struct StaticOrder {
    int nM, nN, nwg, G, c;
    __host__ __device__ void init(int M, int N, int G_, int c_) { nM = M / BM; nN = N / BM; nwg = nM * nN; G = G_; c = c_; }
    __host__ __device__ bool next(int i, Unit& u) const {
        const long L = (long)i * G + c; if (L >= nwg) return false;
        int wgid = (int)L; { const int q = nwg / NXCD, r = nwg % NXCD, xcd = wgid % NXCD, off = wgid / NXCD; wgid = (xcd < r ? xcd * (q + 1) : r * (q + 1) + (xcd - r) * q) + off; }
        const int nig = WGM * nN, gid = wgid / nig, fm = gid * WGM, gsz = (nM - fm) < WGM ? (nM - fm) : WGM;
        u.pm = fm + ((wgid % nig) % gsz); u.pn = (wgid % nig) / gsz; u.seg = 0; return true;
    }
    __device__ __forceinline__ void a_ready(const Unit&) const {}
    __device__ __forceinline__ void done(const Unit&) const {}
};
struct ChainOrder { StaticOrder T;
    __device__ __forceinline__ bool next(int i, Unit& u) const { if (!T.next(i >> 2, u)) return false; u.seg = i & 3; return true; }
    __device__ __forceinline__ void a_ready(const Unit&) const {}
    __device__ __forceinline__ void done(const Unit&) const {}
};

__device__ __forceinline__ unsigned cvt_pk_bf16(float lo, float hi) { unsigned r; asm volatile("v_cvt_pk_bf16_f32 %0, %1, %2" : "=v"(r) : "v"(lo), "v"(hi)); return r; }
typedef float f32x2 __attribute__((ext_vector_type(2)));
typedef int i32x4 __attribute__((ext_vector_type(4)));
template <bool I8> struct AccT { typedef f32x4 type; };
template <> struct AccT<true> { typedef i32x4 type; };
template <bool I8> __device__ __forceinline__ typename AccT<I8>::type mma1(bf16x8 b, bf16x8 a, typename AccT<I8>::type c) {
    if constexpr (I8) return __builtin_amdgcn_mfma_i32_16x16x64_i8(__builtin_bit_cast(i32x4, b), __builtin_bit_cast(i32x4, a), c, 0, 0, 0);
    else return __builtin_amdgcn_mfma_f32_16x16x32_bf16(b, a, c, 0, 0, 0);
}
__device__ __forceinline__ float sigmoid_fast(float v) { return __builtin_amdgcn_rcpf(1.0f + __builtin_amdgcn_exp2f(-1.4426950408889634f * v)); }
__device__ __forceinline__ float bf_lo(unsigned w) { return __builtin_bit_cast(float, w << 16); }
__device__ __forceinline__ float bf_hi(unsigned w) { return __builtin_bit_cast(float, w & 0xffff0000u); }
template <bool I8> struct EpiProjT {
    static constexpr bool PERM = true, AFTER_DRAIN = false;
    bf16_t* O; int ldc; const float* qk_gain  ; PG8_LAS float* xtab  ; float qscale; const float* sa; const float* sb;
    __device__ __forceinline__ bool resets(const Unit&) const { return true; }
    __device__ __forceinline__ void operator()(const typename AccT<I8>::type (&acc)[2][2][4][2], const Unit& u, int wr, int wc, int fr, int fq) const {
        const int pn = I8 ? map8(u.pn) : map16(u.pn);
        int kind, br = 0, isk = 0;
        if (pn >= 62) kind = 2;
        else if ((pn >= 12 && pn < 16) || (pn >= 22 && pn < 26) || (pn >= 38 && pn < 42) || pn >= 60) kind = 1;
        else if (pn < 8) { kind = 3; br = 0; isk = pn >= 4; }
        else if (pn >= 16 && pn < 21) { kind = 3; br = 1; isk = pn >= 20; }
        else if (pn >= 26 && pn < 34) { kind = 3; br = 2; isk = pn >= 30; }
        else if (pn >= 42 && pn < 54) { kind = 3; br = 3; isk = pn >= 48; }
        else kind = 0;
        const int row0 = u.pm * BM + wr * 64 + fr, cc0 = wc * 32 + 8 * fq, col0 = pn * BM + cc0;
        f32x4 sbv[2][2];
        if (I8) {
#pragma unroll
            for (int bj = 0; bj < 2; ++bj)
#pragma unroll
                for (int n = 0; n < 2; ++n) sbv[bj][n] = *(const f32x4*)(sb + u.pn * BM + cc0 + bj * HALF + 4 * n);
        }
        float sarr[2][4];
#pragma unroll
        for (int ai = 0; ai < 2; ++ai)
#pragma unroll
            for (int m = 0; m < 4; ++m) sarr[ai][m] = I8 ? sa[row0 + ai * HALF + m * 16] : 1.0f;
        if (I8) asm volatile("" ::: "memory");
#define EPV(ai, bj, m, n, sar) (I8 ? (f32x4){(float)acc[ai][bj][m][n][0], (float)acc[ai][bj][m][n][1], (float)acc[ai][bj][m][n][2], (float)acc[ai][bj][m][n][3]} * (sar) * sbv[bj][n] \
                                   : (f32x4){(float)acc[ai][bj][m][n][0], (float)acc[ai][bj][m][n][1], (float)acc[ai][bj][m][n][2], (float)acc[ai][bj][m][n][3]})
        if (kind != 3) {
#pragma unroll
            for (int ai = 0; ai < 2; ++ai)
#pragma unroll
                for (int m = 0; m < 4; ++m) { const int row = row0 + ai * HALF + m * 16; bf16_t* rowp = O + (size_t)row * ldc + col0; const float sar = sarr[ai][m];
#pragma unroll
                    for (int bj = 0; bj < 2; ++bj) { f32x4 v0 = EPV(ai, bj, m, 0, sar), v1 = EPV(ai, bj, m, 1, sar);
                        if (kind == 1) {
#pragma unroll
                            for (int e = 0; e < 4; ++e) { v0[e] *= sigmoid_fast(v0[e]); v1[e] *= sigmoid_fast(v1[e]); }
                        } else if (kind == 2) {
#pragma unroll
                            for (int e = 0; e < 4; ++e) { v0[e] = fminf(__builtin_amdgcn_exp2f(-1.4426950408889634f * v0[e]), 1e18f); v1[e] = fminf(__builtin_amdgcn_exp2f(-1.4426950408889634f * v1[e]), 1e18f); }
                        }
                        u32x4 w; w.x = cvt_pk_bf16(v0[0], v0[1]); w.y = cvt_pk_bf16(v0[2], v0[3]); w.z = cvt_pk_bf16(v1[0], v1[1]); w.w = cvt_pk_bf16(v1[2], v1[3]);
                        *(u32x4*)(rowp + bj * HALF) = w; } }
            return;
        }
#pragma unroll
        for (int ai = 0; ai < 2; ++ai)
#pragma unroll
            for (int m = 0; m < 4; ++m) { const float sar = sarr[ai][m];
#pragma unroll
                for (int bj = 0; bj < 2; ++bj) { const f32x4 a = EPV(ai, bj, m, 0, sar), b = EPV(ai, bj, m, 1, sar);
                    float s = (a[0] * a[0] + a[1] * a[1]) + (a[2] * a[2] + a[3] * a[3]) + (b[0] * b[0] + b[1] * b[1]) + (b[2] * b[2] + b[3] * b[3]);
                    s += __builtin_bit_cast(float, __builtin_amdgcn_ds_bpermute(((fq * 16 + fr) ^ 16) << 2, __builtin_bit_cast(int, s)));
                    s += __builtin_bit_cast(float, __builtin_amdgcn_ds_bpermute(((fq * 16 + fr) ^ 32) << 2, __builtin_bit_cast(int, s)));
                    if (fq == 0) xtab[((ai * HALF + wr * 64 + m * 16 + fr) * 2 + bj) * 4 + wc] = s; } }
        asm volatile("s_waitcnt lgkmcnt(0)" ::: "memory"); __builtin_amdgcn_s_barrier(); asm volatile("" ::: "memory");
        const float* gp = qk_gain + (br * 2 + isk) * 128 + cc0;
        const f32x4 ga = *(const f32x4*)gp, gb = *(const f32x4*)(gp + 4);
        const float sc = isk ? 1.0f : qscale;
        float invf[4];
#pragma unroll
        for (int i = 0; i < 4; ++i) invf[i] = __builtin_amdgcn_exp2f(-(float)(((cc0 >> 1) + i) & 31) * (13.287712379549449f / 32.f));
#pragma unroll
        for (int ai = 0; ai < 2; ++ai)
#pragma unroll
            for (int m = 0; m < 4; ++m) { const int rl = ai * HALF + wr * 64 + m * 16 + fr; const int row = u.pm * BM + rl;
                bf16_t* rowp = O + (size_t)row * ldc + col0; const float sar = sarr[ai][m];
                const int spos = row & 4095; const float fpos = (wc < 2) ? (float)(spos >> 6) : (float)(spos & 63);
#pragma unroll
                for (int bj = 0; bj < 2; ++bj) { const f32x4 t = *(const PG8_LAS f32x4*)(xtab + (rl * 2 + bj) * 4);
                    const float rstd = sc / sqrtf(((t[0] + t[1]) + (t[2] + t[3])) * (1.0f / 128.0f) + 1e-6f);
                    f32x4 v0 = EPV(ai, bj, m, 0, sar) * rstd * ga, v1 = EPV(ai, bj, m, 1, sar) * rstd * gb;
                    if (br == 1) {
                        float x[8] = {v0[0], v0[1], v0[2], v0[3], v1[0], v1[1], v1[2], v1[3]};
#pragma unroll
                        for (int i = 0; i < 4; ++i) { const float rev = __builtin_amdgcn_fractf(fpos * invf[i] * 0.15915494309189535f);
                            const float sn = __builtin_amdgcn_sinf(rev), cs = __builtin_amdgcn_cosf(rev);
                            const float x1 = x[2 * i], x2 = x[2 * i + 1]; x[2 * i] = x1 * cs - x2 * sn; x[2 * i + 1] = x1 * sn + x2 * cs; }
                        v0 = (f32x4){x[0], x[1], x[2], x[3]}; v1 = (f32x4){x[4], x[5], x[6], x[7]};
                    }
                    u32x4 w; w.x = cvt_pk_bf16(v0[0], v0[1]); w.y = cvt_pk_bf16(v0[2], v0[3]); w.z = cvt_pk_bf16(v1[0], v1[1]); w.w = cvt_pk_bf16(v1[2], v1[3]);
                    *(u32x4*)(rowp + bj * HALF) = w; } }
#undef EPV
    }
};
struct EpiChain {
    static constexpr bool PERM = true, AFTER_DRAIN = false;
    const bf16_t* G; int ldg; bf16_t* Mg; int ldm; int rot;
    __device__ __forceinline__ bool resets(const Unit& u) const { return u.seg == 3; }
    __device__ __forceinline__ void operator()(f32x4 (&acc)[2][2][4][2], const Unit& u, int wr, int wc, int fr, int fq) const {
        const int row0 = u.pm * BM + wr * 64 + fr, col0 = u.pn * BM + wc * 32 + 8 * fq, seg = u.seg;
        const int bcur = (seg + 3 * rot) & 3, bnxt = (seg + 1 + 3 * rot) & 3;
        const bf16_t* Gs = G + (size_t)bcur * 4096;
        const bool lastseg = seg == 3;
        const int nxo = lastseg ? 0 : (bnxt - bcur) * 4096;
#pragma unroll
        for (int ai = 0; ai < 2; ++ai) {
            u32x4 gw[4][2], nw[4][2];
#pragma unroll
            for (int m = 0; m < 4; ++m) { const size_t row = (size_t)(row0 + ai * HALF + m * 16);
#pragma unroll
                for (int bj = 0; bj < 2; ++bj) { gw[m][bj] = *(const u32x4*)(Gs + row * ldg + col0 + bj * HALF); nw[m][bj] = *(const u32x4*)(Gs + nxo + row * ldg + col0 + bj * HALF); } }
            asm volatile("" ::: "memory");
#pragma unroll
            for (int m = 0; m < 4; ++m) { const size_t row = (size_t)(row0 + ai * HALF + m * 16);
#pragma unroll
                for (int bj = 0; bj < 2; ++bj) { const u32x4 g = gw[m][bj], q = nw[m][bj];
                    float f[8] = {bf_lo(g.x), bf_hi(g.x), bf_lo(g.y), bf_hi(g.y), bf_lo(g.z), bf_hi(g.z), bf_lo(g.w), bf_hi(g.w)};
                    const float d[8] = {bf_lo(q.x), bf_hi(q.x), bf_lo(q.y), bf_hi(q.y), bf_lo(q.z), bf_hi(q.z), bf_lo(q.w), bf_hi(q.w)};
#pragma unroll
                    for (int e = 0; e < 8; ++e) { const float r = __builtin_amdgcn_rcpf(1.0f + f[e]); f[e] = lastseg ? r : (1.0f + d[e]) * r; }
                    f32x4 v0 = acc[ai][bj][m][0], v1 = acc[ai][bj][m][1];
                    v0[0] *= f[0]; v0[1] *= f[1]; v0[2] *= f[2]; v0[3] *= f[3]; v1[0] *= f[4]; v1[1] *= f[5]; v1[2] *= f[6]; v1[3] *= f[7];
                    acc[ai][bj][m][0] = v0; acc[ai][bj][m][1] = v1;
                    if (lastseg) { u32x4 w; w.x = cvt_pk_bf16(v0[0], v0[1]); w.y = cvt_pk_bf16(v0[2], v0[3]); w.z = cvt_pk_bf16(v1[0], v1[1]); w.w = cvt_pk_bf16(v1[2], v1[3]);
                        *(u32x4*)(Mg + row * ldm + col0 + bj * HALF) = w; } } }
            asm volatile("" ::: "memory");
        }
    }
};
struct EpiRes {
    static constexpr bool PERM = false, AFTER_DRAIN = false;
    const float* base; float* out; int ldc;
    __device__ __forceinline__ bool resets(const Unit&) const { return true; }
    __device__ __forceinline__ void operator()(const f32x4 (&acc)[2][2][4][2], const Unit& u, int wr, int wc, int fr, int fq) const {
        const int col0 = u.pn * BM + wc * 32 + 4 * fq;
#pragma unroll
        for (int ai = 0; ai < 2; ++ai) {
            f32x4 pre[4][2][2];
#pragma unroll
            for (int m = 0; m < 4; ++m) { const size_t off = (size_t)(u.pm * BM + ai * HALF + wr * 64 + m * 16 + fr) * ldc + col0;
#pragma unroll
                for (int bj = 0; bj < 2; ++bj)
#pragma unroll
                    for (int n = 0; n < 2; ++n) pre[m][bj][n] = *(const f32x4*)(base + off + bj * HALF + n * 16); }
            asm volatile("" ::: "memory");
#pragma unroll
            for (int m = 0; m < 4; ++m) { const size_t off = (size_t)(u.pm * BM + ai * HALF + wr * 64 + m * 16 + fr) * ldc + col0;
#pragma unroll
                for (int bj = 0; bj < 2; ++bj)
#pragma unroll
                    for (int n = 0; n < 2; ++n) *(f32x4*)(out + off + bj * HALF + n * 16) = pre[m][bj][n] + acc[ai][bj][m][n]; }
            asm volatile("" ::: "memory");
        }
    }
};
struct EpiRes8 {
    static constexpr bool PERM = false, AFTER_DRAIN = false;
    const float* base; float* out; int ldc; const float* sm; const float* so;
    __device__ __forceinline__ bool resets(const Unit&) const { return true; }
    __device__ __forceinline__ void operator()(const i32x4 (&acc)[2][2][4][2], const Unit& u, int wr, int wc, int fr, int fq) const {
        const int col0 = u.pn * BM + wc * 32 + 4 * fq;
        f32x4 sov[2][2];
#pragma unroll
        for (int bj = 0; bj < 2; ++bj)
#pragma unroll
            for (int n = 0; n < 2; ++n) sov[bj][n] = *(const f32x4*)(so + col0 + bj * HALF + n * 16);
#pragma unroll
        for (int ai = 0; ai < 2; ++ai) {
            f32x4 pre[4][2][2]; float smr[4];
#pragma unroll
            for (int m = 0; m < 4; ++m) { const int row = u.pm * BM + ai * HALF + wr * 64 + m * 16 + fr; const size_t off = (size_t)row * ldc + col0; smr[m] = sm[row];
#pragma unroll
                for (int bj = 0; bj < 2; ++bj)
#pragma unroll
                    for (int n = 0; n < 2; ++n) pre[m][bj][n] = *(const f32x4*)(base + off + bj * HALF + n * 16); }
            asm volatile("" ::: "memory");
#pragma unroll
            for (int m = 0; m < 4; ++m) { const size_t off = (size_t)(u.pm * BM + ai * HALF + wr * 64 + m * 16 + fr) * ldc + col0;
#pragma unroll
                for (int bj = 0; bj < 2; ++bj)
#pragma unroll
                    for (int n = 0; n < 2; ++n) { const i32x4 a = acc[ai][bj][m][n]; f32x4 v; v[0] = (float)a[0]; v[1] = (float)a[1]; v[2] = (float)a[2]; v[3] = (float)a[3];
                        *(f32x4*)(out + off + bj * HALF + n * 16) = pre[m][bj][n] + v * smr[m] * sov[bj][n]; } }
            asm volatile("" ::: "memory");
        }
    }
};

template <class Epi, class Sched, bool ALIGN_EPI = false, bool SP2 = false, class GemmT = Gemm, bool I8 = false>
__device__ __forceinline__ void gemm_phase(PG8_LAS unsigned char* lds, const GemmT g, const Sched& S, const Epi& E, const int wave_in) {
    int tid_ = fresh_tid(wave_in); asm volatile("" : "+v"(tid_));
    const int tid = tid_, wid = __builtin_amdgcn_readfirstlane(tid >> 6), lane = tid & 63, wr = wid >> 2, wc = wid & 3, fr = lane & 15, fq = lane >> 4;
    const int K = g.pitch();
    unsigned voffA[2], voffB[2];
#pragma unroll
    for (int i = 0; i < 2; ++i) { int R, C; stage_rc(tid * 16 + i * 8192, R, C); const int Rb = Epi::PERM ? ((R & ~31) + perm32(R & 31)) : R;
        voffA[i] = (unsigned)(R * K + C) * 2u; voffB[i] = (unsigned)(Rb * K + C) * 2u; }
    const size_t kstep = (size_t)(BK * 2);
    const size_t hstep = (size_t)HALF * K * 2;
    const size_t tstep = 2 * hstep;
    const unsigned ldsw = (unsigned)wid * 1024u;
    const int aoff = lds_byte(wr * 64 + fr, fq * 8), boff = lds_byte(wc * 32 + fr, fq * 8);
#define PG8_SA(b, h) (((b) * 2 + (h)) * HTB)
#define PG8_SB(b, h) ((4 + (b) * 2 + (h)) * HTB)
#define PG8_STAGE(bufoff, gbase, voff) do { _Pragma("unroll") for (int _i = 0; _i < 2; ++_i) \
        __builtin_amdgcn_global_load_lds((const unsigned*)((const char*)(gbase) + (voff)[_i]), (PG8_LAS unsigned*)(lds + (bufoff) + ldsw + _i * 8192), 16, 0, 0); } while (0)
#define PG8_LDA(dst, b, h) do { _Pragma("unroll") for (int m = 0; m < 4; ++m) _Pragma("unroll") for (int k = 0; k < 2; ++k) dst[m][k] = *(const PG8_LAS bf16x8*)(lds + PG8_SA(b, h) + aoff + m * 2048 + k * 1024); } while (0)
#define PG8_LDB(dst, b, h) do { _Pragma("unroll") for (int n = 0; n < 2; ++n) _Pragma("unroll") for (int k = 0; k < 2; ++k) dst[n][k] = *(const PG8_LAS bf16x8*)(lds + PG8_SB(b, h) + boff + n * 2048 + k * 1024); } while (0)
#define PG8_MMA(ai, bj, At, Bt) do { __builtin_amdgcn_s_setprio(1); _Pragma("unroll") for (int m = 0; m < 4; ++m) _Pragma("unroll") for (int n = 0; n < 2; ++n) _Pragma("unroll") for (int k = 0; k < 2; ++k) \
        acc[ai][bj][m][n] = mma1<I8>(Bt[n][k], At[m][k], acc[ai][bj][m][n]); __builtin_amdgcn_s_setprio(0); } while (0)
#define PG8_WAIT_V(n) asm volatile("s_waitcnt vmcnt(" #n ")" ::: "memory")
#define PG8_WAIT_L(n) asm volatile("s_waitcnt lgkmcnt(" #n ")" ::: "memory")
#define PG8_BAR __builtin_amdgcn_s_barrier()
#define PG8_SCHED __builtin_amdgcn_sched_barrier(0)
    Unit cur, nxt; int ui = 0;
    if (!S.next(0, cur)) return;
    int nt = g.ntiles(cur);
    typedef typename AccT<I8>::type acc_t;
    acc_t acc[2][2][4][2];
#pragma unroll
    for (int a = 0; a < 2; ++a)
#pragma unroll
        for (int b = 0; b < 2; ++b)
#pragma unroll
            for (int m = 0; m < 4; ++m)
#pragma unroll
                for (int n = 0; n < 2; ++n) acc[a][b][m][n] = acc_t{};
    bf16x8 At[4][2], B0[2][2], B1[2][2];
    const char* cA = g.a_base(cur, tstep); const char* cB = g.b_base(cur, tstep);
    S.a_ready(cur);
    if constexpr (SP2) {
        PG8_STAGE(PG8_SB(0, 0), cB, voffB); PG8_STAGE(PG8_SB(0, 1), cB + hstep, voffB); PG8_STAGE(PG8_SA(0, 0), cA, voffA); PG8_STAGE(PG8_SA(0, 1), cA + hstep, voffA);
        if (wr == 1) PG8_BAR;
        PG8_WAIT_V(2); PG8_BAR;
        PG8_STAGE(PG8_SB(1, 0), cB + kstep, voffB); PG8_STAGE(PG8_SA(1, 0), cA + kstep, voffA); PG8_STAGE(PG8_SB(1, 1), cB + hstep + kstep, voffB);
        PG8_WAIT_V(6); PG8_BAR;
    } else {
        PG8_STAGE(PG8_SB(0, 0), cB, voffB); PG8_STAGE(PG8_SA(0, 0), cA, voffA); PG8_STAGE(PG8_SB(0, 1), cB + hstep, voffB); PG8_STAGE(PG8_SA(0, 1), cA + hstep, voffA);
        if (wr == 1) PG8_BAR;
        PG8_WAIT_V(4); PG8_BAR;
        PG8_STAGE(PG8_SB(1, 0), cB + kstep, voffB); PG8_STAGE(PG8_SA(1, 0), cA + kstep, voffA); PG8_STAGE(PG8_SB(1, 1), cB + hstep + kstep, voffB);
        PG8_WAIT_V(6); PG8_BAR;
    }
    for (;;) {
        const bool has_next = S.next(ui + 1, nxt);
        const char* nA = has_next ? g.a_base(nxt, tstep) : cA; const char* nB = has_next ? g.b_base(nxt, tstep) : cB;
        for (int t = 0; t < nt; t += 2) {
            const bool last = (t == nt - 2);
            const char* a1 = cA + (size_t)(t + 1) * kstep;
            const char* a2 = last ? nA : cA + (size_t)(t + 2) * kstep; const char* b2 = last ? nB : cB + (size_t)(t + 2) * kstep;
            const char* a3 = a2 + kstep; const char* b3 = b2 + kstep;
            if (last && has_next) S.a_ready(nxt);
            if constexpr (SP2) {
            PG8_LDB(B0, 0, 0); PG8_LDB(B1, 0, 1); PG8_SCHED; PG8_LDA(At, 0, 0); PG8_STAGE(PG8_SA(1, 1), a1 + hstep, voffA);
            PG8_WAIT_V(8); PG8_WAIT_L(0); PG8_BAR; PG8_MMA(0, 0, At, B0); PG8_MMA(0, 1, At, B1); PG8_BAR; PG8_SCHED;
            PG8_LDA(At, 0, 1); PG8_STAGE(PG8_SB(0, 0), b2, voffB); PG8_STAGE(PG8_SB(0, 1), b2 + hstep, voffB); PG8_STAGE(PG8_SA(0, 0), a2, voffA);
            PG8_WAIT_V(8); PG8_WAIT_L(0); PG8_BAR; PG8_MMA(1, 0, At, B0); PG8_MMA(1, 1, At, B1); PG8_BAR; PG8_SCHED;
            PG8_LDB(B0, 1, 0); PG8_LDB(B1, 1, 1); PG8_SCHED; PG8_LDA(At, 1, 0); PG8_STAGE(PG8_SA(0, 1), a2 + hstep, voffA);
            PG8_WAIT_V(8); PG8_WAIT_L(0); PG8_BAR; PG8_MMA(0, 0, At, B0); PG8_MMA(0, 1, At, B1); PG8_BAR; PG8_SCHED;
            PG8_LDA(At, 1, 1); PG8_STAGE(PG8_SB(1, 0), b3, voffB); PG8_STAGE(PG8_SB(1, 1), b3 + hstep, voffB); PG8_STAGE(PG8_SA(1, 0), a3, voffA);
            PG8_WAIT_V(8); PG8_WAIT_L(0); PG8_BAR; PG8_MMA(1, 0, At, B0); PG8_MMA(1, 1, At, B1); PG8_BAR; PG8_SCHED;
            } else {
            PG8_LDB(B0, 0, 0); PG8_SCHED; PG8_LDA(At, 0, 0); PG8_STAGE(PG8_SA(1, 1), a1 + hstep, voffA);
            PG8_WAIT_L(8); PG8_BAR; PG8_WAIT_L(0); PG8_MMA(0, 0, At, B0); PG8_BAR; PG8_SCHED;
            PG8_LDB(B1, 0, 1); PG8_STAGE(PG8_SB(0, 0), b2, voffB);
            PG8_BAR; PG8_WAIT_L(0); PG8_MMA(0, 1, At, B1); PG8_BAR;
            PG8_LDA(At, 0, 1); PG8_STAGE(PG8_SA(0, 0), a2, voffA);
            PG8_BAR; PG8_WAIT_L(0); PG8_MMA(1, 0, At, B0); PG8_BAR; PG8_SCHED;
            PG8_STAGE(PG8_SB(0, 1), b2 + hstep, voffB);
            PG8_WAIT_V(6); PG8_BAR; PG8_MMA(1, 1, At, B1); PG8_BAR;
            PG8_LDB(B0, 1, 0); PG8_SCHED; PG8_LDA(At, 1, 0); PG8_STAGE(PG8_SA(0, 1), a2 + hstep, voffA);
            PG8_WAIT_L(8); PG8_BAR; PG8_WAIT_L(0); PG8_MMA(0, 0, At, B0); PG8_BAR; PG8_SCHED;
            PG8_LDB(B1, 1, 1); PG8_STAGE(PG8_SB(1, 0), b3, voffB);
            PG8_BAR; PG8_WAIT_L(0); PG8_MMA(0, 1, At, B1); PG8_BAR;
            PG8_LDA(At, 1, 1); PG8_STAGE(PG8_SA(1, 0), a3, voffA);
            PG8_BAR; PG8_WAIT_L(0); PG8_MMA(1, 0, At, B0); PG8_BAR; PG8_SCHED;
            PG8_STAGE(PG8_SB(1, 1), b3 + hstep, voffB);
            PG8_WAIT_V(6); PG8_BAR; PG8_MMA(1, 1, At, B1); PG8_BAR;
            }
        }
        if constexpr (ALIGN_EPI) { if (wr == 0) PG8_BAR; }
        if constexpr (!Epi::AFTER_DRAIN) { E(acc, cur, wr, wc, fr, fq); S.done(cur); }
        if (!has_next) break;
        if (E.resets(cur)) {
#pragma unroll
        for (int a = 0; a < 2; ++a)
#pragma unroll
            for (int b = 0; b < 2; ++b)
#pragma unroll
                for (int m = 0; m < 4; ++m)
#pragma unroll
                    for (int n = 0; n < 2; ++n) acc[a][b][m][n] = acc_t{};
        }
        cur = nxt; cA = nA; cB = nB; ++ui; nt = g.ntiles(cur);
        if constexpr (ALIGN_EPI) { if (wr == 1) PG8_BAR; }
    }
    PG8_WAIT_V(0);
    if constexpr (!ALIGN_EPI) { if (wr == 0) PG8_BAR; }
    PG8_BAR;
    if constexpr (Epi::AFTER_DRAIN) { E.fused(acc, cur, wr, wc, fr, fq, lds, wid, lane); S.done(cur); }
#undef PG8_SA
#undef PG8_SB
#undef PG8_STAGE
#undef PG8_LDA
#undef PG8_LDB
#undef PG8_MMA
#undef PG8_WAIT_V
#undef PG8_WAIT_L
#undef PG8_BAR
#undef PG8_SCHED
}
}
namespace att {
typedef unsigned short bf16;
using bf16x8 = __attribute__((ext_vector_type(8))) short;
using s16x4  = __attribute__((ext_vector_type(4))) short;
using f32x16 = __attribute__((ext_vector_type(16))) float;
using u32x4  = __attribute__((ext_vector_type(4))) unsigned;
constexpr int D = 128, NW = 8, QBLK = 32, KVBLK = 64;
constexpr int SHM_V = KVBLK * D * 2, SHM_K = KVBLK * D * 2;
constexpr int OFF_WS = 2 * SHM_V + 2 * SHM_K, OFF_TBL = OFF_WS + NW * 64 * 4, SHM_ATTN = OFF_TBL + 4096;
constexpr float THR2 = 8.f;
constexpr float LOG2E = 1.4426950408889634f;
enum { M_NA = 0, M_DENSE = 1, M_ALIBI = 2, M_DIL = 3 };
#define KSWZ(row, colB) ((row) * 256 + ((colB) ^ (((row) & 7) << 4)))
#define SBAR() __builtin_amdgcn_sched_barrier(0)
__device__ __forceinline__ int crow(int r, int hi) { return (r & 3) + 8 * (r >> 2) + 4 * hi; }
__device__ __forceinline__ unsigned cvtpk(float lo, float hi) { unsigned r; asm volatile("v_cvt_pk_bf16_f32 %0, %1, %2" : "=v"(r) : "v"(lo), "v"(hi)); return r; }
__device__ __forceinline__ unsigned short f2bf1(float f) { unsigned u = __builtin_bit_cast(unsigned, f); return (unsigned short)((u + 0x7fffu + ((u >> 16) & 1u)) >> 16); }
__device__ __forceinline__ float bf2f(unsigned short h) { return __builtin_bit_cast(float, (unsigned)h << 16); }

__device__ __forceinline__ void partialSM(f32x16& p0, f32x16& p1, float& m_reg, float& mn, float& alpha) {
  float pmax = p0[0];
#pragma unroll
  for (int r = 1; r < 16; ++r) pmax = fmaxf(pmax, p0[r]);
#pragma unroll
  for (int r = 0; r < 16; ++r) pmax = fmaxf(pmax, p1[r]);
  { auto rr = __builtin_amdgcn_permlane32_swap(__float_as_uint(pmax), __float_as_uint(pmax), false, false);
    pmax = fmaxf(__uint_as_float(rr[0]), __uint_as_float(rr[1])); }
  if (__builtin_expect(__all(pmax - m_reg <= THR2), 1)) { mn = m_reg; alpha = 1.f; }
  else { mn = fmaxf(m_reg, pmax); alpha = __builtin_amdgcn_exp2f(m_reg - mn); m_reg = mn; }
#pragma unroll
  for (int r = 0; r < 16; ++r) p0[r] = p0[r] - mn;
#pragma unroll
  for (int r = 0; r < 16; ++r) p1[r] = p1[r] - mn;
#pragma unroll
  for (int r = 0; r < 16; ++r) p0[r] = __builtin_amdgcn_exp2f(p0[r]);
}
__device__ __forceinline__ void finishSM(f32x16& p0, f32x16& p1, float alpha, float& l_reg, bf16x8& pa0, bf16x8& pa1, bf16x8& pa2, bf16x8& pa3) {
#pragma unroll
  for (int r = 0; r < 16; ++r) p1[r] = __builtin_amdgcn_exp2f(p1[r]);
  float ps = 0;
#pragma unroll
  for (int r = 0; r < 16; ++r) ps += p0[r];
#pragma unroll
  for (int r = 0; r < 16; ++r) ps += p1[r];
  { auto rr = __builtin_amdgcn_permlane32_swap(__float_as_uint(ps), __float_as_uint(ps), false, false);
    ps = __uint_as_float(rr[0]) + __uint_as_float(rr[1]); }
  l_reg = l_reg * alpha + ps;
#define PK4(P, BASE, OUT) do { unsigned a0 = cvtpk(P[BASE + 0], P[BASE + 1]), a1 = cvtpk(P[BASE + 2], P[BASE + 3]);   \
    unsigned b0 = cvtpk(P[BASE + 4], P[BASE + 5]), b1 = cvtpk(P[BASE + 6], P[BASE + 7]);                              \
    auto r0 = __builtin_amdgcn_permlane32_swap(a0, b0, false, false); auto r1 = __builtin_amdgcn_permlane32_swap(a1, b1, false, false); \
    u32x4 w = {r0[0], r1[0], r0[1], r1[1]}; OUT = *reinterpret_cast<bf16x8*>(&w); } while (0)
  PK4(p0, 0, pa0); PK4(p0, 8, pa1); PK4(p1, 0, pa2); PK4(p1, 8, pa3);
#undef PK4
}
__device__ __forceinline__ void qkt(f32x16& p0, f32x16& p1, const bf16* Ks, const bf16x8* qr, int r32, int hi) {
  p0 = f32x16{}; p1 = f32x16{};
#pragma unroll
  for (int d0 = 0; d0 < 8; ++d0) { int cb = (d0 * 16 + hi * 8) * 2;
    bf16x8 b0 = *reinterpret_cast<const bf16x8*>((const char*)Ks + KSWZ(r32, cb));
    bf16x8 b1 = *reinterpret_cast<const bf16x8*>((const char*)Ks + KSWZ(32 + r32, cb));
    p0 = __builtin_amdgcn_mfma_f32_32x32x16_bf16(b0, qr[d0], p0, 0, 0, 0);
    p1 = __builtin_amdgcn_mfma_f32_32x32x16_bf16(b1, qr[d0], p1, 0, 0, 0); }
}
__device__ __forceinline__ int v_st(int k, int c) { const int kk = (k & ~0xC) | ((k & 4) << 1) | ((k & 8) >> 1); return ((kk >> 3) * 4 + (c >> 5)) * 512 + ((kk & 7) * 32 + (c & 31)) * 2; }
__device__ __forceinline__ int v_rd_base(int lane) { return ((lane & 3) << 3) | (((lane >> 2) & 3) << 6) | (((lane >> 4) & 1) << 5) | (((lane >> 5) & 1) << 8); }
constexpr int v_rd_off(int d0, int ks, int half) { return d0 * 512 + ks * 4096 + half * 2048; }
template <int OFF> __device__ __forceinline__ s16x4 tr_read(int vb) {
  s16x4 r; asm volatile("ds_read_b64_tr_b16 %0, %1 offset:%2" : "=&v"(r) : "v"(vb), "i"(OFF) : "memory"); return r;
}
template <int D0> __device__ __forceinline__ void pv_one(f32x16& od, int vb, bf16x8 pa0, bf16x8 pa1, bf16x8 pa2, bf16x8 pa3) {
  const s16x4 l0 = tr_read<v_rd_off(D0, 0, 0)>(vb), h0 = tr_read<v_rd_off(D0, 0, 1)>(vb), l1 = tr_read<v_rd_off(D0, 1, 0)>(vb), h1 = tr_read<v_rd_off(D0, 1, 1)>(vb);
  const s16x4 l2 = tr_read<v_rd_off(D0, 2, 0)>(vb), h2 = tr_read<v_rd_off(D0, 2, 1)>(vb), l3 = tr_read<v_rd_off(D0, 3, 0)>(vb), h3 = tr_read<v_rd_off(D0, 3, 1)>(vb);
  asm volatile("s_waitcnt lgkmcnt(0)" ::: "memory"); SBAR();
#define PK(L, H) (bf16x8){L[0], L[1], L[2], L[3], H[0], H[1], H[2], H[3]}
  od = __builtin_amdgcn_mfma_f32_32x32x16_bf16(pa0, PK(l0, h0), od, 0, 0, 0);
  od = __builtin_amdgcn_mfma_f32_32x32x16_bf16(pa1, PK(l1, h1), od, 0, 0, 0);
  od = __builtin_amdgcn_mfma_f32_32x32x16_bf16(pa2, PK(l2, h2), od, 0, 0, 0);
  od = __builtin_amdgcn_mfma_f32_32x32x16_bf16(pa3, PK(l3, h3), od, 0, 0, 0);
#undef PK
}
template <int D0> __device__ __forceinline__ void pv_one_lean(f32x16& od, int vb, bf16x8 pa0, bf16x8 pa1, bf16x8 pa2, bf16x8 pa3) {
#define PK(L, H) (bf16x8){L[0], L[1], L[2], L[3], H[0], H[1], H[2], H[3]}
  { const s16x4 l0 = tr_read<v_rd_off(D0, 0, 0)>(vb), h0 = tr_read<v_rd_off(D0, 0, 1)>(vb), l1 = tr_read<v_rd_off(D0, 1, 0)>(vb), h1 = tr_read<v_rd_off(D0, 1, 1)>(vb);
    asm volatile("s_waitcnt lgkmcnt(0)" ::: "memory"); SBAR();
    od = __builtin_amdgcn_mfma_f32_32x32x16_bf16(pa0, PK(l0, h0), od, 0, 0, 0);
    od = __builtin_amdgcn_mfma_f32_32x32x16_bf16(pa1, PK(l1, h1), od, 0, 0, 0); }
  { const s16x4 l2 = tr_read<v_rd_off(D0, 2, 0)>(vb), h2 = tr_read<v_rd_off(D0, 2, 1)>(vb), l3 = tr_read<v_rd_off(D0, 3, 0)>(vb), h3 = tr_read<v_rd_off(D0, 3, 1)>(vb);
    asm volatile("s_waitcnt lgkmcnt(0)" ::: "memory"); SBAR();
    od = __builtin_amdgcn_mfma_f32_32x32x16_bf16(pa2, PK(l2, h2), od, 0, 0, 0);
    od = __builtin_amdgcn_mfma_f32_32x32x16_bf16(pa3, PK(l3, h3), od, 0, 0, 0); }
#undef PK
}
__device__ __forceinline__ void pv_d0_lean(f32x16* o, int vb, bf16x8 pa0, bf16x8 pa1, bf16x8 pa2, bf16x8 pa3) {
  pv_one_lean<0>(o[0], vb, pa0, pa1, pa2, pa3); pv_one_lean<1>(o[1], vb, pa0, pa1, pa2, pa3); pv_one_lean<2>(o[2], vb, pa0, pa1, pa2, pa3); pv_one_lean<3>(o[3], vb, pa0, pa1, pa2, pa3);
}
__device__ __forceinline__ void pv_d0(f32x16* o, int vb, bf16x8 pa0, bf16x8 pa1, bf16x8 pa2, bf16x8 pa3) {
  pv_one<0>(o[0], vb, pa0, pa1, pa2, pa3); pv_one<1>(o[1], vb, pa0, pa1, pa2, pa3); pv_one<2>(o[2], vb, pa0, pa1, pa2, pa3); pv_one<3>(o[3], vb, pa0, pa1, pa2, pa3);
}

struct UA {
  const bf16* Q; long ldq;
  const bf16* K; const bf16* V; long ldk;
  int NT;
  int j0;
  int qk0;
  float slope2;
  int qrow0, krow0;
  const float* tbl;
  bf16* Y; long ldy; const bf16* Z; long ldz;
  float* O; long ldo;
  float* L; long ldl;
};

template <int MODE, int SDEPTH>
__device__ __forceinline__ void attn_unit(const UA& a, char* lds, const int wave_in) {
  int tid_ = fresh_tid(wave_in); asm volatile("" : "+v"(tid_));
  const int tid = tid_, wid = __builtin_amdgcn_readfirstlane(tid >> 6), lane = tid & 63, r32 = lane & 31, hi = lane >> 5;
  bf16* V_lds = (bf16*)lds; bf16* K_lds = (bf16*)(lds + 2 * SHM_V);
  float* ws = (float*)(lds + OFF_WS) + wid * 64; float* li_l = ws; float* al_l = ws + 32;
  float* tbl = (float*)(lds + OFF_TBL) + 64;
  if (MODE == M_NA) { __syncthreads(); for (int i = tid; i < 15 * 31; i += 512) tbl[i] = a.tbl[i] * LOG2E; }
  float m_reg = -1e30f, l_reg = 0; f32x16 o[4] = {}; bf16x8 qr[8];
  const bf16* Qw = a.Q + (long)(wid * QBLK + r32) * a.ldq + hi * 8;
#pragma unroll
  for (int d0 = 0; d0 < 8; ++d0) qr[d0] = *reinterpret_cast<const bf16x8*>(Qw + d0 * 16);
  const int sr = tid >> 4, sc = (tid & 15) * 8, vst0 = v_st(sr, sc), vst1 = v_st(32 + sr, sc);
  const int vb0 = (int)(uintptr_t)V_lds + v_rd_base(lane);
  const bf16* Kh = a.K; const bf16* Vh = a.V; const long LDK = a.ldk;
  struct { bf16x8 vs0, vs1, ks0, ks1; } sr_[SDEPTH];
#define SLOAD(i, k0) do { sr_[i].vs0 = *reinterpret_cast<const bf16x8*>(&Vh[(long)((k0) + sr) * LDK + sc]); sr_[i].vs1 = *reinterpret_cast<const bf16x8*>(&Vh[(long)((k0) + 32 + sr) * LDK + sc]); \
    sr_[i].ks0 = *reinterpret_cast<const bf16x8*>(&Kh[(long)((k0) + sr) * LDK + sc]); sr_[i].ks1 = *reinterpret_cast<const bf16x8*>(&Kh[(long)((k0) + 32 + sr) * LDK + sc]); } while (0)
#define SWRITE(b, i) do { *(bf16x8*)((char*)V_lds + (b) * SHM_V + vst0) = sr_[i].vs0;          \
    *(bf16x8*)((char*)V_lds + (b) * SHM_V + vst1) = sr_[i].vs1; int kc = sc * 2;               \
    *(bf16x8*)((char*)K_lds + (b) * SHM_K + KSWZ(sr, kc)) = sr_[i].ks0;                       \
    *(bf16x8*)((char*)K_lds + (b) * SHM_K + KSWZ(32 + sr, kc)) = sr_[i].ks1; } while (0)
#define SWAIT() do { if constexpr (SDEPTH == 2) asm volatile("s_waitcnt vmcnt(4)" ::: "memory"); else asm volatile("s_waitcnt vmcnt(0)" ::: "memory"); } while (0)
#define RESC(a_) do { if (__any((a_) < 1.f)) { if (hi == 0) al_l[r32] = (a_); asm volatile("s_waitcnt lgkmcnt(0)" ::: "memory"); \
    _Pragma("unroll") for (int d = 0; d < 4; ++d) _Pragma("unroll") for (int r = 0; r < 16; ++r) o[d][r] *= al_l[crow(r, hi)]; } } while (0)
  const float NEG_INF = -__builtin_inff();
  const int qkrel = a.qk0 + wid * 32 + r32 - 4 * hi;
  const float nslope = -a.slope2;
  const int qgr = a.qrow0 + (wid >> 1), cq = 32 * (wid & 1) + r32;
  const int c0 = min(max(cq - 8, 0), 48), r0 = min(max(qgr - 4, 0), 56);
#define MOD(P0, P1, J) do { \
    if (MODE == M_ALIBI || MODE == M_DIL) { const float rel = (float)(qkrel - (J) * 64); \
      _Pragma("unroll") for (int r = 0; r < 16; ++r) { const float cr = (float)((r & 3) + 8 * (r >> 2)); const float d0_ = fabsf(rel - cr), d1_ = fabsf(rel - cr - 32.f); \
        float v0_ = fmaf(nslope, d0_, P0[r]), v1_ = fmaf(nslope, d1_, P1[r]); \
        if (MODE == M_DIL) { v0_ = (d0_ <= 64.f) ? v0_ : NEG_INF; v1_ = (d1_ <= 64.f) ? v1_ : NEG_INF; } \
        P0[r] = v0_; P1[r] = v1_; } } \
    if (MODE == M_NA) { const int kr = a.krow0 + (J); const bool rv = (kr >= r0) && (kr < r0 + 8); \
      if (!rv) { _Pragma("unroll") for (int r = 0; r < 16; ++r) { P0[r] = NEG_INF; P1[r] = NEG_INF; } } \
      else { const float* tp = tbl + (kr - qgr + 7) * 31 + (4 * hi - cq + 15); const int kcb = 4 * hi - c0; \
        _Pragma("unroll") for (int r = 0; r < 16; ++r) { const int cr = (r & 3) + 8 * (r >> 2); \
          const bool ok0 = (unsigned)(kcb + cr) < 16u, ok1 = (unsigned)(kcb + cr + 32) < 16u; \
          const float b0_ = tp[cr], b1_ = tp[cr + 32]; \
          P0[r] = ok0 ? P0[r] + b0_ : NEG_INF; P1[r] = ok1 ? P1[r] + b1_ : NEG_INF; } } } \
  } while (0)
  f32x16 pA0, pA1, pB0, pB1; float mnA, mnB, alA, alB; bf16x8 pa0, pa1, pa2, pa3; const int NT = a.NT;
  constexpr int SE = 0, SO = SDEPTH - 1;
  SLOAD(SE, 0); asm volatile("s_waitcnt vmcnt(0)" ::: "memory"); SWRITE(0, SE); __syncthreads();
  qkt(pA0, pA1, K_lds, qr, r32, hi); MOD(pA0, pA1, 0); partialSM(pA0, pA1, m_reg, mnA, alA);
  SLOAD(SO, KVBLK); if constexpr (SDEPTH == 2) { if (2 < NT) SLOAD(SE, 2 * KVBLK); }
  SWAIT(); SWRITE(1, SO); __syncthreads();
  for (int j = 1; j + 1 < NT; j += 2) {
    SBAR(); qkt(pB0, pB1, (bf16*)((char*)K_lds + SHM_K), qr, r32, hi); MOD(pB0, pB1, j);
    finishSM(pA0, pA1, alA, l_reg, pa0, pa1, pa2, pa3); SBAR();
    SLOAD(SO, (j + SDEPTH) * KVBLK); SBAR();
    pv_d0(o, vb0, pa0, pa1, pa2, pa3); partialSM(pB0, pB1, m_reg, mnB, alB);
    __syncthreads(); SWAIT(); SWRITE(0, SE);
    RESC(alB); __syncthreads();
    SBAR(); qkt(pA0, pA1, K_lds, qr, r32, hi); MOD(pA0, pA1, j + 1);
    finishSM(pB0, pB1, alB, l_reg, pa0, pa1, pa2, pa3); SBAR();
    if (SDEPTH == 1 || j + 3 < NT) SLOAD(SE, (j + 1 + SDEPTH) * KVBLK); SBAR();
    pv_d0(o, vb0 + (int)SHM_V, pa0, pa1, pa2, pa3); partialSM(pA0, pA1, m_reg, mnA, alA);
    __syncthreads(); SWAIT(); SWRITE(1, SO);
    RESC(alA); __syncthreads();
  }
  SBAR(); qkt(pB0, pB1, (bf16*)((char*)K_lds + SHM_K), qr, r32, hi); MOD(pB0, pB1, NT - 1);
  finishSM(pA0, pA1, alA, l_reg, pa0, pa1, pa2, pa3); SBAR();
  pv_d0(o, vb0, pa0, pa1, pa2, pa3); partialSM(pB0, pB1, m_reg, mnB, alB);
  __syncthreads(); RESC(alB);
  finishSM(pB0, pB1, alB, l_reg, pa0, pa1, pa2, pa3); SBAR();
  pv_d0(o, vb0 + (int)SHM_V, pa0, pa1, pa2, pa3);
  if (hi == 0) li_l[r32] = l_reg; asm volatile("s_waitcnt lgkmcnt(0)" ::: "memory");
  float rli[16];
#pragma unroll
  for (int r = 0; r < 16; ++r) rli[r] = __builtin_amdgcn_rcpf(li_l[crow(r, hi)]);
  if (MODE == M_NA || MODE == M_DENSE) {
    bf16 zz[16][4];
#pragma unroll
    for (int r = 0; r < 16; ++r) { const long orow = wid * QBLK + crow(r, hi);
#pragma unroll
      for (int d0 = 0; d0 < 4; ++d0) zz[r][d0] = a.Z[orow * a.ldz + d0 * 32 + r32]; }
#pragma unroll
    for (int r = 0; r < 16; ++r) { const long orow = wid * QBLK + crow(r, hi);
#pragma unroll
      for (int d0 = 0; d0 < 4; ++d0) a.Y[orow * a.ldy + d0 * 32 + r32] = f2bf1(o[d0][r] * rli[r] * bf2f(zz[r][d0])); }
  } else {
#pragma unroll
    for (int r = 0; r < 16; ++r) { const long orow = wid * QBLK + crow(r, hi);
#pragma unroll
      for (int d0 = 0; d0 < 4; ++d0) a.O[orow * a.ldo + d0 * 32 + r32] = o[d0][r] * rli[r]; }
    if (MODE == M_DIL) { if (hi == 0) a.L[(long)(wid * QBLK + r32) * a.ldl] = m_reg + __builtin_amdgcn_logf(l_reg); }
  }
#undef SLOAD
#undef SWRITE
#undef SWAIT
#undef RESC
#undef MOD
}

#define ATT_LAS __attribute__((address_space(3)))
#ifndef PINGPONG_SPLIT
#define PINGPONG_SPLIT 4
#endif
template <int MODE, int NVH>
__device__ __forceinline__ void attn_unit_dma(const UA& a, char* lds, int wsoff, const int wave_in) {
  int tid_ = fresh_tid(wave_in); asm volatile("" : "+v"(tid_));
  const int tid = tid_, wid = __builtin_amdgcn_readfirstlane(tid >> 6), lane = tid & 63, r32 = lane & 31, hi = lane >> 5;
  constexpr int KB = 16384, VB = NVH * 16384, OFF_V2 = 2 * KB;
  char* K_lds = lds;
  float* ws = (float*)(lds + wsoff) + wid * 64; float* li_l = ws; float* al_l = ws + 32;
  float* tbl = (float*)(lds + wsoff + 2048) + 64;
  if (MODE == M_NA) { for (int i = tid; i < 15 * 31; i += 512) tbl[i] = a.tbl[i] * LOG2E; }
  float m_reg = -1e30f, l_reg = 0; f32x16 o[4 * NVH]; bf16x8 qr[8];
#pragma unroll
  for (int d = 0; d < 4 * NVH; ++d) o[d] = f32x16{};
  const bf16* Qw = a.Q + (long)(wid * QBLK + r32) * a.ldq + hi * 8;
#pragma unroll
  for (int d0 = 0; d0 < 8; ++d0) qr[d0] = *reinterpret_cast<const bf16x8*>(Qw + d0 * 16);
  const int vb0 = (int)(uintptr_t)(lds + OFF_V2) + v_rd_base(lane);
  const unsigned ldkb = (unsigned)(a.ldk * 2);
  unsigned koff[2], voff[2 * NVH];
#pragma unroll
  for (int i = 0; i < 2; ++i) { const int row = (wid * 2 + i) * 4 + (lane >> 4), c = (lane & 15) ^ (row & 7); koff[i] = (unsigned)row * ldkb + (unsigned)c * 16u; }
#pragma unroll
  for (int i = 0; i < 2 * NVH; ++i) { const int vb = wid * 2 * NVH + i, half = vb >> 4, b = (vb & 15) * 1024 + lane * 16;
    const int sub = b >> 9, e = (b & 511) >> 1, kk = (sub >> 2) * 8 + (e >> 5), c = (sub & 3) * 32 + (e & 31);
    const int k = (kk & ~0xC) | ((kk & 4) << 1) | ((kk & 8) >> 1);
    voff[i] = (unsigned)k * ldkb + (unsigned)(half * 128 + c) * 2u; }
  const char* Kb = (const char*)a.K; const char* Vb = (const char*)a.V; const size_t tstep = (size_t)KVBLK * ldkb;
  ATT_LAS unsigned char* ldl = (ATT_LAS unsigned char*)lds;
#define TROT(j) (((j) + a.j0 >= NT) ? (j) + a.j0 - NT : (j) + a.j0)
#define DMA(j, ks, vs) do { const int jt_ = TROT(j); const char* kt_ = Kb + (size_t)jt_ * tstep; const char* vt_ = Vb + (size_t)jt_ * tstep; \
    _Pragma("unroll") for (int i_ = 0; i_ < 2; ++i_) __builtin_amdgcn_global_load_lds((const unsigned*)(kt_ + koff[i_]), (ATT_LAS unsigned*)(ldl + (ks) * KB + (wid * 2 + i_) * 1024), 16, 0, 0); \
    _Pragma("unroll") for (int i_ = 0; i_ < 2 * NVH; ++i_) __builtin_amdgcn_global_load_lds((const unsigned*)(vt_ + voff[i_]), (ATT_LAS unsigned*)(ldl + OFF_V2 + (vs) * VB + (wid * 2 * NVH + i_) * 1024), 16, 0, 0); } while (0)
#define RESC(a_) do { if (__any((a_) < 1.f)) { if (hi == 0) al_l[r32] = (a_); asm volatile("s_waitcnt lgkmcnt(0)" ::: "memory"); \
    _Pragma("unroll") for (int d = 0; d < 4 * NVH; ++d) _Pragma("unroll") for (int r = 0; r < 16; ++r) o[d][r] *= al_l[crow(r, hi)]; } } while (0)
  const float NEG_INF = -__builtin_inff();
  const int qkrel = a.qk0 + wid * 32 + r32 - 4 * hi;
  const float nslope = -a.slope2;
  const int qgr = a.qrow0 + (wid >> 1), cq = 32 * (wid & 1) + r32;
  const int c0 = min(max(cq - 8, 0), 48), r0 = min(max(qgr - 4, 0), 56);
#define ROWOK(J) ((MODE == M_NA) ? ((a.krow0 + (J)) >= r0 && (a.krow0 + (J)) < r0 + 8) : (MODE == M_DIL) ? ((J) * 64 <= a.qk0 + wid * 32 + 95 && (J) * 64 + 127 >= a.qk0 + wid * 32) : true)
#define MOD(P0, P1, J) do { \
    if (MODE == M_ALIBI || MODE == M_DIL) { const float rel = (float)(qkrel - (J) * 64); \
      _Pragma("unroll") for (int r = 0; r < 16; ++r) { const float cr = (float)((r & 3) + 8 * (r >> 2)); const float d0_ = fabsf(rel - cr), d1_ = fabsf(rel - cr - 32.f); \
        float v0_ = fmaf(nslope, d0_, P0[r]), v1_ = fmaf(nslope, d1_, P1[r]); \
        if (MODE == M_DIL) { v0_ = (d0_ <= 64.f) ? v0_ : NEG_INF; v1_ = (d1_ <= 64.f) ? v1_ : NEG_INF; } \
        P0[r] = v0_; P1[r] = v1_; } } \
    if (MODE == M_NA) { const int kr = a.krow0 + (J); const float* tp = tbl + (kr - qgr + 7) * 31 + (4 * hi - cq + 15); const int kcb = 4 * hi - c0; \
      _Pragma("unroll") for (int r = 0; r < 16; ++r) { const int cr = (r & 3) + 8 * (r >> 2); \
        const bool ok0 = (unsigned)(kcb + cr) < 16u, ok1 = (unsigned)(kcb + cr + 32) < 16u; \
        const float b0_ = tp[cr], b1_ = tp[cr + 32]; \
        P0[r] = ok0 ? P0[r] + b0_ : NEG_INF; P1[r] = ok1 ? P1[r] + b1_ : NEG_INF; } } \
  } while (0)
  f32x16 p0, p1; float mn, al; bf16x8 pa0, pa1, pa2, pa3; const int NT = a.NT;
#define TOP(j, ks, vs) do { asm volatile("s_waitcnt vmcnt(0)" ::: "memory");        \
    __builtin_amdgcn_s_barrier(); asm volatile("" ::: "memory");                    \
    if ((j) + 1 < NT) DMA((j) + 1, (ks) ^ 1, ((vs) == 2) ? 0 : (vs) + 1); } while (0)
#define QKSM(j, ks) do { SBAR(); qkt(p0, p1, (const bf16*)(K_lds + (ks) * KB), qr, r32, hi); MOD(p0, p1, TROT(j)); \
    partialSM(p0, p1, m_reg, mn, al); RESC(al); finishSM(p0, p1, al, l_reg, pa0, pa1, pa2, pa3); SBAR(); } while (0)
#define PVS(vs) do { _Pragma("unroll") for (int h = 0; h < NVH; ++h) { if (NVH == 2) pv_d0_lean(o + 4 * h, vb0 + (vs) * VB + h * 16384, pa0, pa1, pa2, pa3); else pv_d0(o + 4 * h, vb0 + (vs) * VB + h * 16384, pa0, pa1, pa2, pa3); } } while (0)
  DMA(0, 0, 0);
  if (wid < PINGPONG_SPLIT) {
    int vs = 0;
    for (int j = 0; j < NT; ++j) { const int ks = j & 1;
      TOP(j, ks, vs); if (ROWOK(TROT(j))) { QKSM(j, ks); PVS(vs); }
      vs = (vs == 2) ? 0 : vs + 1; }
  } else {
    int vs = 0, vprev = 0; bool pend = false;
    for (int j = 0; j < NT; ++j) { const int ks = j & 1;
      TOP(j, ks, vs); if (pend) PVS(vprev); pend = ROWOK(TROT(j)); if (pend) QKSM(j, ks);
      vprev = vs; vs = (vs == 2) ? 0 : vs + 1; }
    if (pend) PVS(vprev);
  }
  if (hi == 0) li_l[r32] = l_reg; asm volatile("s_waitcnt lgkmcnt(0)" ::: "memory");
  float rli[16];
#pragma unroll
  for (int r = 0; r < 16; ++r) rli[r] = __builtin_amdgcn_rcpf(li_l[crow(r, hi)]);
  if (MODE == M_DENSE || MODE == M_NA) {
    bf16 zz[16][4 * NVH];
#pragma unroll
    for (int r = 0; r < 16; ++r) { const long orow = wid * QBLK + crow(r, hi);
#pragma unroll
      for (int d0 = 0; d0 < 4 * NVH; ++d0) zz[r][d0] = a.Z[orow * a.ldz + d0 * 32 + r32]; }
#pragma unroll
    for (int r = 0; r < 16; ++r) { const long orow = wid * QBLK + crow(r, hi);
#pragma unroll
      for (int d0 = 0; d0 < 4 * NVH; ++d0) a.Y[orow * a.ldy + d0 * 32 + r32] = f2bf1(o[d0][r] * rli[r] * bf2f(zz[r][d0])); }
  } else {
#pragma unroll
    for (int r = 0; r < 16; ++r) { const long orow = wid * QBLK + crow(r, hi);
#pragma unroll
      for (int d0 = 0; d0 < 4 * NVH; ++d0) a.O[orow * a.ldo + d0 * 32 + r32] = o[d0][r] * rli[r]; }
    if (MODE == M_DIL) { if (hi == 0) a.L[(long)(wid * QBLK + r32) * a.ldl] = m_reg + __builtin_amdgcn_logf(l_reg); }
  }
  __builtin_amdgcn_s_barrier(); asm volatile("" ::: "memory");
#undef DMA
#undef RESC
#undef MOD
#undef TOP
#undef QKSM
#undef PVS
#undef ROWOK
#undef TROT
}
#undef KSWZ
#undef SBAR
}
constexpr int NWAVES = 8;
#ifndef MK_ONE_LAUNCH
#define MK_ONE_LAUNCH 1
#endif
constexpr bool ONE_LAUNCH = MK_ONE_LAUNCH != 0;

constexpr int DM = 4096, NB = 2, SEQ = 4096, DEPTH = 2, HD = 128, GRID_W = 64;
constexpr int M = NB * SEQ;
constexpr int LDP = 32256;
constexpr float RMS_EPS = 1e-6f;
constexpr float QSCALE = 0.08838834764831845f * 1.4426950408889634f;
constexpr int CA_Q = 0, CA_K = 1024, CA_V = 2048, CA_Z = 3072;
constexpr int CB_Q = 4096, CB_K = 5120, CB_V = 5376, CB_Z = 5632;
constexpr int CC_Q = 6656, CC_K = 7680, CC_V = 8704, CC_Z = 9728;
constexpr int CD_Q = 10752, CD_K = 12288, CD_V = 13824, CD_Z = 15360;
constexpr int CG = 15872;

constexpr size_t MiB = 1u << 20;
constexpr size_t WS_CTL = 0, CTL_ZERO_BYTES = 1 * MiB;
constexpr int PK = DM + 64, PY = 1024 + 64;
constexpr size_t WS_WIN = 2 * MiB, WIN_LAYER = 256 * MiB;
constexpr size_t WBR_BLOCK = 9 * MiB;
constexpr size_t WS_WBR = WS_WIN + 2 * WIN_LAYER, WBR_LAYER = 4 * WBR_BLOCK;
constexpr size_t WS_WOUT = WS_WBR + 2 * WBR_LAYER, WOUT_LAYER = 33 * MiB;
constexpr size_t WS_XN = WS_WOUT + 2 * WOUT_LAYER;
constexpr size_t WS_PROJ = WS_XN + 66 * MiB;
constexpr size_t WS_OC = WS_PROJ + 504 * MiB;
constexpr size_t WS_OD = WS_OC + 64 * MiB;
constexpr size_t WS_LSE = WS_OD + 48 * MiB;
constexpr size_t Y_BLOCK = 17 * MiB;
constexpr size_t WS_YA = WS_LSE + 1 * MiB, WS_YB = WS_YA + Y_BLOCK, WS_YC = WS_YB + Y_BLOCK, WS_YD = WS_YC + Y_BLOCK;
constexpr size_t WS_MG = WS_YD + Y_BLOCK;
constexpr size_t WS_X1 = WS_MG + 66 * MiB;
constexpr int P8 = DM + 128;
constexpr size_t WS_XN8 = WS_X1 + 128 * MiB;
constexpr size_t WS_SA = WS_XN8 + 33 * MiB;
constexpr int N8 = 110 * 256;
constexpr size_t WS_WG8 = WS_SA + 1 * MiB, WG8_LAYER = 114 * MiB;
constexpr size_t WS_SB = WS_WG8 + 2 * WG8_LAYER;
constexpr size_t WS_MG8 = WS_SB + 1 * MiB;
constexpr size_t WS_SM = WS_MG8 + 33 * MiB;
constexpr size_t WS_WO8 = WS_SM + 1 * MiB, WO8_LAYER = 17 * MiB;
constexpr size_t WS_SO = WS_WO8 + 2 * WO8_LAYER;
constexpr size_t WS_END = WS_SO + 1 * MiB;
static_assert((size_t)DM * P8 <= WO8_LAYER, "d_ws map (int8 w_out)");
static_assert((size_t)M * P8 <= 33 * MiB && (size_t)N8 * P8 <= WG8_LAYER && (size_t)2 * N8 * 4 <= 1 * MiB, "d_ws map (int8)");
static_assert((size_t)LDP * PK * 2 <= WIN_LAYER && (size_t)DM * PY * 2 <= WBR_BLOCK && (size_t)DM * PK * 2 <= WOUT_LAYER && (size_t)M * PK * 2 <= 66 * MiB && (size_t)M * PY * 2 <= Y_BLOCK, "d_ws map");
constexpr int CW_BAR = 4096;

constexpr int RING_OFF = 0, RING_BYTES = 131072;
constexpr int LDSCTL_OFF = RING_BYTES, MISC_OFF = LDSCTL_OFF + 320;
constexpr int XTAB_OFF = RING_BYTES + 1024;
constexpr int LDS_BYTES = 147456;
static_assert(att::SHM_ATTN <= RING_BYTES, "attention scratch fits the ring region");

#define LAS __attribute__((address_space(3)))
typedef unsigned short bf16;
typedef unsigned v4u __attribute__((ext_vector_type(4)));
typedef unsigned v2u __attribute__((ext_vector_type(2)));
typedef float f32x4 __attribute__((ext_vector_type(4)));
#define LDS_WAIT() asm volatile("s_waitcnt lgkmcnt(0)" ::: "memory")
__device__ __forceinline__ unsigned f2bf(float f) { unsigned u = __builtin_bit_cast(unsigned, f); return (u + 0x7fffu + ((u >> 16) & 1u)) >> 16; }
__device__ __forceinline__ unsigned pk2(float lo, float hi) { return f2bf(lo) | (f2bf(hi) << 16); }
__device__ __forceinline__ float bflo(unsigned w) { return __builtin_bit_cast(float, w << 16); }
__device__ __forceinline__ float bfhi(unsigned w) { return __builtin_bit_cast(float, w & 0xffff0000u); }
#define XB_TMO      128
#define XB_XCNT(j)  (256  + 64 * (j))
#define XB_XSUB(j)  (1280 + 64 * (j))
#define XB_XGEN(j)  (2304 + 64 * (j))
#define XB_TOP      3328
#define XB_TOPGEN   3392
#define XCD_BAR_WORDS 3456
#define XB_SPIN_CAP (1u << 22)

__device__ __forceinline__ unsigned xb_ld(unsigned* p)              { return __hip_atomic_load(p, __ATOMIC_RELAXED, __HIP_MEMORY_SCOPE_AGENT); }
__device__ __forceinline__ unsigned xb_add(unsigned* p, unsigned v) { return __hip_atomic_fetch_add(p, v, __ATOMIC_RELAXED, __HIP_MEMORY_SCOPE_AGENT); }
__device__ __forceinline__ unsigned xb_xcc_id() { return (unsigned)__builtin_amdgcn_s_getreg((3 << 11) | 20) & 0xFu; }
#define XB_SPIN(cond, bar) do { unsigned _sp = 0; while (cond) { __builtin_amdgcn_s_sleep(1); \
    if ((++_sp & 255u) == 0u) { if (xb_ld(&(bar)[XB_TMO])) break; if (_sp > XB_SPIN_CAP) { atomicAdd(&(bar)[XB_TMO], 1u); break; } } } } while (0)

struct XcdBarrier {
    unsigned* bar; unsigned x;
    volatile LAS unsigned* st;
};

__device__ __forceinline__ XcdBarrier xcd_barrier_post(unsigned* bar, volatile LAS unsigned* st) {
    XcdBarrier b; b.bar = bar; b.x = xb_xcc_id(); b.st = st;
    if (threadIdx.x == 0) (void)xb_add(&bar[XB_XCNT(b.x)], 1u);
    return b;
}
__device__ __forceinline__ void xcd_barrier_complete(unsigned* bar, unsigned x, unsigned& nloc, unsigned& nx) {
    const unsigned G = gridDim.x * gridDim.y * gridDim.z;
    unsigned sum, cnt, mine, sp = 0u;
    for (;;) {
        sum = 0u; cnt = 0u; mine = 0u;
#pragma unroll 1
        for (unsigned j = 0; j < 16; ++j) { const unsigned c = xb_ld(&bar[XB_XCNT(j)]); sum += c; cnt += (c > 0u) ? 1u : 0u; mine = (j == x) ? c : mine; }
        if (sum == G) break;
        __builtin_amdgcn_s_sleep(1);
        if ((++sp & 255u) == 0u) { if (xb_ld(&bar[XB_TMO])) break; if (sp > XB_SPIN_CAP) { atomicAdd(&bar[XB_TMO], 1u); break; } }
    }
    nloc = mine > 0u ? mine : 1u; nx = cnt > 0u ? cnt : 1u;
}

__device__ __noinline__ void xcd_barrier(const XcdBarrier b, const bool leader  ) {
    asm volatile("s_waitcnt vmcnt(0)" ::: "memory");
    __syncthreads();
    if (leader) {
        unsigned* bar = b.bar;
        __builtin_amdgcn_s_waitcnt(0);
        unsigned nloc = b.st[0], nx = b.st[1];
        if (nloc == 0u) { xcd_barrier_complete(bar, b.x, nloc, nx); b.st[0] = nloc; b.st[1] = nx; }
        const unsigned old = xb_add(&bar[XB_XSUB(b.x)], 1u);
        const unsigned gen = old / nloc;
        if (old + 1u == (gen + 1u) * nloc) {
            __builtin_amdgcn_fence(__ATOMIC_RELEASE, "agent");
            asm volatile("s_waitcnt vmcnt(0)" ::: "memory");
            const unsigned og = xb_add(&bar[XB_TOP], 1u);
            const unsigned tg = og / nx;
            if (og + 1u == (tg + 1u) * nx) xb_add(&bar[XB_TOPGEN], 1u);
            else XB_SPIN(xb_ld(&bar[XB_TOPGEN]) == tg, bar);
            __builtin_amdgcn_fence(__ATOMIC_ACQUIRE, "agent");
            xb_add(&bar[XB_XGEN(b.x)], 1u);
            asm volatile("s_waitcnt vmcnt(0)" ::: "memory");
        } else {
            XB_SPIN(xb_ld(&bar[XB_XGEN(b.x)]) == gen, bar);
            __builtin_amdgcn_fence(__ATOMIC_ACQUIRE, "agent");
            asm volatile("s_waitcnt vmcnt(0)" ::: "memory");
        }
    }
    __syncthreads();
}
struct Frame {
    LAS unsigned char* lds;
    volatile LAS unsigned* MISC;
    unsigned* ctl;
    int tid, lane, wave;
    int vcu, G;
};
__device__ __forceinline__ float wave_sum(float v, const int lane) {
#pragma unroll
    for (int o = 1; o < 64; o <<= 1) v += __builtin_bit_cast(float, __builtin_amdgcn_ds_bpermute((lane ^ o) << 2, __builtin_bit_cast(int, v)));
    return v;
}
__device__ __forceinline__ float wave_max(float v, const int lane) {
#pragma unroll
    for (int o = 1; o < 64; o <<= 1) v = fmaxf(v, __builtin_bit_cast(float, __builtin_amdgcn_ds_bpermute((lane ^ o) << 2, __builtin_bit_cast(int, v))));
    return v;
}
__device__ __forceinline__ unsigned q8(float a, float b, float c, float d, float inv) {
    const int qa = (int)__builtin_rintf(a * inv), qb = (int)__builtin_rintf(b * inv), qc = (int)__builtin_rintf(c * inv), qd = (int)__builtin_rintf(d * inv);
    return (unsigned)(qa & 255) | ((unsigned)(qb & 255) << 8) | ((unsigned)(qc & 255) << 16) | ((unsigned)(qd & 255) << 24);
}
__device__ __forceinline__ void p0_transpose_item(const float* W, int K, int N, bf16* WT, int ldt, LAS float* scr, int item, int lane, int noff = 0, int ncols = 0) {
    const int nblk = (ncols ? ncols : N) / 32, kb = item / nblk, nb = item % nblk, k0 = 64 * kb, n0 = noff + 32 * nb;
    float v[32];
#pragma unroll
    for (int i = 0; i < 32; ++i) { const int kk = 2 * i + (lane >> 5); v[i] = __builtin_nontemporal_load(W + (size_t)(k0 + kk) * N + n0 + (lane & 31)); }
#pragma unroll
    for (int i = 0; i < 32; ++i) { const int kk = 2 * i + (lane >> 5); scr[kk * 33 + (lane & 31)] = v[i]; }
    LDS_WAIT(); asm volatile("" ::: "memory");
    const int c = lane & 7;
#pragma unroll
    for (int j = 0; j < 4; ++j) { const int n = (lane >> 3) + 8 * j; const LAS float* s = scr + (8 * c) * 33 + n;
        v4u o; o.x = pk2(s[0 * 33], s[1 * 33]); o.y = pk2(s[2 * 33], s[3 * 33]); o.z = pk2(s[4 * 33], s[5 * 33]); o.w = pk2(s[6 * 33], s[7 * 33]);
        *(v4u*)(WT + (size_t)(n0 + n) * ldt + k0 + 8 * c) = o; }
    LDS_WAIT(); asm volatile("" ::: "memory");
}
__device__ __forceinline__ void ld_xrow(const float* xrow, f32x4 (&v)[16], int lane) {
    const f32x4* xr = (const f32x4*)xrow + lane;
#pragma unroll
    for (int j = 0; j < 16; ++j) v[j] = xr[64 * j];
}
__device__ __forceinline__ void rms_row_regs(f32x4 (&v)[16], const f32x4 (&gr)[16]  , bf16* orow, unsigned* qrow, float* sa_row, int lane) {
    float s = 0.f;
#pragma unroll
    for (int j = 0; j < 16; ++j) s += (v[j].x * v[j].x + v[j].y * v[j].y) + (v[j].z * v[j].z + v[j].w * v[j].w);
    const float rstd = 1.0f / sqrtf(wave_sum(s, lane) * (1.f / DM) + RMS_EPS);
    v2u* o8 = (v2u*)orow + lane; float mx = 0.f;
#pragma unroll
    for (int j = 0; j < 16; ++j) { const f32x4 gg = gr[j]; v[j].x *= rstd * gg.x; v[j].y *= rstd * gg.y; v[j].z *= rstd * gg.z; v[j].w *= rstd * gg.w;
        mx = fmaxf(fmaxf(mx, fmaxf(fabsf(v[j].x), fabsf(v[j].y))), fmaxf(fabsf(v[j].z), fabsf(v[j].w)));
        v2u w; w.x = pk2(v[j].x, v[j].y); w.y = pk2(v[j].z, v[j].w); o8[64 * j] = w; }
    mx = fmaxf(wave_max(mx, lane), 1e-30f);
    const float inv = 127.0f / mx;
#pragma unroll
    for (int j = 0; j < 16; ++j) qrow[lane + 64 * j] = q8(v[j].x, v[j].y, v[j].z, v[j].w, inv);
    if (lane == 0) *sa_row = mx * (1.0f / 127.0f);
}
__device__ __forceinline__ void ld_row16(const bf16* wrow, v4u (&w)[8], int lane) {
#pragma unroll
    for (int j = 0; j < 8; ++j) w[j] = *((const v4u*)wrow + lane + 64 * j);
}
__device__ __forceinline__ void q_row16(const v4u (&w)[8], unsigned* qrow, float* sc, int lane) {
    float mx = 0.f;
#pragma unroll
    for (int j = 0; j < 8; ++j) {
        mx = fmaxf(mx, fmaxf(fmaxf(fmaxf(fabsf(bflo(w[j].x)), fabsf(bfhi(w[j].x))), fmaxf(fabsf(bflo(w[j].y)), fabsf(bfhi(w[j].y)))), fmaxf(fmaxf(fabsf(bflo(w[j].z)), fabsf(bfhi(w[j].z))), fmaxf(fabsf(bflo(w[j].w)), fabsf(bfhi(w[j].w)))))); }
    mx = fmaxf(wave_max(mx, lane), 1e-30f);
    const float inv = 127.0f / mx;
#pragma unroll
    for (int j = 0; j < 8; ++j) { v2u o; o.x = q8(bflo(w[j].x), bfhi(w[j].x), bflo(w[j].y), bfhi(w[j].y), inv); o.y = q8(bflo(w[j].z), bfhi(w[j].z), bflo(w[j].w), bfhi(w[j].w), inv);
        *((v2u*)qrow + lane + 64 * j) = o; }
    if (lane == 0) *sc = mx * (1.0f / 127.0f);
}
struct Args;
template <class KPT> __device__ __forceinline__ void phase_prologue(Frame& F, KPT KP, unsigned char* ws) {
#define in_(i) ((const float*)(__attribute__((address_space(1))) const float*)(unsigned long long)KP->in[i])
    LAS float* scr = (LAS float*)(F.lds + RING_OFF + F.wave * 16384);
    const int gw = F.vcu * NWAVES + F.wave, NGW = F.G * NWAVES;
    constexpr int C16 = pg8::NT16 * 256, C16_OFF = 26 * 256;
    constexpr int I_IN = (DM / 64) * (C16 / 32), I_BR = (1024 / 64) * (DM / 32), I_BD = (512 / 64) * (DM / 32);
    constexpr int I_LAYER = I_IN + 3 * I_BR + I_BD;
    for (int it = gw; it < 2 * I_LAYER; it += NGW) {
        const int l = it / I_LAYER; int r = it % I_LAYER;
        bf16* wbr = (bf16*)(ws + WS_WBR + (size_t)l * WBR_LAYER);
        if (r < I_IN) { p0_transpose_item(in_(2) + (size_t)l * DM * LDP, DM, LDP, (bf16*)(ws + WS_WIN + (size_t)l * WIN_LAYER), PK, scr, r, F.lane, C16_OFF, C16); continue; } r -= I_IN;
        if (r < I_BR) { p0_transpose_item(in_(7) + (size_t)l * 1024 * DM, 1024, DM, wbr, PY, scr, r, F.lane); continue; } r -= I_BR;
        if (r < I_BR) { p0_transpose_item(in_(8) + (size_t)l * 1024 * DM, 1024, DM, wbr + 1 * (WBR_BLOCK / 2), PY, scr, r, F.lane); continue; } r -= I_BR;
        if (r < I_BR) { p0_transpose_item(in_(9) + (size_t)l * 1024 * DM, 1024, DM, wbr + 2 * (WBR_BLOCK / 2), PY, scr, r, F.lane); continue; } r -= I_BR;
        p0_transpose_item(in_(10) + (size_t)l * 512 * DM, 512, DM, wbr + 3 * (WBR_BLOCK / 2), PY, scr, r, F.lane);
    }
    {
        LAS float* cm = (LAS float*)(F.lds + RING_OFF + 12288);
        const int lane = F.lane, n = lane & 31, kpar = lane >> 5;
        constexpr int NBQ = N8 / 32;
        for (int it = F.vcu; it < 2 * NBQ + 2 * (DM / 32); it += F.G) {
            const float* W; int ldw; unsigned char* Q; float* SC;
            if (it < 2 * NBQ) { const int l = it / NBQ, n0c = (it % NBQ) * 32, n0 = pg8::map8(n0c >> 8) * 256 + (n0c & 255);
                W = in_(2) + (size_t)l * DM * LDP + n0 + n; ldw = LDP; Q = ws + WS_WG8 + (size_t)l * WG8_LAYER + (size_t)n0c * P8; SC = (float*)(ws + WS_SB) + (size_t)l * N8 + n0c; }
            else { const int r = it - 2 * NBQ, l = r / (DM / 32), n0 = (r % (DM / 32)) * 32;
                W = in_(11) + (size_t)l * DM * DM + n0 + n; ldw = DM; Q = ws + WS_WO8 + (size_t)l * WO8_LAYER + (size_t)n0 * P8; SC = (float*)(ws + WS_SO) + (size_t)l * DM + n0; }
            float mx = 0.f; unsigned pk[8][16];
#pragma unroll
            for (int kb = 0; kb < 8; ++kb) { const int k0 = (F.wave * 8 + kb) * 64;
                float v[32]; const float* wp = W + (size_t)(k0 + kpar) * ldw;
#pragma unroll
                for (int i = 0; i < 32; ++i) { v[i] = __builtin_nontemporal_load(wp); wp += 2 * ldw; asm volatile("" : "+v"(wp)); }
#pragma unroll
                for (int i = 0; i < 32; ++i) mx = fmaxf(mx, fabsf(v[i]));
#pragma unroll
                for (int i = 0; i < 16; ++i) { pk[kb][i] = pk2(v[2 * i], v[2 * i + 1]); asm volatile("" : "+v"(pk[kb][i])); }
                asm volatile("" ::: "memory"); __builtin_amdgcn_sched_barrier(0); }
            mx = fmaxf(mx, __builtin_bit_cast(float, __builtin_amdgcn_ds_bpermute((lane ^ 32) << 2, __builtin_bit_cast(int, mx))));
            if (lane < 32) cm[F.wave * 32 + lane] = mx;
            LDS_WAIT(); __syncthreads();
            float cmax = cm[n];
#pragma unroll
            for (int w = 1; w < 8; ++w) cmax = fmaxf(cmax, cm[w * 32 + n]);
            cmax = fmaxf(cmax, 1e-30f);
            const float inv = 127.0f / cmax;
            if (F.wave == 0 && lane < 32) SC[lane] = cmax * (1.0f / 127.0f);
#pragma unroll
            for (int kb = 0; kb < 8; ++kb) { const int k0 = (F.wave * 8 + kb) * 64;
#pragma unroll
                for (int i = 0; i < 16; ++i) { scr[(4 * i + kpar) * 33 + n] = bflo(pk[kb][i]) * inv; scr[(4 * i + 2 + kpar) * 33 + n] = bfhi(pk[kb][i]) * inv; }
                LDS_WAIT(); asm volatile("" ::: "memory");
                const int c = lane & 7;
#pragma unroll
                for (int j = 0; j < 4; ++j) { const int nn = (lane >> 3) + 8 * j; const LAS float* sp = scr + (8 * c) * 33 + nn;
                    v2u o; o.x = q8(sp[0 * 33], sp[1 * 33], sp[2 * 33], sp[3 * 33], 1.0f); o.y = q8(sp[4 * 33], sp[5 * 33], sp[6 * 33], sp[7 * 33], 1.0f);
                    *(v2u*)(Q + (size_t)nn * P8 + k0 + 8 * c) = o; }
                LDS_WAIT(); asm volatile("" ::: "memory"); __builtin_amdgcn_sched_barrier(0); }
            __syncthreads();
        }
    }
    f32x4 gg[16]; ld_xrow(in_(1), gg, F.lane);
    for (int m = gw; m < M; m += NGW) { f32x4 v[16]; ld_xrow(in_(0) + (size_t)m * DM, v, F.lane);
        rms_row_regs(v, gg, (bf16*)(ws + WS_XN) + (size_t)m * PK, (unsigned*)(ws + WS_XN8 + (size_t)m * P8), (float*)(ws + WS_SA) + m, F.lane); }
}
#undef in_
__device__ __forceinline__ void phase_finalize(Frame& F, unsigned char* ws, const float* lam_p  , const float* subln_g  , float lam_init) {
    const int gw = F.vcu * NWAVES + F.wave, NGW = F.G * NWAVES, lane = F.lane;
    const bf16* proj = (const bf16*)(ws + WS_PROJ);
    float d1 = lam_p[lane] * lam_p[128 + lane] + lam_p[64 + lane] * lam_p[192 + lane];
    float d2 = lam_p[256 + lane] * lam_p[384 + lane] + lam_p[320 + lane] * lam_p[448 + lane];
    d1 = wave_sum(d1, lane); d2 = wave_sum(d2, lane);
    const float lam = expf(d1) - expf(d2) + lam_init;
    const float post = 1.0f - lam_init;
    const float* OC = (const float*)(ws + WS_OC);
    const f32x4 sg = *(const f32x4*)(subln_g + 4 * lane);
    bf16* YC = (bf16*)(ws + WS_YC);
    for (int t = gw; t < M; t += NGW) {
        f32x4 o0[4], o1[4]; v2u zw[4];
#pragma unroll
        for (int h = 0; h < 4; ++h) { o0[h] = *(const f32x4*)(OC + (size_t)t * 2048 + (2 * h) * 256 + 4 * lane); o1[h] = *(const f32x4*)(OC + (size_t)t * 2048 + (2 * h + 1) * 256 + 4 * lane);
            zw[h] = *(const v2u*)(proj + (size_t)t * LDP + CC_Z + h * 256 + 4 * lane); }
#pragma unroll
        for (int h = 0; h < 4; ++h) {
            const f32x4 d = o0[h] - lam * o1[h];
            const float ss = wave_sum((d.x * d.x + d.y * d.y) + (d.z * d.z + d.w * d.w), lane);
            const float rstd = 1.0f / sqrtf(ss * (1.f / 256.f) + RMS_EPS) * post;
            v2u o; o.x = pk2(d.x * rstd * sg.x * bflo(zw[h].x), d.y * rstd * sg.y * bfhi(zw[h].x)); o.y = pk2(d.z * rstd * sg.z * bflo(zw[h].y), d.w * rstd * sg.w * bfhi(zw[h].y));
            *(v2u*)(YC + (size_t)t * PY + h * 256 + 4 * lane) = o;
        }
    }
    const float* OD = (const float*)(ws + WS_OD); const float* LSE = (const float*)(ws + WS_LSE);
    bf16* YD = (bf16*)(ws + WS_YD);
    const int hg = lane >> 4, c0 = hg * 128 + (lane & 15) * 8;
    for (int t0 = gw; t0 < M; t0 += 2 * NGW) {
        float ls[2][3]; f32x4 av[2][3][2]; v4u zw[2];
#pragma unroll
        for (int k = 0; k < 2; ++k) { const int t = min(t0 + k * NGW, M - 1);
#pragma unroll
            for (int g = 0; g < 3; ++g) { ls[k][g] = LSE[(size_t)g * M * 4 + (size_t)t * 4 + hg]; const float* pp = OD + (size_t)g * M * 512 + (size_t)t * 512 + c0; av[k][g][0] = *(const f32x4*)pp; av[k][g][1] = *(const f32x4*)(pp + 4); }
            zw[k] = *(const v4u*)(proj + (size_t)t * LDP + CD_Z + c0); }
#pragma unroll
        for (int k = 0; k < 2; ++k) { const int t = t0 + k * NGW;
            const float mx = fmaxf(ls[k][0], fmaxf(ls[k][1], ls[k][2]));
            float w0 = __builtin_amdgcn_exp2f(ls[k][0] - mx), w1 = __builtin_amdgcn_exp2f(ls[k][1] - mx), w2 = __builtin_amdgcn_exp2f(ls[k][2] - mx);
            const float inv = 1.0f / (w0 + w1 + w2); w0 *= inv; w1 *= inv; w2 *= inv;
            const f32x4 r0 = w0 * av[k][0][0] + w1 * av[k][1][0] + w2 * av[k][2][0], r1 = w0 * av[k][0][1] + w1 * av[k][1][1] + w2 * av[k][2][1];
            v4u o; o.x = pk2(r0.x * bflo(zw[k].x), r0.y * bfhi(zw[k].x)); o.y = pk2(r0.z * bflo(zw[k].y), r0.w * bfhi(zw[k].y));
            o.z = pk2(r1.x * bflo(zw[k].z), r1.y * bfhi(zw[k].z)); o.w = pk2(r1.z * bflo(zw[k].w), r1.w * bfhi(zw[k].w));
            if (t < M) *(v4u*)(YD + (size_t)t * PY + c0) = o; }
    }
}
#ifndef REP_AB
#define REP_AB 1
#endif
#ifndef REP_AC
#define REP_AC 1
#endif
#ifndef REP_AA
#define REP_AA 1
#endif
#ifndef REP_AD
#define REP_AD 1
#endif
#ifndef SD_DENSE
#define SD_DENSE 2
#endif
#ifndef SD_ALIBI
#define SD_ALIBI 2
#endif
#ifndef SD_NA
#define SD_NA 1
#endif
#ifndef SD_DIL
#define SD_DIL 1
#endif
__device__ __forceinline__ void phase_attention(Frame& F, unsigned char* ws, const float* rel_bias  , char* lds) {
    const att::bf16* P = (const att::bf16*)(ws + WS_PROJ);
    for (int rep = 0; rep < REP_AB; ++rep)
    for (int u = F.vcu; u < 256; u += F.G) {
        const int grp = u >> 6, b = grp >> 1, kvh = grp & 1, hq = kvh * 4 + ((u >> 4) & 3), qb = u & 15;
        const size_t tb = (size_t)b * SEQ, tq = tb + 256 * qb;
        att::UA a{};
        a.Q = P + tq * LDP + CB_Q + hq * 128; a.ldq = LDP;
        a.K = P + tb * LDP + CB_K + kvh * 128; a.V = P + tb * LDP + CB_V + kvh * 128; a.ldk = LDP; a.NT = SEQ / 64;
        a.Y = (att::bf16*)(ws + WS_YB) + tq * PY + hq * 128; a.ldy = PY; a.Z = P + tq * LDP + CB_Z + hq * 128; a.ldz = LDP;
        att::attn_unit_dma<att::M_DENSE, 1>(a, lds, 2 * 16384 + 3 * 16384, F.wave);
    }
    for (int rep = 0; rep < REP_AC; ++rep)
    for (int u = F.vcu; u < 256; u += F.G) {
        const int combo = u >> 4, b = combo >> 3, h = (combo >> 1) & 3, mp = combo & 1, qb = u & 15;
        const size_t tb = (size_t)b * SEQ, tq = tb + 256 * qb;
        att::UA a{};
        a.Q = P + tq * LDP + CC_Q + (h * 2 + mp) * 128; a.ldq = LDP;
        a.K = P + tb * LDP + CC_K + (h * 2 + mp) * 128; a.V = P + tb * LDP + CC_V + h * 256; a.ldk = LDP; a.NT = SEQ / 64;
        a.qk0 = 256 * qb; a.slope2 = __builtin_amdgcn_exp2f(-2.0f * (float)(h + 1)) * att::LOG2E; a.j0 = 4 * qb;
        a.O = (float*)(ws + WS_OC) + tq * 2048 + (h * 2 + mp) * 256; a.ldo = 2048;
        att::attn_unit_dma<att::M_ALIBI, 2>(a, lds, XTAB_OFF, F.wave);
    }
    for (int rep = 0; rep < REP_AA; ++rep)
    for (int u = F.vcu; u < 256; u += F.G) {
        const int b = u >> 7, h = (u >> 4) & 7, R = u & 15;
        const size_t tb = (size_t)b * SEQ, tq = tb + 256 * R;
        int kr_lo = min(max(4 * R - 4, 0), 56); const int kr_last = min(max(4 * R - 1, 0), 56) + 7; int NT = kr_last - kr_lo + 1;
        att::UA a{};
        a.Q = P + tq * LDP + CA_Q + h * 128; a.ldq = LDP;
        a.K = P + (tb + (size_t)kr_lo * 64) * LDP + CA_K + h * 128; a.V = P + (tb + (size_t)kr_lo * 64) * LDP + CA_V + h * 128; a.ldk = LDP; a.NT = NT;
        a.qrow0 = 4 * R; a.krow0 = kr_lo; a.tbl = rel_bias + h * (15 * 31);
        a.Y = (att::bf16*)(ws + WS_YA) + tq * PY + h * 128; a.ldy = PY; a.Z = P + tq * LDP + CA_Z + h * 128; a.ldz = LDP;
        att::attn_unit_dma<att::M_NA, 1>(a, lds, 2 * 16384 + 3 * 16384, F.wave);
    }
    for (int rep = 0; rep < REP_AD; ++rep)
    for (int u = F.vcu; u < 384; u += F.G) {
        const int bh = u >> 4, b = bh / 12, gh = bh % 12, g = gh >> 2, hg = gh & 3, u16 = u & 15;
        const int dil = (g == 0) ? 1 : ((g == 1) ? 4 : 16);
        const int qb = (g == 0) ? u16 : ((g == 1) ? (u16 & 3) : 0), rho = (g == 0) ? 0 : ((g == 1) ? (u16 >> 2) : u16);
        const int nttot = 64 / dil;
        const int t_lo = max(0, 4 * qb - 1), t_hi = min(nttot, 4 * qb + 5);
        const size_t tb = (size_t)b * SEQ, tq = tb + rho + (size_t)dil * 256 * qb, tk = tb + rho + (size_t)dil * 64 * t_lo;
        att::UA a{};
        a.Q = P + tq * LDP + CD_Q + gh * 128; a.ldq = (long)LDP * dil;
        a.K = P + tk * LDP + CD_K + gh * 128; a.V = P + tk * LDP + CD_V + gh * 128; a.ldk = (long)LDP * dil; a.NT = t_hi - t_lo;
        a.qk0 = 256 * qb - 64 * t_lo; a.slope2 = __builtin_amdgcn_exp2f(-8.0f * (float)(gh + 1) / 12.0f) * (float)dil * att::LOG2E;
        a.O = (float*)(ws + WS_OD) + (size_t)g * M * 512 + tq * 512 + hg * 128; a.ldo = 512L * dil;
        a.L = (float*)(ws + WS_LSE) + (size_t)g * M * 4 + tq * 4 + hg; a.ldl = 4L * dil;
        att::attn_unit_dma<att::M_DIL, 1>(a, lds, 2 * 16384 + 3 * 16384, F.wave);
    }
}

#ifndef REP_PRO
#define REP_PRO 1
#endif
#ifndef REP_INP
#define REP_INP 1
#endif
#ifndef REP_ATT
#define REP_ATT 1
#endif
#ifndef REP_FIN
#define REP_FIN 1
#endif
#ifndef REP_BRA
#define REP_BRA 1
#endif
#ifndef REP_OUT
#define REP_OUT 1
#endif
#ifndef REP_NRM
#define REP_NRM 1
#endif
constexpr int NPH = 14;
struct Args { const float* in[12]; float* out; unsigned char* ws; int ph_lo, ph_hi; };
__global__ void __launch_bounds__(NWAVES * 64, 2) mega_fwd(Args args) {
    extern __shared__ __attribute__((aligned(16))) unsigned char lds[];
    Frame F;
    F.lds = (LAS unsigned char*)lds;
    F.MISC = (volatile LAS unsigned*)(F.lds + MISC_OFF);
    F.tid = threadIdx.x; F.lane = F.tid & 63; F.wave = __builtin_amdgcn_readfirstlane(F.tid >> 6);
    const int wave0 = F.wave;
    F.G = gridDim.x; { const int bx = blockIdx.x; F.vcu = (F.G % 8 == 0) ? (bx % 8) * (F.G / 8) + bx / 8 : bx; }
    unsigned char* ws = args.ws;
    F.ctl = (unsigned*)(ws + WS_CTL);
    for (int u = F.tid; u < (LDS_BYTES - LDSCTL_OFF) / 4; u += NWAVES * 64) ((LAS unsigned*)(F.lds + LDSCTL_OFF))[u] = 0u;
    __syncthreads();
    XcdBarrier bar; bar.bar = F.ctl + CW_BAR; bar.x = 0; bar.st = nullptr;
    if (ONE_LAUNCH) bar = xcd_barrier_post(F.ctl + CW_BAR, F.MISC + 8);
    const int lo = args.ph_lo, hi = args.ph_hi;
    const __attribute__((address_space(4))) Args* KP = (const __attribute__((address_space(4))) Args*)__builtin_amdgcn_kernarg_segment_ptr();
#define INP(i) ((const float*)(__attribute__((address_space(1))) const float*)(unsigned long long)KP->in[i])
#define PHASE_ENTER() do { unsigned long long kpi_ = (unsigned long long)__builtin_amdgcn_kernarg_segment_ptr(); asm volatile("" : "+s"(kpi_)); KP = (const __attribute__((address_space(4))) Args*)kpi_; \
        unsigned long long wsi_ = (unsigned long long)KP->ws; asm volatile("" : "+s"(wsi_)); ws = (unsigned char*)(__attribute__((address_space(1))) unsigned char*)wsi_; int t_ = fresh_tid(wave0); asm volatile("" : "+v"(t_)); F.tid = t_; F.lane = t_ & 63; F.wave = wave0; } while (0)
#define IN(k) (lo <= (k) && (k) < hi)
#define SEAM(k) do { if (IN(k) && IN((k) + 1)) xcd_barrier(bar, fresh_tid(wave0) == 0); } while (0)

    if (IN(0)) { for (int rep = 0; rep < REP_PRO; ++rep) { PHASE_ENTER(); phase_prologue(F, KP, ws); }
        SEAM(0); }

#pragma unroll 1
    for (int l = 0; l < DEPTH; ++l) {
        const int pb = 1 + 7 * l;
        if (IN(pb)) for (int rep = 0; rep < REP_INP; ++rep) {
            PHASE_ENTER(); bf16* proj = (bf16*)(ws + WS_PROJ);
            {
                pg8::Gemm g8{(const pg8::bf16_t*)(ws + WS_XN8), (const pg8::bf16_t*)(ws + WS_WG8 + (size_t)l * WG8_LAYER), M, N8, DM / 2, P8 / 2};
                pg8::StaticOrder S8; S8.init(M, N8, F.G, (int)blockIdx.x);
                pg8::EpiProjT<true> E8{proj, LDP, INP(3) + (size_t)l * 4 * 2 * HD, (LAS float*)(F.lds + XTAB_OFF), QSCALE, (const float*)(ws + WS_SA), (const float*)(ws + WS_SB) + (size_t)l * N8};
                pg8::gemm_phase<pg8::EpiProjT<true>, pg8::StaticOrder, true, true, pg8::Gemm, true>(F.lds + RING_OFF, g8, S8, E8, F.wave);
            }
            pg8::GemmMap16 g{(const pg8::bf16_t*)(ws + WS_XN), (const pg8::bf16_t*)(ws + WS_WIN + (size_t)l * WIN_LAYER), DM, PK};
            pg8::StaticOrder S; S.init(M, pg8::NT16 * 256, F.G, (int)blockIdx.x);
            pg8::EpiProjT<false> E{proj, LDP, INP(3) + (size_t)l * 4 * 2 * HD, (LAS float*)(F.lds + XTAB_OFF), QSCALE, nullptr, nullptr};
            pg8::gemm_phase<pg8::EpiProjT<false>, pg8::StaticOrder, true, true, pg8::GemmMap16>(F.lds + RING_OFF, g, S, E, F.wave);
            if (rep == REP_INP - 1) SEAM(pb);
        }
        if (IN(pb + 2)) { for (int rep = 0; rep < REP_ATT; ++rep) { PHASE_ENTER(); phase_attention(F, ws, INP(4) + (size_t)l * 8 * 15 * 31, (char*)lds + RING_OFF); } SEAM(pb + 2); }
        if (IN(pb + 3)) for (int rep = 0; rep < REP_FIN; ++rep) {
            PHASE_ENTER();
            const float lam_init = 0.8f - 0.6f * expf(-0.3f * (float)l);
            phase_finalize(F, ws, INP(5) + (size_t)l * 4 * HD, INP(6) + (size_t)l * 2 * HD, lam_init); if (rep == REP_FIN - 1) SEAM(pb + 3);
        }
        if (IN(pb + 4)) for (int rep = 0; rep < REP_BRA; ++rep) {
            PHASE_ENTER(); bf16* proj = (bf16*)(ws + WS_PROJ);
            const int rot = (int)(blockIdx.x & 1);
            pg8::ChainGemm g{(const bf16*)(ws + WS_YA), (const bf16*)(ws + WS_WBR + (size_t)l * WBR_LAYER), Y_BLOCK / 2, WBR_BLOCK / 2, PY, 1024, rot};
            pg8::ChainOrder S; S.T.init(M, DM, F.G, (int)blockIdx.x);
            pg8::EpiChain E{proj + CG, LDP, (bf16*)(ws + WS_MG), PK, rot};
            pg8::gemm_phase<pg8::EpiChain, pg8::ChainOrder, true, true, pg8::ChainGemm>(F.lds + RING_OFF, g, S, E, F.wave);
            if (rep == REP_BRA - 1) SEAM(pb + 4);
        }
        if (IN(pb + 5)) {
            { PHASE_ENTER(); const int gw = F.vcu * NWAVES + F.wave, NGW = F.G * NWAVES;
              for (int m = gw; m < M; m += 2 * NGW) { const int m2 = min(m + NGW, M - 1); v4u wa[8], wb[8];
                  ld_row16((const bf16*)(ws + WS_MG) + (size_t)m * PK, wa, F.lane); ld_row16((const bf16*)(ws + WS_MG) + (size_t)m2 * PK, wb, F.lane);
                  q_row16(wa, (unsigned*)(ws + WS_MG8 + (size_t)m * P8), (float*)(ws + WS_SM) + m, F.lane);
                  if (m + NGW < M) q_row16(wb, (unsigned*)(ws + WS_MG8 + (size_t)m2 * P8), (float*)(ws + WS_SM) + m2, F.lane); } }
            xcd_barrier(bar, fresh_tid(wave0) == 0);
            for (int rep = 0; rep < REP_OUT; ++rep) {
            PHASE_ENTER();
            const float* xin = (l == 0) ? INP(0) : (const float*)(ws + WS_X1);
            float* xout = (l == DEPTH - 1) ? (float*)(__attribute__((address_space(1))) float*)(unsigned long long)KP->out : (float*)(ws + WS_X1);
            pg8::Gemm g{(const pg8::bf16_t*)(ws + WS_MG8), (const pg8::bf16_t*)(ws + WS_WO8 + (size_t)l * WO8_LAYER), M, DM, DM / 2, P8 / 2};
            pg8::StaticOrder S; S.init(M, DM, F.G, (int)blockIdx.x);
            pg8::EpiRes8 E{xin, xout, DM, (const float*)(ws + WS_SM), (const float*)(ws + WS_SO) + (size_t)l * DM};
            pg8::gemm_phase<pg8::EpiRes8, pg8::StaticOrder, true, true, pg8::Gemm, true>(F.lds + RING_OFF, g, S, E, F.wave);
            }
            SEAM(pb + 5);
        }
        if (l + 1 < DEPTH && IN(pb + 6)) for (int rep = 0; rep < REP_NRM; ++rep) {
            PHASE_ENTER();
            const int gw = F.vcu * NWAVES + F.wave, NGW = F.G * NWAVES;
            f32x4 gg[16]; ld_xrow(INP(1) + (size_t)(l + 1) * DM, gg, F.lane);
            for (int m = gw; m < M; m += 2 * NGW) { const int m2 = min(m + NGW, M - 1); f32x4 va[16], vb[16];
                ld_xrow((const float*)(ws + WS_X1) + (size_t)m * DM, va, F.lane); ld_xrow((const float*)(ws + WS_X1) + (size_t)m2 * DM, vb, F.lane);
                rms_row_regs(va, gg, (bf16*)(ws + WS_XN) + (size_t)m * PK, (unsigned*)(ws + WS_XN8 + (size_t)m * P8), (float*)(ws + WS_SA) + m, F.lane);
                if (m + NGW < M) rms_row_regs(vb, gg, (bf16*)(ws + WS_XN) + (size_t)m2 * PK, (unsigned*)(ws + WS_XN8 + (size_t)m2 * P8), (float*)(ws + WS_SA) + m2, F.lane); }
            if (rep == REP_NRM - 1) SEAM(pb + 6);
        }
    }
#undef IN
#undef SEAM
#undef PHASE_ENTER
#undef INP
}

extern "C" void kernel_launch(void* const* d_in, const int* in_sizes, int n_in, void* d_out, int out_size, void* d_ws, size_t ws_size, hipStream_t stream) {
    static int grid = 0;
    if (grid == 0) {
        if (n_in != 12 || in_sizes[0] != M * DM || out_size != M * DM || ws_size < WS_END) { fprintf(stderr, "kernel_launch: shape/workspace mismatch (n_in %d, in0 %d, out %d, ws %zu, need %zu)\n", n_in, n_in > 0 ? in_sizes[0] : -1, out_size, ws_size, (size_t)WS_END); grid = -1; return; }
        int dev = 0, cus = 0, per_cu = 0;
        if (hipGetDevice(&dev) != hipSuccess || hipDeviceGetAttribute(&cus, hipDeviceAttributeMultiprocessorCount, dev) != hipSuccess) { grid = -1; return; }
        if (hipFuncSetAttribute((const void*)mega_fwd, hipFuncAttributeMaxDynamicSharedMemorySize, LDS_BYTES) != hipSuccess) { fprintf(stderr, "kernel_launch: hipFuncSetAttribute failed\n"); grid = -1; return; }
        if (hipOccupancyMaxActiveBlocksPerMultiprocessor(&per_cu, (const void*)mega_fwd, NWAVES * 64, LDS_BYTES) != hipSuccess || per_cu < 1)
            fprintf(stderr, "kernel_launch: note: occupancy query reports %d workgroups per CU\n", per_cu);
        (void)hipGetLastError();
        grid = cus;
    }
    if (grid < 0) return;
    if (hipMemsetAsync((char*)d_ws + WS_CTL, 0, CTL_ZERO_BYTES, stream) != hipSuccess) { fprintf(stderr, "kernel_launch: hipMemsetAsync failed\n"); return; }
    Args a{};
    for (int i = 0; i < 12; ++i) a.in[i] = (const float*)d_in[i];
    a.out = (float*)d_out; a.ws = (unsigned char*)d_ws;
    if (ONE_LAUNCH) {
        a.ph_lo = 0; a.ph_hi = NPH;
        hipLaunchKernelGGL(mega_fwd, dim3(grid), dim3(NWAVES * 64), LDS_BYTES, stream, a);
    } else {
        for (int p = 0; p < NPH; ++p) { a.ph_lo = p; a.ph_hi = p + 1; hipLaunchKernelGGL(mega_fwd, dim3(grid), dim3(NWAVES * 64), LDS_BYTES, stream, a); }
    }
    const hipError_t le = hipPeekAtLastError();
    if (le != hipSuccess) fprintf(stderr, "kernel_launch: launch failed: %s\n", hipGetErrorName(le));
}
```

```cpp
#include <hip/hip_runtime.h>
#include <cstdio>
#include <cstdint>
__device__ __forceinline__ int fresh_tid(int wave) { unsigned m = ~0u; asm volatile("" : "+s"(m)); return wave * 64 + (int)__builtin_amdgcn_mbcnt_hi(m, __builtin_amdgcn_mbcnt_lo(m, 0u)); }
namespace pg8 {
#define PG8_LAS __attribute__((address_space(3)))
typedef unsigned short bf16_t;
typedef short bf16x8 __attribute__((ext_vector_type(8)));
typedef float f32x4 __attribute__((ext_vector_type(4)));
typedef unsigned u32x4 __attribute__((ext_vector_type(4)));
constexpr int BM = 256, BK = 64, HALF = 128, HTB = HALF * BK * 2  , STAGE_BYTES = 8 * HTB, NXCD = 8, WGM = 8;

__host__ __device__ __forceinline__ int lds_byte(int r, int c) { const int st = (r >> 4) * 2 + (c >> 5), rr = r & 15, cc = c & 31, ob = rr * 64 + cc * 2; return st * 1024 + (ob ^ (((ob >> 9) & 1) << 5)); }
__host__ __device__ __forceinline__ void stage_rc(int b, int& R, int& C) { const int st = b / 1024, sb = b % 1024, swz = sb ^ (((sb >> 9) & 1) << 5); R = (st >> 1) * 16 + swz / 64; C = (st & 1) * 32 + (swz % 64) / 2; }
__host__ __device__ __forceinline__ int perm32(int rho) { const int n = rho >> 4, i = rho & 15; return 8 * (i >> 2) + 4 * n + (i & 3); }

struct Unit { int pm, pn, seg; };
struct Gemm { const bf16_t* A; const bf16_t* Bt; int M, N, K, P;
    __device__ __forceinline__ int pitch() const { return P; }
    __device__ __forceinline__ int ntiles(const Unit&) const { return K / BK; }
    __device__ __forceinline__ const char* a_base(const Unit& u, size_t tstep) const { return (const char*)A + (size_t)u.pm * tstep; }
    __device__ __forceinline__ const char* b_base(const Unit& u, size_t tstep) const { return (const char*)Bt + (size_t)u.pn * tstep; }
};
__host__ __device__ __forceinline__ int map16(int j) { return j + 26; }
__host__ __device__ __forceinline__ int map8(int j) { return j < 26 ? j : j + 8; }
constexpr int NT16 = 8, NT8 = 118;
struct GemmMap16 { const bf16_t* A; const bf16_t* Bt; int K, P;
    __device__ __forceinline__ int pitch() const { return P; }
    __device__ __forceinline__ int ntiles(const Unit&) const { return K / BK; }
    __device__ __forceinline__ const char* a_base(const Unit& u, size_t tstep) const { return (const char*)A + (size_t)u.pm * tstep; }
    __device__ __forceinline__ const char* b_base(const Unit& u, size_t tstep) const { return (const char*)Bt + (size_t)map16(u.pn) * tstep; }
};
struct ChainGemm { const bf16_t* A0; const bf16_t* B0; size_t a_stride, b_stride; int P, K, rot;
    __device__ __forceinline__ int branch(const Unit& u) const { return (u.seg + 3 * rot) & 3; }
    __device__ __forceinline__ int pitch() const { return P; }
    __device__ __forceinline__ int ntiles(const Unit& u) const { return (branch(u) == 3) ? (K / BK) / 2 : K / BK; }
    __device__ __forceinline__ const char* a_base(const Unit& u, size_t tstep) const { return (const char*)(A0 + (size_t)branch(u) * a_stride) + (size_t)u.pm * tstep; }
    __device__ __forceinline__ const char* b_base(const Unit& u, size_t tstep) const { return (const char*)(B0 + (size_t)branch(u) * b_stride) + (size_t)u.pn * tstep; }
};

struct StaticOrder {
    int nM, nN, nwg, G, c;
    __host__ __device__ void init(int M, int N, int G_, int c_) { nM = M / BM; nN = N / BM; nwg = nM * nN; G = G_; c = c_; }
    __host__ __device__ bool next(int i, Unit& u) const {
        const long L = (long)i * G + c; if (L >= nwg) return false;
        int wgid = (int)L; { const int q = nwg / NXCD, r = nwg % NXCD, xcd = wgid % NXCD, off = wgid / NXCD; wgid = (xcd < r ? xcd * (q + 1) : r * (q + 1) + (xcd - r) * q) + off; }
        const int nig = WGM * nN, gid = wgid / nig, fm = gid * WGM, gsz = (nM - fm) < WGM ? (nM - fm) : WGM;
        u.pm = fm + ((wgid % nig) % gsz); u.pn = (wgid % nig) / gsz; u.seg = 0; return true;
    }
    __device__ __forceinline__ void a_ready(const Unit&) const {}
    __device__ __forceinline__ void done(const Unit&) const {}
};
struct ChainOrder { StaticOrder T;
    __device__ __forceinline__ bool next(int i, Unit& u) const { if (!T.next(i >> 2, u)) return false; u.seg = i & 3; return true; }
    __device__ __forceinline__ void a_ready(const Unit&) const {}
    __device__ __forceinline__ void done(const Unit&) const {}
};

__device__ __forceinline__ unsigned cvt_pk_bf16(float lo, float hi) { unsigned r; asm volatile("v_cvt_pk_bf16_f32 %0, %1, %2" : "=v"(r) : "v"(lo), "v"(hi)); return r; }
typedef float f32x2 __attribute__((ext_vector_type(2)));
typedef int i32x4 __attribute__((ext_vector_type(4)));
template <bool I8> struct AccT { typedef f32x4 type; };
template <> struct AccT<true> { typedef i32x4 type; };
template <bool I8> __device__ __forceinline__ typename AccT<I8>::type mma1(bf16x8 b, bf16x8 a, typename AccT<I8>::type c) {
    if constexpr (I8) return __builtin_amdgcn_mfma_i32_16x16x64_i8(__builtin_bit_cast(i32x4, b), __builtin_bit_cast(i32x4, a), c, 0, 0, 0);
    else return __builtin_amdgcn_mfma_f32_16x16x32_bf16(b, a, c, 0, 0, 0);
}
__device__ __forceinline__ float sigmoid_fast(float v) { return __builtin_amdgcn_rcpf(1.0f + __builtin_amdgcn_exp2f(-1.4426950408889634f * v)); }
__device__ __forceinline__ float bf_lo(unsigned w) { return __builtin_bit_cast(float, w << 16); }
__device__ __forceinline__ float bf_hi(unsigned w) { return __builtin_bit_cast(float, w & 0xffff0000u); }
template <bool I8> struct EpiProjT {
    static constexpr bool PERM = true, AFTER_DRAIN = false;
    bf16_t* O; int ldc; const float* qk_gain  ; PG8_LAS float* xtab  ; float qscale; const float* sa; const float* sb;
    __device__ __forceinline__ bool resets(const Unit&) const { return true; }
    __device__ __forceinline__ void operator()(const typename AccT<I8>::type (&acc)[2][2][4][2], const Unit& u, int wr, int wc, int fr, int fq) const {
        const int pn = I8 ? map8(u.pn) : map16(u.pn);
        int kind, br = 0, isk = 0;
        if (pn >= 62) kind = 2;
        else if ((pn >= 12 && pn < 16) || (pn >= 22 && pn < 26) || (pn >= 38 && pn < 42) || pn >= 60) kind = 1;
        else if (pn < 8) { kind = 3; br = 0; isk = pn >= 4; }
        else if (pn >= 16 && pn < 21) { kind = 3; br = 1; isk = pn >= 20; }
        else if (pn >= 26 && pn < 34) { kind = 3; br = 2; isk = pn >= 30; }
        else if (pn >= 42 && pn < 54) { kind = 3; br = 3; isk = pn >= 48; }
        else kind = 0;
        const int row0 = u.pm * BM + wr * 64 + fr, cc0 = wc * 32 + 8 * fq, col0 = pn * BM + cc0;
        f32x4 sbv[2][2];
        if (I8) {
#pragma unroll
            for (int bj = 0; bj < 2; ++bj)
#pragma unroll
                for (int n = 0; n < 2; ++n) sbv[bj][n] = *(const f32x4*)(sb + u.pn * BM + cc0 + bj * HALF + 4 * n);
        }
        float sarr[2][4];
#pragma unroll
        for (int ai = 0; ai < 2; ++ai)
#pragma unroll
            for (int m = 0; m < 4; ++m) sarr[ai][m] = I8 ? sa[row0 + ai * HALF + m * 16] : 1.0f;
        if (I8) asm volatile("" ::: "memory");
#define EPV(ai, bj, m, n, sar) (I8 ? (f32x4){(float)acc[ai][bj][m][n][0], (float)acc[ai][bj][m][n][1], (float)acc[ai][bj][m][n][2], (float)acc[ai][bj][m][n][3]} * (sar) * sbv[bj][n] \
                                   : (f32x4){(float)acc[ai][bj][m][n][0], (float)acc[ai][bj][m][n][1], (float)acc[ai][bj][m][n][2], (float)acc[ai][bj][m][n][3]})
        if (kind != 3) {
#pragma unroll
            for (int ai = 0; ai < 2; ++ai)
#pragma unroll
                for (int m = 0; m < 4; ++m) { const int row = row0 + ai * HALF + m * 16; bf16_t* rowp = O + (size_t)row * ldc + col0; const float sar = sarr[ai][m];
#pragma unroll
                    for (int bj = 0; bj < 2; ++bj) { f32x4 v0 = EPV(ai, bj, m, 0, sar), v1 = EPV(ai, bj, m, 1, sar);
                        if (kind == 1) {
#pragma unroll
                            for (int e = 0; e < 4; ++e) { v0[e] *= sigmoid_fast(v0[e]); v1[e] *= sigmoid_fast(v1[e]); }
                        } else if (kind == 2) {
#pragma unroll
                            for (int e = 0; e < 4; ++e) { v0[e] = fminf(__builtin_amdgcn_exp2f(-1.4426950408889634f * v0[e]), 1e18f); v1[e] = fminf(__builtin_amdgcn_exp2f(-1.4426950408889634f * v1[e]), 1e18f); }
                        }
                        u32x4 w; w.x = cvt_pk_bf16(v0[0], v0[1]); w.y = cvt_pk_bf16(v0[2], v0[3]); w.z = cvt_pk_bf16(v1[0], v1[1]); w.w = cvt_pk_bf16(v1[2], v1[3]);
                        *(u32x4*)(rowp + bj * HALF) = w; } }
            return;
        }
#pragma unroll
        for (int ai = 0; ai < 2; ++ai)
#pragma unroll
            for (int m = 0; m < 4; ++m) { const float sar = sarr[ai][m];
#pragma unroll
                for (int bj = 0; bj < 2; ++bj) { const f32x4 a = EPV(ai, bj, m, 0, sar), b = EPV(ai, bj, m, 1, sar);
                    float s = (a[0] * a[0] + a[1] * a[1]) + (a[2] * a[2] + a[3] * a[3]) + (b[0] * b[0] + b[1] * b[1]) + (b[2] * b[2] + b[3] * b[3]);
                    s += __builtin_bit_cast(float, __builtin_amdgcn_ds_bpermute(((fq * 16 + fr) ^ 16) << 2, __builtin_bit_cast(int, s)));
                    s += __builtin_bit_cast(float, __builtin_amdgcn_ds_bpermute(((fq * 16 + fr) ^ 32) << 2, __builtin_bit_cast(int, s)));
                    if (fq == 0) xtab[((ai * HALF + wr * 64 + m * 16 + fr) * 2 + bj) * 4 + wc] = s; } }
        asm volatile("s_waitcnt lgkmcnt(0)" ::: "memory"); __builtin_amdgcn_s_barrier(); asm volatile("" ::: "memory");
        const float* gp = qk_gain + (br * 2 + isk) * 128 + cc0;
        const f32x4 ga = *(const f32x4*)gp, gb = *(const f32x4*)(gp + 4);
        const float sc = isk ? 1.0f : qscale;
        float invf[4];
#pragma unroll
        for (int i = 0; i < 4; ++i) invf[i] = __builtin_amdgcn_exp2f(-(float)(((cc0 >> 1) + i) & 31) * (13.287712379549449f / 32.f));
#pragma unroll
        for (int ai = 0; ai < 2; ++ai)
#pragma unroll
            for (int m = 0; m < 4; ++m) { const int rl = ai * HALF + wr * 64 + m * 16 + fr; const int row = u.pm * BM + rl;
                bf16_t* rowp = O + (size_t)row * ldc + col0; const float sar = sarr[ai][m];
                const int spos = row & 4095; const float fpos = (wc < 2) ? (float)(spos >> 6) : (float)(spos & 63);
#pragma unroll
                for (int bj = 0; bj < 2; ++bj) { const f32x4 t = *(const PG8_LAS f32x4*)(xtab + (rl * 2 + bj) * 4);
                    const float rstd = sc / sqrtf(((t[0] + t[1]) + (t[2] + t[3])) * (1.0f / 128.0f) + 1e-6f);
                    f32x4 v0 = EPV(ai, bj, m, 0, sar) * rstd * ga, v1 = EPV(ai, bj, m, 1, sar) * rstd * gb;
                    if (br == 1) {
                        float x[8] = {v0[0], v0[1], v0[2], v0[3], v1[0], v1[1], v1[2], v1[3]};
#pragma unroll
                        for (int i = 0; i < 4; ++i) { const float rev = __builtin_amdgcn_fractf(fpos * invf[i] * 0.15915494309189535f);
                            const float sn = __builtin_amdgcn_sinf(rev), cs = __builtin_amdgcn_cosf(rev);
                            const float x1 = x[2 * i], x2 = x[2 * i + 1]; x[2 * i] = x1 * cs - x2 * sn; x[2 * i + 1] = x1 * sn + x2 * cs; }
                        v0 = (f32x4){x[0], x[1], x[2], x[3]}; v1 = (f32x4){x[4], x[5], x[6], x[7]};
                    }
                    u32x4 w; w.x = cvt_pk_bf16(v0[0], v0[1]); w.y = cvt_pk_bf16(v0[2], v0[3]); w.z = cvt_pk_bf16(v1[0], v1[1]); w.w = cvt_pk_bf16(v1[2], v1[3]);
                    *(u32x4*)(rowp + bj * HALF) = w; } }
#undef EPV
    }
};
struct EpiChain {
    static constexpr bool PERM = true, AFTER_DRAIN = false;
    const bf16_t* G; int ldg; bf16_t* Mg; int ldm; int rot;
    __device__ __forceinline__ bool resets(const Unit& u) const { return u.seg == 3; }
    __device__ __forceinline__ void operator()(f32x4 (&acc)[2][2][4][2], const Unit& u, int wr, int wc, int fr, int fq) const {
        const int row0 = u.pm * BM + wr * 64 + fr, col0 = u.pn * BM + wc * 32 + 8 * fq, seg = u.seg;
        const int bcur = (seg + 3 * rot) & 3, bnxt = (seg + 1 + 3 * rot) & 3;
        const bf16_t* Gs = G + (size_t)bcur * 4096;
        const bool lastseg = seg == 3;
        const int nxo = lastseg ? 0 : (bnxt - bcur) * 4096;
#pragma unroll
        for (int ai = 0; ai < 2; ++ai) {
            u32x4 gw[4][2], nw[4][2];
#pragma unroll
            for (int m = 0; m < 4; ++m) { const size_t row = (size_t)(row0 + ai * HALF + m * 16);
#pragma unroll
                for (int bj = 0; bj < 2; ++bj) { gw[m][bj] = *(const u32x4*)(Gs + row * ldg + col0 + bj * HALF); nw[m][bj] = *(const u32x4*)(Gs + nxo + row * ldg + col0 + bj * HALF); } }
            asm volatile("" ::: "memory");
#pragma unroll
            for (int m = 0; m < 4; ++m) { const size_t row = (size_t)(row0 + ai * HALF + m * 16);
#pragma unroll
                for (int bj = 0; bj < 2; ++bj) { const u32x4 g = gw[m][bj], q = nw[m][bj];
                    float f[8] = {bf_lo(g.x), bf_hi(g.x), bf_lo(g.y), bf_hi(g.y), bf_lo(g.z), bf_hi(g.z), bf_lo(g.w), bf_hi(g.w)};
                    const float d[8] = {bf_lo(q.x), bf_hi(q.x), bf_lo(q.y), bf_hi(q.y), bf_lo(q.z), bf_hi(q.z), bf_lo(q.w), bf_hi(q.w)};
#pragma unroll
                    for (int e = 0; e < 8; ++e) { const float r = __builtin_amdgcn_rcpf(1.0f + f[e]); f[e] = lastseg ? r : (1.0f + d[e]) * r; }
                    f32x4 v0 = acc[ai][bj][m][0], v1 = acc[ai][bj][m][1];
                    v0[0] *= f[0]; v0[1] *= f[1]; v0[2] *= f[2]; v0[3] *= f[3]; v1[0] *= f[4]; v1[1] *= f[5]; v1[2] *= f[6]; v1[3] *= f[7];
                    acc[ai][bj][m][0] = v0; acc[ai][bj][m][1] = v1;
                    if (lastseg) { u32x4 w; w.x = cvt_pk_bf16(v0[0], v0[1]); w.y = cvt_pk_bf16(v0[2], v0[3]); w.z = cvt_pk_bf16(v1[0], v1[1]); w.w = cvt_pk_bf16(v1[2], v1[3]);
                        *(u32x4*)(Mg + row * ldm + col0 + bj * HALF) = w; } } }
            asm volatile("" ::: "memory");
        }
    }
};
struct EpiRes {
    static constexpr bool PERM = false, AFTER_DRAIN = false;
    const float* base; float* out; int ldc;
    __device__ __forceinline__ bool resets(const Unit&) const { return true; }
    __device__ __forceinline__ void operator()(const f32x4 (&acc)[2][2][4][2], const Unit& u, int wr, int wc, int fr, int fq) const {
        const int col0 = u.pn * BM + wc * 32 + 4 * fq;
#pragma unroll
        for (int ai = 0; ai < 2; ++ai) {
            f32x4 pre[4][2][2];
#pragma unroll
            for (int m = 0; m < 4; ++m) { const size_t off = (size_t)(u.pm * BM + ai * HALF + wr * 64 + m * 16 + fr) * ldc + col0;
#pragma unroll
                for (int bj = 0; bj < 2; ++bj)
#pragma unroll
                    for (int n = 0; n < 2; ++n) pre[m][bj][n] = *(const f32x4*)(base + off + bj * HALF + n * 16); }
            asm volatile("" ::: "memory");
#pragma unroll
            for (int m = 0; m < 4; ++m) { const size_t off = (size_t)(u.pm * BM + ai * HALF + wr * 64 + m * 16 + fr) * ldc + col0;
#pragma unroll
                for (int bj = 0; bj < 2; ++bj)
#pragma unroll
                    for (int n = 0; n < 2; ++n) *(f32x4*)(out + off + bj * HALF + n * 16) = pre[m][bj][n] + acc[ai][bj][m][n]; }
            asm volatile("" ::: "memory");
        }
    }
};
struct EpiRes8 {
    static constexpr bool PERM = false, AFTER_DRAIN = false;
    const float* base; float* out; int ldc; const float* sm; const float* so;
    __device__ __forceinline__ bool resets(const Unit&) const { return true; }
    __device__ __forceinline__ void operator()(const i32x4 (&acc)[2][2][4][2], const Unit& u, int wr, int wc, int fr, int fq) const {
        const int col0 = u.pn * BM + wc * 32 + 4 * fq;
        f32x4 sov[2][2];
#pragma unroll
        for (int bj = 0; bj < 2; ++bj)
#pragma unroll
            for (int n = 0; n < 2; ++n) sov[bj][n] = *(const f32x4*)(so + col0 + bj * HALF + n * 16);
#pragma unroll
        for (int ai = 0; ai < 2; ++ai) {
            f32x4 pre[4][2][2]; float smr[4];
#pragma unroll
            for (int m = 0; m < 4; ++m) { const int row = u.pm * BM + ai * HALF + wr * 64 + m * 16 + fr; const size_t off = (size_t)row * ldc + col0; smr[m] = sm[row];
#pragma unroll
                for (int bj = 0; bj < 2; ++bj)
#pragma unroll
                    for (int n = 0; n < 2; ++n) pre[m][bj][n] = *(const f32x4*)(base + off + bj * HALF + n * 16); }
            asm volatile("" ::: "memory");
#pragma unroll
            for (int m = 0; m < 4; ++m) { const size_t off = (size_t)(u.pm * BM + ai * HALF + wr * 64 + m * 16 + fr) * ldc + col0;
#pragma unroll
                for (int bj = 0; bj < 2; ++bj)
#pragma unroll
                    for (int n = 0; n < 2; ++n) { const i32x4 a = acc[ai][bj][m][n]; f32x4 v; v[0] = (float)a[0]; v[1] = (float)a[1]; v[2] = (float)a[2]; v[3] = (float)a[3];
                        *(f32x4*)(out + off + bj * HALF + n * 16) = pre[m][bj][n] + v * smr[m] * sov[bj][n]; } }
            asm volatile("" ::: "memory");
        }
    }
};

template <class Epi, class Sched, bool ALIGN_EPI = false, bool SP2 = false, class GemmT = Gemm, bool I8 = false>
__device__ __forceinline__ void gemm_phase(PG8_LAS unsigned char* lds, const GemmT g, const Sched& S, const Epi& E, const int wave_in) {
    int tid_ = fresh_tid(wave_in); asm volatile("" : "+v"(tid_));
    const int tid = tid_, wid = __builtin_amdgcn_readfirstlane(tid >> 6), lane = tid & 63, wr = wid >> 2, wc = wid & 3, fr = lane & 15, fq = lane >> 4;
    const int K = g.pitch();
    unsigned voffA[2], voffB[2];
#pragma unroll
    for (int i = 0; i < 2; ++i) { int R, C; stage_rc(tid * 16 + i * 8192, R, C); const int Rb = Epi::PERM ? ((R & ~31) + perm32(R & 31)) : R;
        voffA[i] = (unsigned)(R * K + C) * 2u; voffB[i] = (unsigned)(Rb * K + C) * 2u; }
    const size_t kstep = (size_t)(BK * 2);
    const size_t hstep = (size_t)HALF * K * 2;
    const size_t tstep = 2 * hstep;
    const unsigned ldsw = (unsigned)wid * 1024u;
    const int aoff = lds_byte(wr * 64 + fr, fq * 8), boff = lds_byte(wc * 32 + fr, fq * 8);
#define PG8_SA(b, h) (((b) * 2 + (h)) * HTB)
#define PG8_SB(b, h) ((4 + (b) * 2 + (h)) * HTB)
#define PG8_STAGE(bufoff, gbase, voff) do { _Pragma("unroll") for (int _i = 0; _i < 2; ++_i) \
        __builtin_amdgcn_global_load_lds((const unsigned*)((const char*)(gbase) + (voff)[_i]), (PG8_LAS unsigned*)(lds + (bufoff) + ldsw + _i * 8192), 16, 0, 0); } while (0)
#define PG8_LDA(dst, b, h) do { _Pragma("unroll") for (int m = 0; m < 4; ++m) _Pragma("unroll") for (int k = 0; k < 2; ++k) dst[m][k] = *(const PG8_LAS bf16x8*)(lds + PG8_SA(b, h) + aoff + m * 2048 + k * 1024); } while (0)
#define PG8_LDB(dst, b, h) do { _Pragma("unroll") for (int n = 0; n < 2; ++n) _Pragma("unroll") for (int k = 0; k < 2; ++k) dst[n][k] = *(const PG8_LAS bf16x8*)(lds + PG8_SB(b, h) + boff + n * 2048 + k * 1024); } while (0)
#define PG8_MMA(ai, bj, At, Bt) do { __builtin_amdgcn_s_setprio(1); _Pragma("unroll") for (int m = 0; m < 4; ++m) _Pragma("unroll") for (int n = 0; n < 2; ++n) _Pragma("unroll") for (int k = 0; k < 2; ++k) \
        acc[ai][bj][m][n] = mma1<I8>(Bt[n][k], At[m][k], acc[ai][bj][m][n]); __builtin_amdgcn_s_setprio(0); } while (0)
#define PG8_WAIT_V(n) asm volatile("s_waitcnt vmcnt(" #n ")" ::: "memory")
#define PG8_WAIT_L(n) asm volatile("s_waitcnt lgkmcnt(" #n ")" ::: "memory")
#define PG8_BAR __builtin_amdgcn_s_barrier()
#define PG8_SCHED __builtin_amdgcn_sched_barrier(0)
    Unit cur, nxt; int ui = 0;
    if (!S.next(0, cur)) return;
    int nt = g.ntiles(cur);
    typedef typename AccT<I8>::type acc_t;
    acc_t acc[2][2][4][2];
#pragma unroll
    for (int a = 0; a < 2; ++a)
#pragma unroll
        for (int b = 0; b < 2; ++b)
#pragma unroll
            for (int m = 0; m < 4; ++m)
#pragma unroll
                for (int n = 0; n < 2; ++n) acc[a][b][m][n] = acc_t{};
    bf16x8 At[4][2], B0[2][2], B1[2][2];
    const char* cA = g.a_base(cur, tstep); const char* cB = g.b_base(cur, tstep);
    S.a_ready(cur);
    if constexpr (SP2) {
        PG8_STAGE(PG8_SB(0, 0), cB, voffB); PG8_STAGE(PG8_SB(0, 1), cB + hstep, voffB); PG8_STAGE(PG8_SA(0, 0), cA, voffA); PG8_STAGE(PG8_SA(0, 1), cA + hstep, voffA);
        if (wr == 1) PG8_BAR;
        PG8_WAIT_V(2); PG8_BAR;
        PG8_STAGE(PG8_SB(1, 0), cB + kstep, voffB); PG8_STAGE(PG8_SA(1, 0), cA + kstep, voffA); PG8_STAGE(PG8_SB(1, 1), cB + hstep + kstep, voffB);
        PG8_WAIT_V(6); PG8_BAR;
    } else {
        PG8_STAGE(PG8_SB(0, 0), cB, voffB); PG8_STAGE(PG8_SA(0, 0), cA, voffA); PG8_STAGE(PG8_SB(0, 1), cB + hstep, voffB); PG8_STAGE(PG8_SA(0, 1), cA + hstep, voffA);
        if (wr == 1) PG8_BAR;
        PG8_WAIT_V(4); PG8_BAR;
        PG8_STAGE(PG8_SB(1, 0), cB + kstep, voffB); PG8_STAGE(PG8_SA(1, 0), cA + kstep, voffA); PG8_STAGE(PG8_SB(1, 1), cB + hstep + kstep, voffB);
        PG8_WAIT_V(6); PG8_BAR;
    }
    for (;;) {
        const bool has_next = S.next(ui + 1, nxt);
        const char* nA = has_next ? g.a_base(nxt, tstep) : cA; const char* nB = has_next ? g.b_base(nxt, tstep) : cB;
        for (int t = 0; t < nt; t += 2) {
            const bool last = (t == nt - 2);
            const char* a1 = cA + (size_t)(t + 1) * kstep;
            const char* a2 = last ? nA : cA + (size_t)(t + 2) * kstep; const char* b2 = last ? nB : cB + (size_t)(t + 2) * kstep;
            const char* a3 = a2 + kstep; const char* b3 = b2 + kstep;
            if (last && has_next) S.a_ready(nxt);
            if constexpr (SP2) {
            PG8_LDB(B0, 0, 0); PG8_LDB(B1, 0, 1); PG8_SCHED; PG8_LDA(At, 0, 0); PG8_STAGE(PG8_SA(1, 1), a1 + hstep, voffA);
            PG8_WAIT_V(8); PG8_WAIT_L(0); PG8_BAR; PG8_MMA(0, 0, At, B0); PG8_MMA(0, 1, At, B1); PG8_BAR; PG8_SCHED;
            PG8_LDA(At, 0, 1); PG8_STAGE(PG8_SB(0, 0), b2, voffB); PG8_STAGE(PG8_SB(0, 1), b2 + hstep, voffB); PG8_STAGE(PG8_SA(0, 0), a2, voffA);
            PG8_WAIT_V(8); PG8_WAIT_L(0); PG8_BAR; PG8_MMA(1, 0, At, B0); PG8_MMA(1, 1, At, B1); PG8_BAR; PG8_SCHED;
            PG8_LDB(B0, 1, 0); PG8_LDB(B1, 1, 1); PG8_SCHED; PG8_LDA(At, 1, 0); PG8_STAGE(PG8_SA(0, 1), a2 + hstep, voffA);
            PG8_WAIT_V(8); PG8_WAIT_L(0); PG8_BAR; PG8_MMA(0, 0, At, B0); PG8_MMA(0, 1, At, B1); PG8_BAR; PG8_SCHED;
            PG8_LDA(At, 1, 1); PG8_STAGE(PG8_SB(1, 0), b3, voffB); PG8_STAGE(PG8_SB(1, 1), b3 + hstep, voffB); PG8_STAGE(PG8_SA(1, 0), a3, voffA);
            PG8_WAIT_V(8); PG8_WAIT_L(0); PG8_BAR; PG8_MMA(1, 0, At, B0); PG8_MMA(1, 1, At, B1); PG8_BAR; PG8_SCHED;
            } else {
            PG8_LDB(B0, 0, 0); PG8_SCHED; PG8_LDA(At, 0, 0); PG8_STAGE(PG8_SA(1, 1), a1 + hstep, voffA);
            PG8_WAIT_L(8); PG8_BAR; PG8_WAIT_L(0); PG8_MMA(0, 0, At, B0); PG8_BAR; PG8_SCHED;
            PG8_LDB(B1, 0, 1); PG8_STAGE(PG8_SB(0, 0), b2, voffB);
            PG8_BAR; PG8_WAIT_L(0); PG8_MMA(0, 1, At, B1); PG8_BAR;
            PG8_LDA(At, 0, 1); PG8_STAGE(PG8_SA(0, 0), a2, voffA);
            PG8_BAR; PG8_WAIT_L(0); PG8_MMA(1, 0, At, B0); PG8_BAR; PG8_SCHED;
            PG8_STAGE(PG8_SB(0, 1), b2 + hstep, voffB);
            PG8_WAIT_V(6); PG8_BAR; PG8_MMA(1, 1, At, B1); PG8_BAR;
            PG8_LDB(B0, 1, 0); PG8_SCHED; PG8_LDA(At, 1, 0); PG8_STAGE(PG8_SA(0, 1), a2 + hstep, voffA);
            PG8_WAIT_L(8); PG8_BAR; PG8_WAIT_L(0); PG8_MMA(0, 0, At, B0); PG8_BAR; PG8_SCHED;
            PG8_LDB(B1, 1, 1); PG8_STAGE(PG8_SB(1, 0), b3, voffB);
            PG8_BAR; PG8_WAIT_L(0); PG8_MMA(0, 1, At, B1); PG8_BAR;
            PG8_LDA(At, 1, 1); PG8_STAGE(PG8_SA(1, 0), a3, voffA);
            PG8_BAR; PG8_WAIT_L(0); PG8_MMA(1, 0, At, B0); PG8_BAR; PG8_SCHED;
            PG8_STAGE(PG8_SB(1, 1), b3 + hstep, voffB);
            PG8_WAIT_V(6); PG8_BAR; PG8_MMA(1, 1, At, B1); PG8_BAR;
            }
        }
        if constexpr (ALIGN_EPI) { if (wr == 0) PG8_BAR; }
        if constexpr (!Epi::AFTER_DRAIN) { E(acc, cur, wr, wc, fr, fq); S.done(cur); }
        if (!has_next) break;
        if (E.resets(cur)) {
#pragma unroll
        for (int a = 0; a < 2; ++a)
#pragma unroll
            for (int b = 0; b < 2; ++b)
#pragma unroll
                for (int m = 0; m < 4; ++m)
#pragma unroll
                    for (int n = 0; n < 2; ++n) acc[a][b][m][n] = acc_t{};
        }
        cur = nxt; cA = nA; cB = nB; ++ui; nt = g.ntiles(cur);
        if constexpr (ALIGN_EPI) { if (wr == 1) PG8_BAR; }
    }
    PG8_WAIT_V(0);
    if constexpr (!ALIGN_EPI) { if (wr == 0) PG8_BAR; }
    PG8_BAR;
    if constexpr (Epi::AFTER_DRAIN) { E.fused(acc, cur, wr, wc, fr, fq, lds, wid, lane); S.done(cur); }
#undef PG8_SA
#undef PG8_SB
#undef PG8_STAGE
#undef PG8_LDA
#undef PG8_LDB
#undef PG8_MMA
#undef PG8_WAIT_V
#undef PG8_WAIT_L
#undef PG8_BAR
#undef PG8_SCHED
}
}
namespace att {
typedef unsigned short bf16;
using bf16x8 = __attribute__((ext_vector_type(8))) short;
using s16x4  = __attribute__((ext_vector_type(4))) short;
using f32x16 = __attribute__((ext_vector_type(16))) float;
using u32x4  = __attribute__((ext_vector_type(4))) unsigned;
constexpr int D = 128, NW = 8, QBLK = 32, KVBLK = 64;
constexpr int SHM_V = KVBLK * D * 2, SHM_K = KVBLK * D * 2;
constexpr int OFF_WS = 2 * SHM_V + 2 * SHM_K, OFF_TBL = OFF_WS + NW * 64 * 4, SHM_ATTN = OFF_TBL + 4096;
constexpr float THR2 = 8.f;
constexpr float LOG2E = 1.4426950408889634f;
enum { M_NA = 0, M_DENSE = 1, M_ALIBI = 2, M_DIL = 3 };
#define KSWZ(row, colB) ((row) * 256 + ((colB) ^ (((row) & 7) << 4)))
#define SBAR() __builtin_amdgcn_sched_barrier(0)
__device__ __forceinline__ int crow(int r, int hi) { return (r & 3) + 8 * (r >> 2) + 4 * hi; }
__device__ __forceinline__ unsigned cvtpk(float lo, float hi) { unsigned r; asm volatile("v_cvt_pk_bf16_f32 %0, %1, %2" : "=v"(r) : "v"(lo), "v"(hi)); return r; }
__device__ __forceinline__ unsigned short f2bf1(float f) { unsigned u = __builtin_bit_cast(unsigned, f); return (unsigned short)((u + 0x7fffu + ((u >> 16) & 1u)) >> 16); }
__device__ __forceinline__ float bf2f(unsigned short h) { return __builtin_bit_cast(float, (unsigned)h << 16); }

__device__ __forceinline__ void partialSM(f32x16& p0, f32x16& p1, float& m_reg, float& mn, float& alpha) {
  float pmax = p0[0];
#pragma unroll
  for (int r = 1; r < 16; ++r) pmax = fmaxf(pmax, p0[r]);
#pragma unroll
  for (int r = 0; r < 16; ++r) pmax = fmaxf(pmax, p1[r]);
  { auto rr = __builtin_amdgcn_permlane32_swap(__float_as_uint(pmax), __float_as_uint(pmax), false, false);
    pmax = fmaxf(__uint_as_float(rr[0]), __uint_as_float(rr[1])); }
  if (__builtin_expect(__all(pmax - m_reg <= THR2), 1)) { mn = m_reg; alpha = 1.f; }
  else { mn = fmaxf(m_reg, pmax); alpha = __builtin_amdgcn_exp2f(m_reg - mn); m_reg = mn; }
#pragma unroll
  for (int r = 0; r < 16; ++r) p0[r] = p0[r] - mn;
#pragma unroll
  for (int r = 0; r < 16; ++r) p1[r] = p1[r] - mn;
#pragma unroll
  for (int r = 0; r < 16; ++r) p0[r] = __builtin_amdgcn_exp2f(p0[r]);
}
__device__ __forceinline__ void finishSM(f32x16& p0, f32x16& p1, float alpha, float& l_reg, bf16x8& pa0, bf16x8& pa1, bf16x8& pa2, bf16x8& pa3) {
#pragma unroll
  for (int r = 0; r < 16; ++r) p1[r] = __builtin_amdgcn_exp2f(p1[r]);
  float ps = 0;
#pragma unroll
  for (int r = 0; r < 16; ++r) ps += p0[r];
#pragma unroll
  for (int r = 0; r < 16; ++r) ps += p1[r];
  { auto rr = __builtin_amdgcn_permlane32_swap(__float_as_uint(ps), __float_as_uint(ps), false, false);
    ps = __uint_as_float(rr[0]) + __uint_as_float(rr[1]); }
  l_reg = l_reg * alpha + ps;
#define PK4(P, BASE, OUT) do { unsigned a0 = cvtpk(P[BASE + 0], P[BASE + 1]), a1 = cvtpk(P[BASE + 2], P[BASE + 3]);   \
    unsigned b0 = cvtpk(P[BASE + 4], P[BASE + 5]), b1 = cvtpk(P[BASE + 6], P[BASE + 7]);                              \
    auto r0 = __builtin_amdgcn_permlane32_swap(a0, b0, false, false); auto r1 = __builtin_amdgcn_permlane32_swap(a1, b1, false, false); \
    u32x4 w = {r0[0], r1[0], r0[1], r1[1]}; OUT = *reinterpret_cast<bf16x8*>(&w); } while (0)
  PK4(p0, 0, pa0); PK4(p0, 8, pa1); PK4(p1, 0, pa2); PK4(p1, 8, pa3);
#undef PK4
}
__device__ __forceinline__ void qkt(f32x16& p0, f32x16& p1, const bf16* Ks, const bf16x8* qr, int r32, int hi) {
  p0 = f32x16{}; p1 = f32x16{};
#pragma unroll
  for (int d0 = 0; d0 < 8; ++d0) { int cb = (d0 * 16 + hi * 8) * 2;
    bf16x8 b0 = *reinterpret_cast<const bf16x8*>((const char*)Ks + KSWZ(r32, cb));
    bf16x8 b1 = *reinterpret_cast<const bf16x8*>((const char*)Ks + KSWZ(32 + r32, cb));
    p0 = __builtin_amdgcn_mfma_f32_32x32x16_bf16(b0, qr[d0], p0, 0, 0, 0);
    p1 = __builtin_amdgcn_mfma_f32_32x32x16_bf16(b1, qr[d0], p1, 0, 0, 0); }
}
__device__ __forceinline__ int v_st(int k, int c) { const int kk = (k & ~0xC) | ((k & 4) << 1) | ((k & 8) >> 1); return ((kk >> 3) * 4 + (c >> 5)) * 512 + ((kk & 7) * 32 + (c & 31)) * 2; }
__device__ __forceinline__ int v_rd_base(int lane) { return ((lane & 3) << 3) | (((lane >> 2) & 3) << 6) | (((lane >> 4) & 1) << 5) | (((lane >> 5) & 1) << 8); }
constexpr int v_rd_off(int d0, int ks, int half) { return d0 * 512 + ks * 4096 + half * 2048; }
template <int OFF> __device__ __forceinline__ s16x4 tr_read(int vb) {
  s16x4 r; asm volatile("ds_read_b64_tr_b16 %0, %1 offset:%2" : "=&v"(r) : "v"(vb), "i"(OFF) : "memory"); return r;
}
template <int D0> __device__ __forceinline__ void pv_one(f32x16& od, int vb, bf16x8 pa0, bf16x8 pa1, bf16x8 pa2, bf16x8 pa3) {
  const s16x4 l0 = tr_read<v_rd_off(D0, 0, 0)>(vb), h0 = tr_read<v_rd_off(D0, 0, 1)>(vb), l1 = tr_read<v_rd_off(D0, 1, 0)>(vb), h1 = tr_read<v_rd_off(D0, 1, 1)>(vb);
  const s16x4 l2 = tr_read<v_rd_off(D0, 2, 0)>(vb), h2 = tr_read<v_rd_off(D0, 2, 1)>(vb), l3 = tr_read<v_rd_off(D0, 3, 0)>(vb), h3 = tr_read<v_rd_off(D0, 3, 1)>(vb);
  asm volatile("s_waitcnt lgkmcnt(0)" ::: "memory"); SBAR();
#define PK(L, H) (bf16x8){L[0], L[1], L[2], L[3], H[0], H[1], H[2], H[3]}
  od = __builtin_amdgcn_mfma_f32_32x32x16_bf16(pa0, PK(l0, h0), od, 0, 0, 0);
  od = __builtin_amdgcn_mfma_f32_32x32x16_bf16(pa1, PK(l1, h1), od, 0, 0, 0);
  od = __builtin_amdgcn_mfma_f32_32x32x16_bf16(pa2, PK(l2, h2), od, 0, 0, 0);
  od = __builtin_amdgcn_mfma_f32_32x32x16_bf16(pa3, PK(l3, h3), od, 0, 0, 0);
#undef PK
}
template <int D0> __device__ __forceinline__ void pv_one_lean(f32x16& od, int vb, bf16x8 pa0, bf16x8 pa1, bf16x8 pa2, bf16x8 pa3) {
#define PK(L, H) (bf16x8){L[0], L[1], L[2], L[3], H[0], H[1], H[2], H[3]}
  { const s16x4 l0 = tr_read<v_rd_off(D0, 0, 0)>(vb), h0 = tr_read<v_rd_off(D0, 0, 1)>(vb), l1 = tr_read<v_rd_off(D0, 1, 0)>(vb), h1 = tr_read<v_rd_off(D0, 1, 1)>(vb);
    asm volatile("s_waitcnt lgkmcnt(0)" ::: "memory"); SBAR();
    od = __builtin_amdgcn_mfma_f32_32x32x16_bf16(pa0, PK(l0, h0), od, 0, 0, 0);
    od = __builtin_amdgcn_mfma_f32_32x32x16_bf16(pa1, PK(l1, h1), od, 0, 0, 0); }
  { const s16x4 l2 = tr_read<v_rd_off(D0, 2, 0)>(vb), h2 = tr_read<v_rd_off(D0, 2, 1)>(vb), l3 = tr_read<v_rd_off(D0, 3, 0)>(vb), h3 = tr_read<v_rd_off(D0, 3, 1)>(vb);
    asm volatile("s_waitcnt lgkmcnt(0)" ::: "memory"); SBAR();
    od = __builtin_amdgcn_mfma_f32_32x32x16_bf16(pa2, PK(l2, h2), od, 0, 0, 0);
    od = __builtin_amdgcn_mfma_f32_32x32x16_bf16(pa3, PK(l3, h3), od, 0, 0, 0); }
#undef PK
}
__device__ __forceinline__ void pv_d0_lean(f32x16* o, int vb, bf16x8 pa0, bf16x8 pa1, bf16x8 pa2, bf16x8 pa3) {
  pv_one_lean<0>(o[0], vb, pa0, pa1, pa2, pa3); pv_one_lean<1>(o[1], vb, pa0, pa1, pa2, pa3); pv_one_lean<2>(o[2], vb, pa0, pa1, pa2, pa3); pv_one_lean<3>(o[3], vb, pa0, pa1, pa2, pa3);
}
__device__ __forceinline__ void pv_d0(f32x16* o, int vb, bf16x8 pa0, bf16x8 pa1, bf16x8 pa2, bf16x8 pa3) {
  pv_one<0>(o[0], vb, pa0, pa1, pa2, pa3); pv_one<1>(o[1], vb, pa0, pa1, pa2, pa3); pv_one<2>(o[2], vb, pa0, pa1, pa2, pa3); pv_one<3>(o[3], vb, pa0, pa1, pa2, pa3);
}

struct UA {
  const bf16* Q; long ldq;
  const bf16* K; const bf16* V; long ldk;
  int NT;
  int j0;
  int qk0;
  float slope2;
  int qrow0, krow0;
  const float* tbl;
  bf16* Y; long ldy; const bf16* Z; long ldz;
  float* O; long ldo;
  float* L; long ldl;
};

template <int MODE, int SDEPTH>
__device__ __forceinline__ void attn_unit(const UA& a, char* lds, const int wave_in) {
  int tid_ = fresh_tid(wave_in); asm volatile("" : "+v"(tid_));
  const int tid = tid_, wid = __builtin_amdgcn_readfirstlane(tid >> 6), lane = tid & 63, r32 = lane & 31, hi = lane >> 5;
  bf16* V_lds = (bf16*)lds; bf16* K_lds = (bf16*)(lds + 2 * SHM_V);
  float* ws = (float*)(lds + OFF_WS) + wid * 64; float* li_l = ws; float* al_l = ws + 32;
  float* tbl = (float*)(lds + OFF_TBL) + 64;
  if (MODE == M_NA) { __syncthreads(); for (int i = tid; i < 15 * 31; i += 512) tbl[i] = a.tbl[i] * LOG2E; }
  float m_reg = -1e30f, l_reg = 0; f32x16 o[4] = {}; bf16x8 qr[8];
  const bf16* Qw = a.Q + (long)(wid * QBLK + r32) * a.ldq + hi * 8;
#pragma unroll
  for (int d0 = 0; d0 < 8; ++d0) qr[d0] = *reinterpret_cast<const bf16x8*>(Qw + d0 * 16);
  const int sr = tid >> 4, sc = (tid & 15) * 8, vst0 = v_st(sr, sc), vst1 = v_st(32 + sr, sc);
  const int vb0 = (int)(uintptr_t)V_lds + v_rd_base(lane);
  const bf16* Kh = a.K; const bf16* Vh = a.V; const long LDK = a.ldk;
  struct { bf16x8 vs0, vs1, ks0, ks1; } sr_[SDEPTH];
#define SLOAD(i, k0) do { sr_[i].vs0 = *reinterpret_cast<const bf16x8*>(&Vh[(long)((k0) + sr) * LDK + sc]); sr_[i].vs1 = *reinterpret_cast<const bf16x8*>(&Vh[(long)((k0) + 32 + sr) * LDK + sc]); \
    sr_[i].ks0 = *reinterpret_cast<const bf16x8*>(&Kh[(long)((k0) + sr) * LDK + sc]); sr_[i].ks1 = *reinterpret_cast<const bf16x8*>(&Kh[(long)((k0) + 32 + sr) * LDK + sc]); } while (0)
#define SWRITE(b, i) do { *(bf16x8*)((char*)V_lds + (b) * SHM_V + vst0) = sr_[i].vs0;          \
    *(bf16x8*)((char*)V_lds + (b) * SHM_V + vst1) = sr_[i].vs1; int kc = sc * 2;               \
    *(bf16x8*)((char*)K_lds + (b) * SHM_K + KSWZ(sr, kc)) = sr_[i].ks0;                       \
    *(bf16x8*)((char*)K_lds + (b) * SHM_K + KSWZ(32 + sr, kc)) = sr_[i].ks1; } while (0)
#define SWAIT() do { if constexpr (SDEPTH == 2) asm volatile("s_waitcnt vmcnt(4)" ::: "memory"); else asm volatile("s_waitcnt vmcnt(0)" ::: "memory"); } while (0)
#define RESC(a_) do { if (__any((a_) < 1.f)) { if (hi == 0) al_l[r32] = (a_); asm volatile("s_waitcnt lgkmcnt(0)" ::: "memory"); \
    _Pragma("unroll") for (int d = 0; d < 4; ++d) _Pragma("unroll") for (int r = 0; r < 16; ++r) o[d][r] *= al_l[crow(r, hi)]; } } while (0)
  const float NEG_INF = -__builtin_inff();
  const int qkrel = a.qk0 + wid * 32 + r32 - 4 * hi;
  const float nslope = -a.slope2;
  const int qgr = a.qrow0 + (wid >> 1), cq = 32 * (wid & 1) + r32;
  const int c0 = min(max(cq - 8, 0), 48), r0 = min(max(qgr - 4, 0), 56);
#define MOD(P0, P1, J) do { \
    if (MODE == M_ALIBI || MODE == M_DIL) { const float rel = (float)(qkrel - (J) * 64); \
      _Pragma("unroll") for (int r = 0; r < 16; ++r) { const float cr = (float)((r & 3) + 8 * (r >> 2)); const float d0_ = fabsf(rel - cr), d1_ = fabsf(rel - cr - 32.f); \
        float v0_ = fmaf(nslope, d0_, P0[r]), v1_ = fmaf(nslope, d1_, P1[r]); \
        if (MODE == M_DIL) { v0_ = (d0_ <= 64.f) ? v0_ : NEG_INF; v1_ = (d1_ <= 64.f) ? v1_ : NEG_INF; } \
        P0[r] = v0_; P1[r] = v1_; } } \
    if (MODE == M_NA) { const int kr = a.krow0 + (J); const bool rv = (kr >= r0) && (kr < r0 + 8); \
      if (!rv) { _Pragma("unroll") for (int r = 0; r < 16; ++r) { P0[r] = NEG_INF; P1[r] = NEG_INF; } } \
      else { const float* tp = tbl + (kr - qgr + 7) * 31 + (4 * hi - cq + 15); const int kcb = 4 * hi - c0; \
        _Pragma("unroll") for (int r = 0; r < 16; ++r) { const int cr = (r & 3) + 8 * (r >> 2); \
          const bool ok0 = (unsigned)(kcb + cr) < 16u, ok1 = (unsigned)(kcb + cr + 32) < 16u; \
          const float b0_ = tp[cr], b1_ = tp[cr + 32]; \
          P0[r] = ok0 ? P0[r] + b0_ : NEG_INF; P1[r] = ok1 ? P1[r] + b1_ : NEG_INF; } } } \
  } while (0)
  f32x16 pA0, pA1, pB0, pB1; float mnA, mnB, alA, alB; bf16x8 pa0, pa1, pa2, pa3; const int NT = a.NT;
  constexpr int SE = 0, SO = SDEPTH - 1;
  SLOAD(SE, 0); asm volatile("s_waitcnt vmcnt(0)" ::: "memory"); SWRITE(0, SE); __syncthreads();
  qkt(pA0, pA1, K_lds, qr, r32, hi); MOD(pA0, pA1, 0); partialSM(pA0, pA1, m_reg, mnA, alA);
  SLOAD(SO, KVBLK); if constexpr (SDEPTH == 2) { if (2 < NT) SLOAD(SE, 2 * KVBLK); }
  SWAIT(); SWRITE(1, SO); __syncthreads();
  for (int j = 1; j + 1 < NT; j += 2) {
    SBAR(); qkt(pB0, pB1, (bf16*)((char*)K_lds + SHM_K), qr, r32, hi); MOD(pB0, pB1, j);
    finishSM(pA0, pA1, alA, l_reg, pa0, pa1, pa2, pa3); SBAR();
    SLOAD(SO, (j + SDEPTH) * KVBLK); SBAR();
    pv_d0(o, vb0, pa0, pa1, pa2, pa3); partialSM(pB0, pB1, m_reg, mnB, alB);
    __syncthreads(); SWAIT(); SWRITE(0, SE);
    RESC(alB); __syncthreads();
    SBAR(); qkt(pA0, pA1, K_lds, qr, r32, hi); MOD(pA0, pA1, j + 1);
    finishSM(pB0, pB1, alB, l_reg, pa0, pa1, pa2, pa3); SBAR();
    if (SDEPTH == 1 || j + 3 < NT) SLOAD(SE, (j + 1 + SDEPTH) * KVBLK); SBAR();
    pv_d0(o, vb0 + (int)SHM_V, pa0, pa1, pa2, pa3); partialSM(pA0, pA1, m_reg, mnA, alA);
    __syncthreads(); SWAIT(); SWRITE(1, SO);
    RESC(alA); __syncthreads();
  }
  SBAR(); qkt(pB0, pB1, (bf16*)((char*)K_lds + SHM_K), qr, r32, hi); MOD(pB0, pB1, NT - 1);
  finishSM(pA0, pA1, alA, l_reg, pa0, pa1, pa2, pa3); SBAR();
  pv_d0(o, vb0, pa0, pa1, pa2, pa3); partialSM(pB0, pB1, m_reg, mnB, alB);
  __syncthreads(); RESC(alB);
  finishSM(pB0, pB1, alB, l_reg, pa0, pa1, pa2, pa3); SBAR();
  pv_d0(o, vb0 + (int)SHM_V, pa0, pa1, pa2, pa3);
  if (hi == 0) li_l[r32] = l_reg; asm volatile("s_waitcnt lgkmcnt(0)" ::: "memory");
  float rli[16];
#pragma unroll
  for (int r = 0; r < 16; ++r) rli[r] = __builtin_amdgcn_rcpf(li_l[crow(r, hi)]);
  if (MODE == M_NA || MODE == M_DENSE) {
    bf16 zz[16][4];
#pragma unroll
    for (int r = 0; r < 16; ++r) { const long orow = wid * QBLK + crow(r, hi);
#pragma unroll
      for (int d0 = 0; d0 < 4; ++d0) zz[r][d0] = a.Z[orow * a.ldz + d0 * 32 + r32]; }
#pragma unroll
    for (int r = 0; r < 16; ++r) { const long orow = wid * QBLK + crow(r, hi);
#pragma unroll
      for (int d0 = 0; d0 < 4; ++d0) a.Y[orow * a.ldy + d0 * 32 + r32] = f2bf1(o[d0][r] * rli[r] * bf2f(zz[r][d0])); }
  } else {
#pragma unroll
    for (int r = 0; r < 16; ++r) { const long orow = wid * QBLK + crow(r, hi);
#pragma unroll
      for (int d0 = 0; d0 < 4; ++d0) a.O[orow * a.ldo + d0 * 32 + r32] = o[d0][r] * rli[r]; }
    if (MODE == M_DIL) { if (hi == 0) a.L[(long)(wid * QBLK + r32) * a.ldl] = m_reg + __builtin_amdgcn_logf(l_reg); }
  }
#undef SLOAD
#undef SWRITE
#undef SWAIT
#undef RESC
#undef MOD
}

#define ATT_LAS __attribute__((address_space(3)))
#ifndef PINGPONG_SPLIT
#define PINGPONG_SPLIT 4
#endif
template <int MODE, int NVH>
__device__ __forceinline__ void attn_unit_dma(const UA& a, char* lds, int wsoff, const int wave_in) {
  int tid_ = fresh_tid(wave_in); asm volatile("" : "+v"(tid_));
  const int tid = tid_, wid = __builtin_amdgcn_readfirstlane(tid >> 6), lane = tid & 63, r32 = lane & 31, hi = lane >> 5;
  constexpr int KB = 16384, VB = NVH * 16384, OFF_V2 = 2 * KB;
  char* K_lds = lds;
  float* ws = (float*)(lds + wsoff) + wid * 64; float* li_l = ws; float* al_l = ws + 32;
  float* tbl = (float*)(lds + wsoff + 2048) + 64;
  if (MODE == M_NA) { for (int i = tid; i < 15 * 31; i += 512) tbl[i] = a.tbl[i] * LOG2E; }
  float m_reg = -1e30f, l_reg = 0; f32x16 o[4 * NVH]; bf16x8 qr[8];
#pragma unroll
  for (int d = 0; d < 4 * NVH; ++d) o[d] = f32x16{};
  const bf16* Qw = a.Q + (long)(wid * QBLK + r32) * a.ldq + hi * 8;
#pragma unroll
  for (int d0 = 0; d0 < 8; ++d0) qr[d0] = *reinterpret_cast<const bf16x8*>(Qw + d0 * 16);
  const int vb0 = (int)(uintptr_t)(lds + OFF_V2) + v_rd_base(lane);
  const unsigned ldkb = (unsigned)(a.ldk * 2);
  unsigned koff[2], voff[2 * NVH];
#pragma unroll
  for (int i = 0; i < 2; ++i) { const int row = (wid * 2 + i) * 4 + (lane >> 4), c = (lane & 15) ^ (row & 7); koff[i] = (unsigned)row * ldkb + (unsigned)c * 16u; }
#pragma unroll
  for (int i = 0; i < 2 * NVH; ++i) { const int vb = wid * 2 * NVH + i, half = vb >> 4, b = (vb & 15) * 1024 + lane * 16;
    const int sub = b >> 9, e = (b & 511) >> 1, kk = (sub >> 2) * 8 + (e >> 5), c = (sub & 3) * 32 + (e & 31);
    const int k = (kk & ~0xC) | ((kk & 4) << 1) | ((kk & 8) >> 1);
    voff[i] = (unsigned)k * ldkb + (unsigned)(half * 128 + c) * 2u; }
  const char* Kb = (const char*)a.K; const char* Vb = (const char*)a.V; const size_t tstep = (size_t)KVBLK * ldkb;
  ATT_LAS unsigned char* ldl = (ATT_LAS unsigned char*)lds;
#define TROT(j) (((j) + a.j0 >= NT) ? (j) + a.j0 - NT : (j) + a.j0)
#define DMA(j, ks, vs) do { const int jt_ = TROT(j); const char* kt_ = Kb + (size_t)jt_ * tstep; const char* vt_ = Vb + (size_t)jt_ * tstep; \
    _Pragma("unroll") for (int i_ = 0; i_ < 2; ++i_) __builtin_amdgcn_global_load_lds((const unsigned*)(kt_ + koff[i_]), (ATT_LAS unsigned*)(ldl + (ks) * KB + (wid * 2 + i_) * 1024), 16, 0, 0); \
    _Pragma("unroll") for (int i_ = 0; i_ < 2 * NVH; ++i_) __builtin_amdgcn_global_load_lds((const unsigned*)(vt_ + voff[i_]), (ATT_LAS unsigned*)(ldl + OFF_V2 + (vs) * VB + (wid * 2 * NVH + i_) * 1024), 16, 0, 0); } while (0)
#define RESC(a_) do { if (__any((a_) < 1.f)) { if (hi == 0) al_l[r32] = (a_); asm volatile("s_waitcnt lgkmcnt(0)" ::: "memory"); \
    _Pragma("unroll") for (int d = 0; d < 4 * NVH; ++d) _Pragma("unroll") for (int r = 0; r < 16; ++r) o[d][r] *= al_l[crow(r, hi)]; } } while (0)
  const float NEG_INF = -__builtin_inff();
  const int qkrel = a.qk0 + wid * 32 + r32 - 4 * hi;
  const float nslope = -a.slope2;
  const int qgr = a.qrow0 + (wid >> 1), cq = 32 * (wid & 1) + r32;
  const int c0 = min(max(cq - 8, 0), 48), r0 = min(max(qgr - 4, 0), 56);
#define ROWOK(J) ((MODE == M_NA) ? ((a.krow0 + (J)) >= r0 && (a.krow0 + (J)) < r0 + 8) : (MODE == M_DIL) ? ((J) * 64 <= a.qk0 + wid * 32 + 95 && (J) * 64 + 127 >= a.qk0 + wid * 32) : true)
#define MOD(P0, P1, J) do { \
    if (MODE == M_ALIBI || MODE == M_DIL) { const float rel = (float)(qkrel - (J) * 64); \
      _Pragma("unroll") for (int r = 0; r < 16; ++r) { const float cr = (float)((r & 3) + 8 * (r >> 2)); const float d0_ = fabsf(rel - cr), d1_ = fabsf(rel - cr - 32.f); \
        float v0_ = fmaf(nslope, d0_, P0[r]), v1_ = fmaf(nslope, d1_, P1[r]); \
        if (MODE == M_DIL) { v0_ = (d0_ <= 64.f) ? v0_ : NEG_INF; v1_ = (d1_ <= 64.f) ? v1_ : NEG_INF; } \
        P0[r] = v0_; P1[r] = v1_; } } \
    if (MODE == M_NA) { const int kr = a.krow0 + (J); const float* tp = tbl + (kr - qgr + 7) * 31 + (4 * hi - cq + 15); const int kcb = 4 * hi - c0; \
      _Pragma("unroll") for (int r = 0; r < 16; ++r) { const int cr = (r & 3) + 8 * (r >> 2); \
        const bool ok0 = (unsigned)(kcb + cr) < 16u, ok1 = (unsigned)(kcb + cr + 32) < 16u; \
        const float b0_ = tp[cr], b1_ = tp[cr + 32]; \
        P0[r] = ok0 ? P0[r] + b0_ : NEG_INF; P1[r] = ok1 ? P1[r] + b1_ : NEG_INF; } } \
  } while (0)
  f32x16 p0, p1; float mn, al; bf16x8 pa0, pa1, pa2, pa3; const int NT = a.NT;
#define TOP(j, ks, vs) do { asm volatile("s_waitcnt vmcnt(0)" ::: "memory");        \
    __builtin_amdgcn_s_barrier(); asm volatile("" ::: "memory");                    \
    if ((j) + 1 < NT) DMA((j) + 1, (ks) ^ 1, ((vs) == 2) ? 0 : (vs) + 1); } while (0)
#define QKSM(j, ks) do { SBAR(); qkt(p0, p1, (const bf16*)(K_lds + (ks) * KB), qr, r32, hi); MOD(p0, p1, TROT(j)); \
    partialSM(p0, p1, m_reg, mn, al); RESC(al); finishSM(p0, p1, al, l_reg, pa0, pa1, pa2, pa3); SBAR(); } while (0)
#define PVS(vs) do { _Pragma("unroll") for (int h = 0; h < NVH; ++h) { if (NVH == 2) pv_d0_lean(o + 4 * h, vb0 + (vs) * VB + h * 16384, pa0, pa1, pa2, pa3); else pv_d0(o + 4 * h, vb0 + (vs) * VB + h * 16384, pa0, pa1, pa2, pa3); } } while (0)
  DMA(0, 0, 0);
  if (wid < PINGPONG_SPLIT) {
    int vs = 0;
    for (int j = 0; j < NT; ++j) { const int ks = j & 1;
      TOP(j, ks, vs); if (ROWOK(TROT(j))) { QKSM(j, ks); PVS(vs); }
      vs = (vs == 2) ? 0 : vs + 1; }
  } else {
    int vs = 0, vprev = 0; bool pend = false;
    for (int j = 0; j < NT; ++j) { const int ks = j & 1;
      TOP(j, ks, vs); if (pend) PVS(vprev); pend = ROWOK(TROT(j)); if (pend) QKSM(j, ks);
      vprev = vs; vs = (vs == 2) ? 0 : vs + 1; }
    if (pend) PVS(vprev);
  }
  if (hi == 0) li_l[r32] = l_reg; asm volatile("s_waitcnt lgkmcnt(0)" ::: "memory");
  float rli[16];
#pragma unroll
  for (int r = 0; r < 16; ++r) rli[r] = __builtin_amdgcn_rcpf(li_l[crow(r, hi)]);
  if (MODE == M_DENSE || MODE == M_NA) {
    bf16 zz[16][4 * NVH];
#pragma unroll
    for (int r = 0; r < 16; ++r) { const long orow = wid * QBLK + crow(r, hi);
#pragma unroll
      for (int d0 = 0; d0 < 4 * NVH; ++d0) zz[r][d0] = a.Z[orow * a.ldz + d0 * 32 + r32]; }
#pragma unroll
    for (int r = 0; r < 16; ++r) { const long orow = wid * QBLK + crow(r, hi);
#pragma unroll
      for (int d0 = 0; d0 < 4 * NVH; ++d0) a.Y[orow * a.ldy + d0 * 32 + r32] = f2bf1(o[d0][r] * rli[r] * bf2f(zz[r][d0])); }
  } else {
#pragma unroll
    for (int r = 0; r < 16; ++r) { const long orow = wid * QBLK + crow(r, hi);
#pragma unroll
      for (int d0 = 0; d0 < 4 * NVH; ++d0) a.O[orow * a.ldo + d0 * 32 + r32] = o[d0][r] * rli[r]; }
    if (MODE == M_DIL) { if (hi == 0) a.L[(long)(wid * QBLK + r32) * a.ldl] = m_reg + __builtin_amdgcn_logf(l_reg); }
  }
  __builtin_amdgcn_s_barrier(); asm volatile("" ::: "memory");
#undef DMA
#undef RESC
#undef MOD
#undef TOP
#undef QKSM
#undef PVS
#undef ROWOK
#undef TROT
}
#undef KSWZ
#undef SBAR
}
constexpr int NWAVES = 8;
#ifndef MK_ONE_LAUNCH
#define MK_ONE_LAUNCH 1
#endif
constexpr bool ONE_LAUNCH = MK_ONE_LAUNCH != 0;

constexpr int DM = 4096, NB = 2, SEQ = 4096, DEPTH = 2, HD = 128, GRID_W = 64;
constexpr int M = NB * SEQ;
constexpr int LDP = 32256;
constexpr float RMS_EPS = 1e-6f;
constexpr float QSCALE = 0.08838834764831845f * 1.4426950408889634f;
constexpr int CA_Q = 0, CA_K = 1024, CA_V = 2048, CA_Z = 3072;
constexpr int CB_Q = 4096, CB_K = 5120, CB_V = 5376, CB_Z = 5632;
constexpr int CC_Q = 6656, CC_K = 7680, CC_V = 8704, CC_Z = 9728;
constexpr int CD_Q = 10752, CD_K = 12288, CD_V = 13824, CD_Z = 15360;
constexpr int CG = 15872;

constexpr size_t MiB = 1u << 20;
constexpr size_t WS_CTL = 0, CTL_ZERO_BYTES = 1 * MiB;
constexpr int PK = DM + 64, PY = 1024 + 64;
constexpr size_t WS_WIN = 2 * MiB, WIN_LAYER = 256 * MiB;
constexpr size_t WBR_BLOCK = 9 * MiB;
constexpr size_t WS_WBR = WS_WIN + 2 * WIN_LAYER, WBR_LAYER = 4 * WBR_BLOCK;
constexpr size_t WS_WOUT = WS_WBR + 2 * WBR_LAYER, WOUT_LAYER = 33 * MiB;
constexpr size_t WS_XN = WS_WOUT + 2 * WOUT_LAYER;
constexpr size_t WS_PROJ = WS_XN + 66 * MiB;
constexpr size_t WS_OC = WS_PROJ + 504 * MiB;
constexpr size_t WS_OD = WS_OC + 64 * MiB;
constexpr size_t WS_LSE = WS_OD + 48 * MiB;
constexpr size_t Y_BLOCK = 17 * MiB;
constexpr size_t WS_YA = WS_LSE + 1 * MiB, WS_YB = WS_YA + Y_BLOCK, WS_YC = WS_YB + Y_BLOCK, WS_YD = WS_YC + Y_BLOCK;
constexpr size_t WS_MG = WS_YD + Y_BLOCK;
constexpr size_t WS_X1 = WS_MG + 66 * MiB;
constexpr int P8 = DM + 128;
constexpr size_t WS_XN8 = WS_X1 + 128 * MiB;
constexpr size_t WS_SA = WS_XN8 + 33 * MiB;
constexpr int N8 = 118 * 256;
constexpr size_t WS_WG8 = WS_SA + 1 * MiB, WG8_LAYER = 123 * MiB;
constexpr size_t WS_SB = WS_WG8 + 2 * WG8_LAYER;
constexpr size_t WS_MG8 = WS_SB + 1 * MiB;
constexpr size_t WS_SM = WS_MG8 + 33 * MiB;
constexpr size_t WS_WO8 = WS_SM + 1 * MiB, WO8_LAYER = 17 * MiB;
constexpr size_t WS_SO = WS_WO8 + 2 * WO8_LAYER;
constexpr size_t WS_END = WS_SO + 1 * MiB;
static_assert((size_t)DM * P8 <= WO8_LAYER, "d_ws map (int8 w_out)");
static_assert((size_t)M * P8 <= 33 * MiB && (size_t)N8 * P8 <= WG8_LAYER && (size_t)2 * N8 * 4 <= 1 * MiB, "d_ws map (int8)");
static_assert((size_t)LDP * PK * 2 <= WIN_LAYER && (size_t)DM * PY * 2 <= WBR_BLOCK && (size_t)DM * PK * 2 <= WOUT_LAYER && (size_t)M * PK * 2 <= 66 * MiB && (size_t)M * PY * 2 <= Y_BLOCK, "d_ws map");
constexpr int CW_BAR = 4096;

constexpr int RING_OFF = 0, RING_BYTES = 131072;
constexpr int LDSCTL_OFF = RING_BYTES, MISC_OFF = LDSCTL_OFF + 320;
constexpr int XTAB_OFF = RING_BYTES + 1024;
constexpr int LDS_BYTES = 147456;
static_assert(att::SHM_ATTN <= RING_BYTES, "attention scratch fits the ring region");

#define LAS __attribute__((address_space(3)))
typedef unsigned short bf16;
typedef unsigned v4u __attribute__((ext_vector_type(4)));
typedef unsigned v2u __attribute__((ext_vector_type(2)));
typedef float f32x4 __attribute__((ext_vector_type(4)));
#define LDS_WAIT() asm volatile("s_waitcnt lgkmcnt(0)" ::: "memory")
__device__ __forceinline__ unsigned f2bf(float f) { unsigned u = __builtin_bit_cast(unsigned, f); return (u + 0x7fffu + ((u >> 16) & 1u)) >> 16; }
__device__ __forceinline__ unsigned pk2(float lo, float hi) { return f2bf(lo) | (f2bf(hi) << 16); }
__device__ __forceinline__ float bflo(unsigned w) { return __builtin_bit_cast(float, w << 16); }
__device__ __forceinline__ float bfhi(unsigned w) { return __builtin_bit_cast(float, w & 0xffff0000u); }
#define XB_TMO      128
#define XB_XCNT(j)  (256  + 64 * (j))
#define XB_XSUB(j)  (1280 + 64 * (j))
#define XB_XGEN(j)  (2304 + 64 * (j))
#define XB_TOP      3328
#define XB_TOPGEN   3392
#define XCD_BAR_WORDS 3456
#define XB_SPIN_CAP (1u << 22)

__device__ __forceinline__ unsigned xb_ld(unsigned* p)              { return __hip_atomic_load(p, __ATOMIC_RELAXED, __HIP_MEMORY_SCOPE_AGENT); }
__device__ __forceinline__ unsigned xb_add(unsigned* p, unsigned v) { return __hip_atomic_fetch_add(p, v, __ATOMIC_RELAXED, __HIP_MEMORY_SCOPE_AGENT); }
__device__ __forceinline__ unsigned xb_xcc_id() { return (unsigned)__builtin_amdgcn_s_getreg((3 << 11) | 20) & 0xFu; }
#define XB_SPIN(cond, bar) do { unsigned _sp = 0; while (cond) { __builtin_amdgcn_s_sleep(1); \
    if ((++_sp & 255u) == 0u) { if (xb_ld(&(bar)[XB_TMO])) break; if (_sp > XB_SPIN_CAP) { atomicAdd(&(bar)[XB_TMO], 1u); break; } } } } while (0)

struct XcdBarrier {
    unsigned* bar; unsigned x;
    volatile LAS unsigned* st;
};

__device__ __forceinline__ XcdBarrier xcd_barrier_post(unsigned* bar, volatile LAS unsigned* st) {
    XcdBarrier b; b.bar = bar; b.x = xb_xcc_id(); b.st = st;
    if (threadIdx.x == 0) (void)xb_add(&bar[XB_XCNT(b.x)], 1u);
    return b;
}
__device__ __forceinline__ void xcd_barrier_complete(unsigned* bar, unsigned x, unsigned& nloc, unsigned& nx) {
    const unsigned G = gridDim.x * gridDim.y * gridDim.z;
    unsigned sum, cnt, mine, sp = 0u;
    for (;;) {
        sum = 0u; cnt = 0u; mine = 0u;
#pragma unroll 1
        for (unsigned j = 0; j < 16; ++j) { const unsigned c = xb_ld(&bar[XB_XCNT(j)]); sum += c; cnt += (c > 0u) ? 1u : 0u; mine = (j == x) ? c : mine; }
        if (sum == G) break;
        __builtin_amdgcn_s_sleep(1);
        if ((++sp & 255u) == 0u) { if (xb_ld(&bar[XB_TMO])) break; if (sp > XB_SPIN_CAP) { atomicAdd(&bar[XB_TMO], 1u); break; } }
    }
    nloc = mine > 0u ? mine : 1u; nx = cnt > 0u ? cnt : 1u;
}

__device__ __noinline__ void xcd_barrier(const XcdBarrier b, const bool leader  ) {
    asm volatile("s_waitcnt vmcnt(0)" ::: "memory");
    __syncthreads();
    if (leader) {
        unsigned* bar = b.bar;
        __builtin_amdgcn_s_waitcnt(0);
        unsigned nloc = b.st[0], nx = b.st[1];
        if (nloc == 0u) { xcd_barrier_complete(bar, b.x, nloc, nx); b.st[0] = nloc; b.st[1] = nx; }
        const unsigned old = xb_add(&bar[XB_XSUB(b.x)], 1u);
        const unsigned gen = old / nloc;
        if (old + 1u == (gen + 1u) * nloc) {
            __builtin_amdgcn_fence(__ATOMIC_RELEASE, "agent");
            asm volatile("s_waitcnt vmcnt(0)" ::: "memory");
            const unsigned og = xb_add(&bar[XB_TOP], 1u);
            const unsigned tg = og / nx;
            if (og + 1u == (tg + 1u) * nx) xb_add(&bar[XB_TOPGEN], 1u);
            else XB_SPIN(xb_ld(&bar[XB_TOPGEN]) == tg, bar);
            __builtin_amdgcn_fence(__ATOMIC_ACQUIRE, "agent");
            xb_add(&bar[XB_XGEN(b.x)], 1u);
            asm volatile("s_waitcnt vmcnt(0)" ::: "memory");
        } else {
            XB_SPIN(xb_ld(&bar[XB_XGEN(b.x)]) == gen, bar);
            __builtin_amdgcn_fence(__ATOMIC_ACQUIRE, "agent");
            asm volatile("s_waitcnt vmcnt(0)" ::: "memory");
        }
    }
    __syncthreads();
}
struct Frame {
    LAS unsigned char* lds;
    volatile LAS unsigned* MISC;
    unsigned* ctl;
    int tid, lane, wave;
    int vcu, G;
};
__device__ __forceinline__ float wave_sum(float v, const int lane) {
#pragma unroll
    for (int o = 1; o < 64; o <<= 1) v += __builtin_bit_cast(float, __builtin_amdgcn_ds_bpermute((lane ^ o) << 2, __builtin_bit_cast(int, v)));
    return v;
}
__device__ __forceinline__ float wave_max(float v, const int lane) {
#pragma unroll
    for (int o = 1; o < 64; o <<= 1) v = fmaxf(v, __builtin_bit_cast(float, __builtin_amdgcn_ds_bpermute((lane ^ o) << 2, __builtin_bit_cast(int, v))));
    return v;
}
__device__ __forceinline__ unsigned q8(float a, float b, float c, float d, float inv) {
    const int qa = (int)__builtin_rintf(a * inv), qb = (int)__builtin_rintf(b * inv), qc = (int)__builtin_rintf(c * inv), qd = (int)__builtin_rintf(d * inv);
    return (unsigned)(qa & 255) | ((unsigned)(qb & 255) << 8) | ((unsigned)(qc & 255) << 16) | ((unsigned)(qd & 255) << 24);
}
__device__ __forceinline__ void p0_transpose_item(const float* W, int K, int N, bf16* WT, int ldt, LAS float* scr, int item, int lane, int noff = 0, int ncols = 0) {
    const int nblk = (ncols ? ncols : N) / 32, kb = item / nblk, nb = item % nblk, k0 = 64 * kb, n0 = noff + 32 * nb;
    float v[32];
#pragma unroll
    for (int i = 0; i < 32; ++i) { const int kk = 2 * i + (lane >> 5); v[i] = __builtin_nontemporal_load(W + (size_t)(k0 + kk) * N + n0 + (lane & 31)); }
#pragma unroll
    for (int i = 0; i < 32; ++i) { const int kk = 2 * i + (lane >> 5); scr[kk * 33 + (lane & 31)] = v[i]; }
    LDS_WAIT(); asm volatile("" ::: "memory");
    const int c = lane & 7;
#pragma unroll
    for (int j = 0; j < 4; ++j) { const int n = (lane >> 3) + 8 * j; const LAS float* s = scr + (8 * c) * 33 + n;
        v4u o; o.x = pk2(s[0 * 33], s[1 * 33]); o.y = pk2(s[2 * 33], s[3 * 33]); o.z = pk2(s[4 * 33], s[5 * 33]); o.w = pk2(s[6 * 33], s[7 * 33]);
        *(v4u*)(WT + (size_t)(n0 + n) * ldt + k0 + 8 * c) = o; }
    LDS_WAIT(); asm volatile("" ::: "memory");
}
__device__ __forceinline__ void ld_xrow(const float* xrow, f32x4 (&v)[16], int lane) {
    const f32x4* xr = (const f32x4*)xrow + lane;
#pragma unroll
    for (int j = 0; j < 16; ++j) v[j] = xr[64 * j];
}
__device__ __forceinline__ void rms_row_regs(f32x4 (&v)[16], const f32x4 (&gr)[16]  , bf16* orow, unsigned* qrow, float* sa_row, int lane) {
    float s = 0.f;
#pragma unroll
    for (int j = 0; j < 16; ++j) s += (v[j].x * v[j].x + v[j].y * v[j].y) + (v[j].z * v[j].z + v[j].w * v[j].w);
    const float rstd = 1.0f / sqrtf(wave_sum(s, lane) * (1.f / DM) + RMS_EPS);
    v2u* o8 = (v2u*)orow + lane; float mx = 0.f;
#pragma unroll
    for (int j = 0; j < 16; ++j) { const f32x4 gg = gr[j]; v[j].x *= rstd * gg.x; v[j].y *= rstd * gg.y; v[j].z *= rstd * gg.z; v[j].w *= rstd * gg.w;
        mx = fmaxf(fmaxf(mx, fmaxf(fabsf(v[j].x), fabsf(v[j].y))), fmaxf(fabsf(v[j].z), fabsf(v[j].w)));
        v2u w; w.x = pk2(v[j].x, v[j].y); w.y = pk2(v[j].z, v[j].w); o8[64 * j] = w; }
    mx = fmaxf(wave_max(mx, lane), 1e-30f);
    const float inv = 127.0f / mx;
#pragma unroll
    for (int j = 0; j < 16; ++j) qrow[lane + 64 * j] = q8(v[j].x, v[j].y, v[j].z, v[j].w, inv);
    if (lane == 0) *sa_row = mx * (1.0f / 127.0f);
}
__device__ __forceinline__ void ld_row16(const bf16* wrow, v4u (&w)[8], int lane) {
#pragma unroll
    for (int j = 0; j < 8; ++j) w[j] = *((const v4u*)wrow + lane + 64 * j);
}
__device__ __forceinline__ void q_row16(const v4u (&w)[8], unsigned* qrow, float* sc, int lane) {
    float mx = 0.f;
#pragma unroll
    for (int j = 0; j < 8; ++j) {
        mx = fmaxf(mx, fmaxf(fmaxf(fmaxf(fabsf(bflo(w[j].x)), fabsf(bfhi(w[j].x))), fmaxf(fabsf(bflo(w[j].y)), fabsf(bfhi(w[j].y)))), fmaxf(fmaxf(fabsf(bflo(w[j].z)), fabsf(bfhi(w[j].z))), fmaxf(fabsf(bflo(w[j].w)), fabsf(bfhi(w[j].w)))))); }
    mx = fmaxf(wave_max(mx, lane), 1e-30f);
    const float inv = 127.0f / mx;
#pragma unroll
    for (int j = 0; j < 8; ++j) { v2u o; o.x = q8(bflo(w[j].x), bfhi(w[j].x), bflo(w[j].y), bfhi(w[j].y), inv); o.y = q8(bflo(w[j].z), bfhi(w[j].z), bflo(w[j].w), bfhi(w[j].w), inv);
        *((v2u*)qrow + lane + 64 * j) = o; }
    if (lane == 0) *sc = mx * (1.0f / 127.0f);
}
struct Args;
template <class KPT> __device__ __forceinline__ void phase_prologue(Frame& F, KPT KP, unsigned char* ws) {
#define in_(i) ((const float*)(__attribute__((address_space(1))) const float*)(unsigned long long)KP->in[i])
    LAS float* scr = (LAS float*)(F.lds + RING_OFF + F.wave * 16384);
    const int gw = F.vcu * NWAVES + F.wave, NGW = F.G * NWAVES;
    constexpr int C16 = pg8::NT16 * 256, C16_OFF = 26 * 256;
    constexpr int I_IN = (DM / 64) * (C16 / 32), I_BR = (1024 / 64) * (DM / 32), I_BD = (512 / 64) * (DM / 32);
    constexpr int I_LAYER = I_IN + 3 * I_BR + I_BD;
    for (int it = gw; it < 2 * I_LAYER; it += NGW) {
        const int l = it / I_LAYER; int r = it % I_LAYER;
        bf16* wbr = (bf16*)(ws + WS_WBR + (size_t)l * WBR_LAYER);
        if (r < I_IN) { p0_transpose_item(in_(2) + (size_t)l * DM * LDP, DM, LDP, (bf16*)(ws + WS_WIN + (size_t)l * WIN_LAYER), PK, scr, r, F.lane, C16_OFF, C16); continue; } r -= I_IN;
        if (r < I_BR) { p0_transpose_item(in_(7) + (size_t)l * 1024 * DM, 1024, DM, wbr, PY, scr, r, F.lane); continue; } r -= I_BR;
        if (r < I_BR) { p0_transpose_item(in_(8) + (size_t)l * 1024 * DM, 1024, DM, wbr + 1 * (WBR_BLOCK / 2), PY, scr, r, F.lane); continue; } r -= I_BR;
        if (r < I_BR) { p0_transpose_item(in_(9) + (size_t)l * 1024 * DM, 1024, DM, wbr + 2 * (WBR_BLOCK / 2), PY, scr, r, F.lane); continue; } r -= I_BR;
        p0_transpose_item(in_(10) + (size_t)l * 512 * DM, 512, DM, wbr + 3 * (WBR_BLOCK / 2), PY, scr, r, F.lane);
    }
    {
        LAS float* cm = (LAS float*)(F.lds + RING_OFF + 12288);
        const int lane = F.lane, n = lane & 31, kpar = lane >> 5;
        constexpr int NBQ = N8 / 32;
        for (int it = F.vcu; it < 2 * NBQ + 2 * (DM / 32); it += F.G) {
            const float* W; int ldw; unsigned char* Q; float* SC;
            if (it < 2 * NBQ) { const int l = it / NBQ, n0c = (it % NBQ) * 32, n0 = pg8::map8(n0c >> 8) * 256 + (n0c & 255);
                W = in_(2) + (size_t)l * DM * LDP + n0 + n; ldw = LDP; Q = ws + WS_WG8 + (size_t)l * WG8_LAYER + (size_t)n0c * P8; SC = (float*)(ws + WS_SB) + (size_t)l * N8 + n0c; }
            else { const int r = it - 2 * NBQ, l = r / (DM / 32), n0 = (r % (DM / 32)) * 32;
                W = in_(11) + (size_t)l * DM * DM + n0 + n; ldw = DM; Q = ws + WS_WO8 + (size_t)l * WO8_LAYER + (size_t)n0 * P8; SC = (float*)(ws + WS_SO) + (size_t)l * DM + n0; }
            float mx = 0.f; unsigned pk[8][16];
#pragma unroll
            for (int kb = 0; kb < 8; ++kb) { const int k0 = (F.wave * 8 + kb) * 64;
                float v[32]; const float* wp = W + (size_t)(k0 + kpar) * ldw;
#pragma unroll
                for (int i = 0; i < 32; ++i) { v[i] = __builtin_nontemporal_load(wp); wp += 2 * ldw; asm volatile("" : "+v"(wp)); }
#pragma unroll
                for (int i = 0; i < 32; ++i) mx = fmaxf(mx, fabsf(v[i]));
#pragma unroll
                for (int i = 0; i < 16; ++i) { pk[kb][i] = pk2(v[2 * i], v[2 * i + 1]); asm volatile("" : "+v"(pk[kb][i])); }
                asm volatile("" ::: "memory"); __builtin_amdgcn_sched_barrier(0); }
            mx = fmaxf(mx, __builtin_bit_cast(float, __builtin_amdgcn_ds_bpermute((lane ^ 32) << 2, __builtin_bit_cast(int, mx))));
            if (lane < 32) cm[F.wave * 32 + lane] = mx;
            LDS_WAIT(); __syncthreads();
            float cmax = cm[n];
#pragma unroll
            for (int w = 1; w < 8; ++w) cmax = fmaxf(cmax, cm[w * 32 + n]);
            cmax = fmaxf(cmax, 1e-30f);
            const float inv = 127.0f / cmax;
            if (F.wave == 0 && lane < 32) SC[lane] = cmax * (1.0f / 127.0f);
#pragma unroll
            for (int kb = 0; kb < 8; ++kb) { const int k0 = (F.wave * 8 + kb) * 64;
#pragma unroll
                for (int i = 0; i < 16; ++i) { scr[(4 * i + kpar) * 33 + n] = bflo(pk[kb][i]) * inv; scr[(4 * i + 2 + kpar) * 33 + n] = bfhi(pk[kb][i]) * inv; }
                LDS_WAIT(); asm volatile("" ::: "memory");
                const int c = lane & 7;
#pragma unroll
                for (int j = 0; j < 4; ++j) { const int nn = (lane >> 3) + 8 * j; const LAS float* sp = scr + (8 * c) * 33 + nn;
                    v2u o; o.x = q8(sp[0 * 33], sp[1 * 33], sp[2 * 33], sp[3 * 33], 1.0f); o.y = q8(sp[4 * 33], sp[5 * 33], sp[6 * 33], sp[7 * 33], 1.0f);
                    *(v2u*)(Q + (size_t)nn * P8 + k0 + 8 * c) = o; }
                LDS_WAIT(); asm volatile("" ::: "memory"); __builtin_amdgcn_sched_barrier(0); }
            __syncthreads();
        }
    }
    f32x4 gg[16]; ld_xrow(in_(1), gg, F.lane);
    for (int m = gw; m < M; m += NGW) { f32x4 v[16]; ld_xrow(in_(0) + (size_t)m * DM, v, F.lane);
        rms_row_regs(v, gg, (bf16*)(ws + WS_XN) + (size_t)m * PK, (unsigned*)(ws + WS_XN8 + (size_t)m * P8), (float*)(ws + WS_SA) + m, F.lane); }
}
#undef in_
__device__ __forceinline__ void phase_finalize(Frame& F, unsigned char* ws, const float* lam_p  , const float* subln_g  , float lam_init) {
    const int gw = F.vcu * NWAVES + F.wave, NGW = F.G * NWAVES, lane = F.lane;
    const bf16* proj = (const bf16*)(ws + WS_PROJ);
    float d1 = lam_p[lane] * lam_p[128 + lane] + lam_p[64 + lane] * lam_p[192 + lane];
    float d2 = lam_p[256 + lane] * lam_p[384 + lane] + lam_p[320 + lane] * lam_p[448 + lane];
    d1 = wave_sum(d1, lane); d2 = wave_sum(d2, lane);
    const float lam = expf(d1) - expf(d2) + lam_init;
    const float post = 1.0f - lam_init;
    const float* OC = (const float*)(ws + WS_OC);
    const f32x4 sg = *(const f32x4*)(subln_g + 4 * lane);
    bf16* YC = (bf16*)(ws + WS_YC);
    for (int t = gw; t < M; t += NGW) {
        f32x4 o0[4], o1[4]; v2u zw[4];
#pragma unroll
        for (int h = 0; h < 4; ++h) { o0[h] = *(const f32x4*)(OC + (size_t)t * 2048 + (2 * h) * 256 + 4 * lane); o1[h] = *(const f32x4*)(OC + (size_t)t * 2048 + (2 * h + 1) * 256 + 4 * lane);
            zw[h] = *(const v2u*)(proj + (size_t)t * LDP + CC_Z + h * 256 + 4 * lane); }
#pragma unroll
        for (int h = 0; h < 4; ++h) {
            const f32x4 d = o0[h] - lam * o1[h];
            const float ss = wave_sum((d.x * d.x + d.y * d.y) + (d.z * d.z + d.w * d.w), lane);
            const float rstd = 1.0f / sqrtf(ss * (1.f / 256.f) + RMS_EPS) * post;
            v2u o; o.x = pk2(d.x * rstd * sg.x * bflo(zw[h].x), d.y * rstd * sg.y * bfhi(zw[h].x)); o.y = pk2(d.z * rstd * sg.z * bflo(zw[h].y), d.w * rstd * sg.w * bfhi(zw[h].y));
            *(v2u*)(YC + (size_t)t * PY + h * 256 + 4 * lane) = o;
        }
    }
    const float* OD = (const float*)(ws + WS_OD); const float* LSE = (const float*)(ws + WS_LSE);
    bf16* YD = (bf16*)(ws + WS_YD);
    const int hg = lane >> 4, c0 = hg * 128 + (lane & 15) * 8;
    for (int t0 = gw; t0 < M; t0 += 2 * NGW) {
        float ls[2][3]; f32x4 av[2][3][2]; v4u zw[2];
#pragma unroll
        for (int k = 0; k < 2; ++k) { const int t = min(t0 + k * NGW, M - 1);
#pragma unroll
            for (int g = 0; g < 3; ++g) { ls[k][g] = LSE[(size_t)g * M * 4 + (size_t)t * 4 + hg]; const float* pp = OD + (size_t)g * M * 512 + (size_t)t * 512 + c0; av[k][g][0] = *(const f32x4*)pp; av[k][g][1] = *(const f32x4*)(pp + 4); }
            zw[k] = *(const v4u*)(proj + (size_t)t * LDP + CD_Z + c0); }
#pragma unroll
        for (int k = 0; k < 2; ++k) { const int t = t0 + k * NGW;
            const float mx = fmaxf(ls[k][0], fmaxf(ls[k][1], ls[k][2]));
            float w0 = __builtin_amdgcn_exp2f(ls[k][0] - mx), w1 = __builtin_amdgcn_exp2f(ls[k][1] - mx), w2 = __builtin_amdgcn_exp2f(ls[k][2] - mx);
            const float inv = 1.0f / (w0 + w1 + w2); w0 *= inv; w1 *= inv; w2 *= inv;
            const f32x4 r0 = w0 * av[k][0][0] + w1 * av[k][1][0] + w2 * av[k][2][0], r1 = w0 * av[k][0][1] + w1 * av[k][1][1] + w2 * av[k][2][1];
            v4u o; o.x = pk2(r0.x * bflo(zw[k].x), r0.y * bfhi(zw[k].x)); o.y = pk2(r0.z * bflo(zw[k].y), r0.w * bfhi(zw[k].y));
            o.z = pk2(r1.x * bflo(zw[k].z), r1.y * bfhi(zw[k].z)); o.w = pk2(r1.z * bflo(zw[k].w), r1.w * bfhi(zw[k].w));
            if (t < M) *(v4u*)(YD + (size_t)t * PY + c0) = o; }
    }
}
#ifndef REP_AB
#define REP_AB 1
#endif
#ifndef REP_AC
#define REP_AC 1
#endif
#ifndef REP_AA
#define REP_AA 1
#endif
#ifndef REP_AD
#define REP_AD 1
#endif
#ifndef SD_DENSE
#define SD_DENSE 2
#endif
#ifndef SD_ALIBI
#define SD_ALIBI 2
#endif
#ifndef SD_NA
#define SD_NA 1
#endif
#ifndef SD_DIL
#define SD_DIL 1
#endif
__device__ __forceinline__ void phase_attention(Frame& F, unsigned char* ws, const float* rel_bias  , char* lds) {
    const att::bf16* P = (const att::bf16*)(ws + WS_PROJ);
    for (int rep = 0; rep < REP_AB; ++rep)
    for (int u = F.vcu; u < 256; u += F.G) {
        const int grp = u >> 6, b = grp >> 1, kvh = grp & 1, hq = kvh * 4 + ((u >> 4) & 3), qb = u & 15;
        const size_t tb = (size_t)b * SEQ, tq = tb + 256 * qb;
        att::UA a{};
        a.Q = P + tq * LDP + CB_Q + hq * 128; a.ldq = LDP;
        a.K = P + tb * LDP + CB_K + kvh * 128; a.V = P + tb * LDP + CB_V + kvh * 128; a.ldk = LDP; a.NT = SEQ / 64;
        a.Y = (att::bf16*)(ws + WS_YB) + tq * PY + hq * 128; a.ldy = PY; a.Z = P + tq * LDP + CB_Z + hq * 128; a.ldz = LDP;
        att::attn_unit_dma<att::M_DENSE, 1>(a, lds, 2 * 16384 + 3 * 16384, F.wave);
    }
    for (int rep = 0; rep < REP_AC; ++rep)
    for (int u = F.vcu; u < 256; u += F.G) {
        const int combo = u >> 4, b = combo >> 3, h = (combo >> 1) & 3, mp = combo & 1, qb = u & 15;
        const size_t tb = (size_t)b * SEQ, tq = tb + 256 * qb;
        att::UA a{};
        a.Q = P + tq * LDP + CC_Q + (h * 2 + mp) * 128; a.ldq = LDP;
        a.K = P + tb * LDP + CC_K + (h * 2 + mp) * 128; a.V = P + tb * LDP + CC_V + h * 256; a.ldk = LDP; a.NT = SEQ / 64;
        a.qk0 = 256 * qb; a.slope2 = __builtin_amdgcn_exp2f(-2.0f * (float)(h + 1)) * att::LOG2E; a.j0 = 4 * qb;
        a.O = (float*)(ws + WS_OC) + tq * 2048 + (h * 2 + mp) * 256; a.ldo = 2048;
        att::attn_unit_dma<att::M_ALIBI, 2>(a, lds, XTAB_OFF, F.wave);
    }
    for (int rep = 0; rep < REP_AA; ++rep)
    for (int u = F.vcu; u < 256; u += F.G) {
        const int b = u >> 7, h = (u >> 4) & 7, R = u & 15;
        const size_t tb = (size_t)b * SEQ, tq = tb + 256 * R;
        int kr_lo = min(max(4 * R - 4, 0), 56); const int kr_last = min(max(4 * R - 1, 0), 56) + 7; int NT = kr_last - kr_lo + 1;
        att::UA a{};
        a.Q = P + tq * LDP + CA_Q + h * 128; a.ldq = LDP;
        a.K = P + (tb + (size_t)kr_lo * 64) * LDP + CA_K + h * 128; a.V = P + (tb + (size_t)kr_lo * 64) * LDP + CA_V + h * 128; a.ldk = LDP; a.NT = NT;
        a.qrow0 = 4 * R; a.krow0 = kr_lo; a.tbl = rel_bias + h * (15 * 31);
        a.Y = (att::bf16*)(ws + WS_YA) + tq * PY + h * 128; a.ldy = PY; a.Z = P + tq * LDP + CA_Z + h * 128; a.ldz = LDP;
        att::attn_unit_dma<att::M_NA, 1>(a, lds, 2 * 16384 + 3 * 16384, F.wave);
    }
    for (int rep = 0; rep < REP_AD; ++rep)
    for (int u = F.vcu; u < 384; u += F.G) {
        const int bh = u >> 4, b = bh / 12, gh = bh % 12, g = gh >> 2, hg = gh & 3, u16 = u & 15;
        const int dil = (g == 0) ? 1 : ((g == 1) ? 4 : 16);
        const int qb = (g == 0) ? u16 : ((g == 1) ? (u16 & 3) : 0), rho = (g == 0) ? 0 : ((g == 1) ? (u16 >> 2) : u16);
        const int nttot = 64 / dil;
        const int t_lo = max(0, 4 * qb - 1), t_hi = min(nttot, 4 * qb + 5);
        const size_t tb = (size_t)b * SEQ, tq = tb + rho + (size_t)dil * 256 * qb, tk = tb + rho + (size_t)dil * 64 * t_lo;
        att::UA a{};
        a.Q = P + tq * LDP + CD_Q + gh * 128; a.ldq = (long)LDP * dil;
        a.K = P + tk * LDP + CD_K + gh * 128; a.V = P + tk * LDP + CD_V + gh * 128; a.ldk = (long)LDP * dil; a.NT = t_hi - t_lo;
        a.qk0 = 256 * qb - 64 * t_lo; a.slope2 = __builtin_amdgcn_exp2f(-8.0f * (float)(gh + 1) / 12.0f) * (float)dil * att::LOG2E;
        a.O = (float*)(ws + WS_OD) + (size_t)g * M * 512 + tq * 512 + hg * 128; a.ldo = 512L * dil;
        a.L = (float*)(ws + WS_LSE) + (size_t)g * M * 4 + tq * 4 + hg; a.ldl = 4L * dil;
        att::attn_unit_dma<att::M_DIL, 1>(a, lds, 2 * 16384 + 3 * 16384, F.wave);
    }
}

#ifndef REP_PRO
#define REP_PRO 1
#endif
#ifndef REP_INP
#define REP_INP 1
#endif
#ifndef REP_ATT
#define REP_ATT 1
#endif
#ifndef REP_FIN
#define REP_FIN 1
#endif
#ifndef REP_BRA
#define REP_BRA 1
#endif
#ifndef REP_OUT
#define REP_OUT 1
#endif
#ifndef REP_NRM
#define REP_NRM 1
#endif
constexpr int NPH = 14;
struct Args { const float* in[12]; float* out; unsigned char* ws; int ph_lo, ph_hi; };
__global__ void __launch_bounds__(NWAVES * 64, 2) mega_fwd(Args args) {
    extern __shared__ __attribute__((aligned(16))) unsigned char lds[];
    Frame F;
    F.lds = (LAS unsigned char*)lds;
    F.MISC = (volatile LAS unsigned*)(F.lds + MISC_OFF);
    F.tid = threadIdx.x; F.lane = F.tid & 63; F.wave = __builtin_amdgcn_readfirstlane(F.tid >> 6);
    const int wave0 = F.wave;
    F.G = gridDim.x; { const int bx = blockIdx.x; F.vcu = (F.G % 8 == 0) ? (bx % 8) * (F.G / 8) + bx / 8 : bx; }
    unsigned char* ws = args.ws;
    F.ctl = (unsigned*)(ws + WS_CTL);
    for (int u = F.tid; u < (LDS_BYTES - LDSCTL_OFF) / 4; u += NWAVES * 64) ((LAS unsigned*)(F.lds + LDSCTL_OFF))[u] = 0u;
    __syncthreads();
    XcdBarrier bar; bar.bar = F.ctl + CW_BAR; bar.x = 0; bar.st = nullptr;
    if (ONE_LAUNCH) bar = xcd_barrier_post(F.ctl + CW_BAR, F.MISC + 8);
    const int lo = args.ph_lo, hi = args.ph_hi;
    const __attribute__((address_space(4))) Args* KP = (const __attribute__((address_space(4))) Args*)__builtin_amdgcn_kernarg_segment_ptr();
#define INP(i) ((const float*)(__attribute__((address_space(1))) const float*)(unsigned long long)KP->in[i])
#define PHASE_ENTER() do { unsigned long long kpi_ = (unsigned long long)__builtin_amdgcn_kernarg_segment_ptr(); asm volatile("" : "+s"(kpi_)); KP = (const __attribute__((address_space(4))) Args*)kpi_; \
        unsigned long long wsi_ = (unsigned long long)KP->ws; asm volatile("" : "+s"(wsi_)); ws = (unsigned char*)(__attribute__((address_space(1))) unsigned char*)wsi_; int t_ = fresh_tid(wave0); asm volatile("" : "+v"(t_)); F.tid = t_; F.lane = t_ & 63; F.wave = wave0; } while (0)
#define IN(k) (lo <= (k) && (k) < hi)
#define SEAM(k) do { if (IN(k) && IN((k) + 1)) xcd_barrier(bar, fresh_tid(wave0) == 0); } while (0)

    if (IN(0)) { for (int rep = 0; rep < REP_PRO; ++rep) { PHASE_ENTER(); phase_prologue(F, KP, ws); }
        SEAM(0); }

#pragma unroll 1
    for (int l = 0; l < DEPTH; ++l) {
        const int pb = 1 + 7 * l;
        if (IN(pb)) for (int rep = 0; rep < REP_INP; ++rep) {
            PHASE_ENTER(); bf16* proj = (bf16*)(ws + WS_PROJ);
            {
                pg8::Gemm g8{(const pg8::bf16_t*)(ws + WS_XN8), (const pg8::bf16_t*)(ws + WS_WG8 + (size_t)l * WG8_LAYER), M, N8, DM / 2, P8 / 2};
                pg8::StaticOrder S8; S8.init(M, N8, F.G, (int)blockIdx.x);
                pg8::EpiProjT<true> E8{proj, LDP, INP(3) + (size_t)l * 4 * 2 * HD, (LAS float*)(F.lds + XTAB_OFF), QSCALE, (const float*)(ws + WS_SA), (const float*)(ws + WS_SB) + (size_t)l * N8};
                pg8::gemm_phase<pg8::EpiProjT<true>, pg8::StaticOrder, true, true, pg8::Gemm, true>(F.lds + RING_OFF, g8, S8, E8, F.wave);
            }
            pg8::GemmMap16 g{(const pg8::bf16_t*)(ws + WS_XN), (const pg8::bf16_t*)(ws + WS_WIN + (size_t)l * WIN_LAYER), DM, PK};
            pg8::StaticOrder S; S.init(M, pg8::NT16 * 256, F.G, (int)blockIdx.x);
            pg8::EpiProjT<false> E{proj, LDP, INP(3) + (size_t)l * 4 * 2 * HD, (LAS float*)(F.lds + XTAB_OFF), QSCALE, nullptr, nullptr};
            pg8::gemm_phase<pg8::EpiProjT<false>, pg8::StaticOrder, true, true, pg8::GemmMap16>(F.lds + RING_OFF, g, S, E, F.wave);
            if (rep == REP_INP - 1) SEAM(pb);
        }
        if (IN(pb + 2)) { for (int rep = 0; rep < REP_ATT; ++rep) { PHASE_ENTER(); phase_attention(F, ws, INP(4) + (size_t)l * 8 * 15 * 31, (char*)lds + RING_OFF); } SEAM(pb + 2); }
        if (IN(pb + 3)) for (int rep = 0; rep < REP_FIN; ++rep) {
            PHASE_ENTER();
            const float lam_init = 0.8f - 0.6f * expf(-0.3f * (float)l);
            phase_finalize(F, ws, INP(5) + (size_t)l * 4 * HD, INP(6) + (size_t)l * 2 * HD, lam_init); if (rep == REP_FIN - 1) SEAM(pb + 3);
        }
        if (IN(pb + 4)) for (int rep = 0; rep < REP_BRA; ++rep) {
            PHASE_ENTER(); bf16* proj = (bf16*)(ws + WS_PROJ);
            const int rot = (int)(blockIdx.x & 1);
            pg8::ChainGemm g{(const bf16*)(ws + WS_YA), (const bf16*)(ws + WS_WBR + (size_t)l * WBR_LAYER), Y_BLOCK / 2, WBR_BLOCK / 2, PY, 1024, rot};
            pg8::ChainOrder S; S.T.init(M, DM, F.G, (int)blockIdx.x);
            pg8::EpiChain E{proj + CG, LDP, (bf16*)(ws + WS_MG), PK, rot};
            pg8::gemm_phase<pg8::EpiChain, pg8::ChainOrder, true, true, pg8::ChainGemm>(F.lds + RING_OFF, g, S, E, F.wave);
            if (rep == REP_BRA - 1) SEAM(pb + 4);
        }
        if (IN(pb + 5)) {
            { PHASE_ENTER(); const int gw = F.vcu * NWAVES + F.wave, NGW = F.G * NWAVES;
              for (int m = gw; m < M; m += 2 * NGW) { const int m2 = min(m + NGW, M - 1); v4u wa[8], wb[8];
                  ld_row16((const bf16*)(ws + WS_MG) + (size_t)m * PK, wa, F.lane); ld_row16((const bf16*)(ws + WS_MG) + (size_t)m2 * PK, wb, F.lane);
                  q_row16(wa, (unsigned*)(ws + WS_MG8 + (size_t)m * P8), (float*)(ws + WS_SM) + m, F.lane);
                  if (m + NGW < M) q_row16(wb, (unsigned*)(ws + WS_MG8 + (size_t)m2 * P8), (float*)(ws + WS_SM) + m2, F.lane); } }
            xcd_barrier(bar, fresh_tid(wave0) == 0);
            for (int rep = 0; rep < REP_OUT; ++rep) {
            PHASE_ENTER();
            const float* xin = (l == 0) ? INP(0) : (const float*)(ws + WS_X1);
            float* xout = (l == DEPTH - 1) ? (float*)(__attribute__((address_space(1))) float*)(unsigned long long)KP->out : (float*)(ws + WS_X1);
            pg8::Gemm g{(const pg8::bf16_t*)(ws + WS_MG8), (const pg8::bf16_t*)(ws + WS_WO8 + (size_t)l * WO8_LAYER), M, DM, DM / 2, P8 / 2};
            pg8::StaticOrder S; S.init(M, DM, F.G, (int)blockIdx.x);
            pg8::EpiRes8 E{xin, xout, DM, (const float*)(ws + WS_SM), (const float*)(ws + WS_SO) + (size_t)l * DM};
            pg8::gemm_phase<pg8::EpiRes8, pg8::StaticOrder, true, true, pg8::Gemm, true>(F.lds + RING_OFF, g, S, E, F.wave);
            }
            SEAM(pb + 5);
        }
        if (l + 1 < DEPTH && IN(pb + 6)) for (int rep = 0; rep < REP_NRM; ++rep) {
            PHASE_ENTER();
            const int gw = F.vcu * NWAVES + F.wave, NGW = F.G * NWAVES;
            f32x4 gg[16]; ld_xrow(INP(1) + (size_t)(l + 1) * DM, gg, F.lane);
            for (int m = gw; m < M; m += 2 * NGW) { const int m2 = min(m + NGW, M - 1); f32x4 va[16], vb[16];
                ld_xrow((const float*)(ws + WS_X1) + (size_t)m * DM, va, F.lane); ld_xrow((const float*)(ws + WS_X1) + (size_t)m2 * DM, vb, F.lane);
                rms_row_regs(va, gg, (bf16*)(ws + WS_XN) + (size_t)m * PK, (unsigned*)(ws + WS_XN8 + (size_t)m * P8), (float*)(ws + WS_SA) + m, F.lane);
                if (m + NGW < M) rms_row_regs(vb, gg, (bf16*)(ws + WS_XN) + (size_t)m2 * PK, (unsigned*)(ws + WS_XN8 + (size_t)m2 * P8), (float*)(ws + WS_SA) + m2, F.lane); }
            if (rep == REP_NRM - 1) SEAM(pb + 6);
        }
    }
#undef IN
#undef SEAM
#undef PHASE_ENTER
#undef INP
}

extern "C" void kernel_launch(void* const* d_in, const int* in_sizes, int n_in, void* d_out, int out_size, void* d_ws, size_t ws_size, hipStream_t stream) {
    static int grid = 0;
    if (grid == 0) {
        if (n_in != 12 || in_sizes[0] != M * DM || out_size != M * DM || ws_size < WS_END) { fprintf(stderr, "kernel_launch: shape/workspace mismatch (n_in %d, in0 %d, out %d, ws %zu, need %zu)\n", n_in, n_in > 0 ? in_sizes[0] : -1, out_size, ws_size, (size_t)WS_END); grid = -1; return; }
        int dev = 0, cus = 0, per_cu = 0;
        if (hipGetDevice(&dev) != hipSuccess || hipDeviceGetAttribute(&cus, hipDeviceAttributeMultiprocessorCount, dev) != hipSuccess) { grid = -1; return; }
        if (hipFuncSetAttribute((const void*)mega_fwd, hipFuncAttributeMaxDynamicSharedMemorySize, LDS_BYTES) != hipSuccess) { fprintf(stderr, "kernel_launch: hipFuncSetAttribute failed\n"); grid = -1; return; }
        if (hipOccupancyMaxActiveBlocksPerMultiprocessor(&per_cu, (const void*)mega_fwd, NWAVES * 64, LDS_BYTES) != hipSuccess || per_cu < 1)
            fprintf(stderr, "kernel_launch: note: occupancy query reports %d workgroups per CU\n", per_cu);
        (void)hipGetLastError();
        grid = cus;
    }
    if (grid < 0) return;
    if (hipMemsetAsync((char*)d_ws + WS_CTL, 0, CTL_ZERO_BYTES, stream) != hipSuccess) { fprintf(stderr, "kernel_launch: hipMemsetAsync failed\n"); return; }
    Args a{};
    for (int i = 0; i < 12; ++i) a.in[i] = (const float*)d_in[i];
    a.out = (float*)d_out; a.ws = (unsigned char*)d_ws;
    if (ONE_LAUNCH) {
        a.ph_lo = 0; a.ph_hi = NPH;
        hipLaunchKernelGGL(mega_fwd, dim3(grid), dim3(NWAVES * 64), LDS_BYTES, stream, a);
    } else {
        for (int p = 0; p < NPH; ++p) { a.ph_lo = p; a.ph_hi = p + 1; hipLaunchKernelGGL(mega_fwd, dim3(grid), dim3(NWAVES * 64), LDS_BYTES, stream, a); }
    }
    const hipError_t le = hipPeekAtLastError();
    if (le != hipSuccess) fprintf(stderr, "kernel_launch: launch failed: %s\n", hipGetErrorName(le));
}
```
